# Optimizing an MI355X kernel written in HIP

```python
import functools
import jax, jax.numpy as jnp
from jax import lax
import numpy as np

D_MODEL = 2048
BATCH = 4
SEQ = 2048
DEPTH = 1
DEC_BATCH = 32
DEC_SEQ = 1
PAST_LEN = 16384
PAGE_SIZE = 128

MIX_WIDTH = D_MODEL
ATTN_WIDTH = MIX_WIDTH // 2
GMLP_WIDTH = MIX_WIDTH - ATTN_WIDTH
HEAD_DIM = 64
N_HEADS = ATTN_WIDTH // HEAD_DIM
N_KV_HEADS = 4
GQA_GROUP = N_HEADS // N_KV_HEADS
KV_WIDTH = N_KV_HEADS * HEAD_DIM
WINDOW = 128
ROPE_THETA = 500000.0
ROPE_DIM = HEAD_DIM // 4
CHUNK = 128
GMLP_GROUP_DIM = 128
N_GMLP_GROUPS = GMLP_WIDTH // GMLP_GROUP_DIM
D_FF = ((8 * D_MODEL // 3 + 127) // 128) * 128
N_SUB = 3
ALPHA = (2.0 * DEPTH) ** 0.25
BETA = (8.0 * DEPTH) ** -0.25
LN_EPS = 1e-5
Q_END = ATTN_WIDTH
K_END = Q_END + KV_WIDTH
V_END = K_END + KV_WIDTH
U_END = V_END + GMLP_WIDTH
IN_WIDTH = U_END + GMLP_WIDTH

kernel_name = "hymba_swa_sink_gmlp_macaron_deepnorm_adaln_step"


def layer_norm(x, g, b):
    xf = x.astype(jnp.float32)
    mu = xf.mean(-1, keepdims=True)
    var = jnp.square(xf - mu).mean(-1, keepdims=True)
    return ((xf - mu) * lax.rsqrt(var + LN_EPS) * g + b).astype(x.dtype)


def rms_norm(x, g):
    xf = x.astype(jnp.float32)
    return (xf * lax.rsqrt(jnp.square(xf).mean(-1, keepdims=True) + LN_EPS) * g).astype(x.dtype)


def partial_rope(x, pos):
    half = ROPE_DIM // 2
    inv = ROPE_THETA ** (-(jnp.arange(half, dtype=jnp.float32) * 2.0) / ROPE_DIM)
    ang = pos.astype(jnp.float32)[:, None] * inv[None, :]
    cos = jnp.cos(ang)[None, :, None, :]
    sin = jnp.sin(ang)[None, :, None, :]
    xr = x[..., :ROPE_DIM].astype(jnp.float32)
    x1, x2 = xr[..., :half], xr[..., half:]
    rot = jnp.concatenate([x1 * cos - x2 * sin, x2 * cos + x1 * sin], -1).astype(x.dtype)
    return jnp.concatenate([rot, x[..., ROPE_DIM:]], -1)


def sink_attention(q, k, v, mask, sinks):
    s = jnp.einsum('...qkgd,...ckd->...kgqc', q.astype(jnp.float32), k.astype(jnp.float32)) * (HEAD_DIM ** -0.5)
    s = jnp.where(mask, s, -jnp.inf)
    sink = sinks.astype(jnp.float32).reshape(N_KV_HEADS, GQA_GROUP, 1, 1)
    m = jnp.maximum(s.max(-1, keepdims=True), sink)
    p = jnp.exp(s - m)
    w = p / (p.sum(-1, keepdims=True) + jnp.exp(sink - m))
    return jnp.einsum('...kgqc,...ckd->...qkgd', w.astype(v.dtype), v)


def spatial_mix(vn, w_s, b_s):
    t = vn.shape[-3]
    w = jnp.where(jnp.tril(jnp.ones((t, t), dtype=bool)), w_s[:, :t, :t], 0.0).astype(vn.dtype)
    mix = jnp.einsum('gij,...jgd->...igd', w, vn)
    return mix + b_s[:, :t].T[:, :, None].astype(vn.dtype)


def gmlp_branch(pu, pv, gn_g, gn_b, w_s, b_s):
    u = jax.nn.gelu(pu)
    v = jax.nn.gelu(pv)
    grp = v.shape[:-1] + (N_GMLP_GROUPS, GMLP_GROUP_DIM)
    vn = layer_norm(v.reshape(grp), gn_g.reshape(N_GMLP_GROUPS, GMLP_GROUP_DIM), gn_b.reshape(N_GMLP_GROUPS, GMLP_GROUP_DIM))
    gated = u.reshape(grp) * spatial_mix(vn, w_s, b_s)
    return gated.reshape(u.shape), vn.reshape(v.shape)


def split_projection(p):
    return p[..., :Q_END], p[..., Q_END:K_END], p[..., K_END:V_END], p[..., V_END:U_END], p[..., U_END:IN_WIDTH]


def mix_output(attn, gm, out_g, w_o):
    merged = jnp.concatenate([rms_norm(attn, out_g[:ATTN_WIDTH]), rms_norm(gm, out_g[ATTN_WIDTH:])], -1)
    return merged @ w_o


def mixer_prompt(h, w_in, sinks, gn_g, gn_b, w_s, b_s, out_g, w_o):
    b, s, _ = h.shape
    q, k, v, pu, pv = split_projection(h @ w_in)
    pos = jnp.arange(s)
    q = partial_rope(q.reshape(b, s, N_HEADS, HEAD_DIM), pos)
    k = partial_rope(k.reshape(b, s, N_KV_HEADS, HEAD_DIM), pos)
    v = v.reshape(b, s, N_KV_HEADS, HEAD_DIM)
    nb = s // WINDOW
    qb = q.reshape(b, nb, WINDOW, N_KV_HEADS, GQA_GROUP, HEAD_DIM)

    def band_keys(t):
        prev = jnp.concatenate([jnp.zeros_like(t[:, :WINDOW]), t[:, :-WINDOW]], 1)
        return jnp.concatenate([prev.reshape(b, nb, WINDOW, N_KV_HEADS, HEAD_DIM),
                                t.reshape(b, nb, WINDOW, N_KV_HEADS, HEAD_DIM)], 2)

    kb, vb = band_keys(k), band_keys(v)
    qi = jnp.arange(WINDOW)[:, None]
    ci = jnp.arange(2 * WINDOW)[None, :]
    rel = WINDOW + qi - ci
    band = (rel >= 0) & (rel < WINDOW)
    valid = band[None] & ((jnp.arange(nb)[:, None, None] > 0) | (ci >= WINDOW)[None])
    attn = sink_attention(qb, kb, vb, valid[:, None, None], sinks).reshape(b, s, ATTN_WIDTH)
    nc = s // CHUNK
    gm, _ = gmlp_branch(pu.reshape(b, nc, CHUNK, GMLP_WIDTH), pv.reshape(b, nc, CHUNK, GMLP_WIDTH), gn_g, gn_b, w_s, b_s)
    gm = gm.reshape(b, s, GMLP_WIDTH)
    buf = min(WINDOW, s)
    return mix_output(attn, gm, out_g, w_o), (k[:, s - buf:], v[:, s - buf:])


def mixer_sample(h, cache_k, cache_v, w_in, sinks, gn_g, gn_b, w_s, b_s, out_g, w_o):
    b, t, _ = h.shape
    buf = cache_k.shape[1]
    q, k, v, pu, pv = split_projection(h @ w_in)
    pos = PAST_LEN + jnp.arange(t)
    q = partial_rope(q.reshape(b, t, N_HEADS, HEAD_DIM), pos)
    k = partial_rope(k.reshape(b, t, N_KV_HEADS, HEAD_DIM), pos)
    v = v.reshape(b, t, N_KV_HEADS, HEAD_DIM)
    k_all = jnp.concatenate([cache_k.astype(k.dtype), k], 1)
    v_all = jnp.concatenate([cache_v.astype(v.dtype), v], 1)
    kpos = PAST_LEN - buf + jnp.arange(buf + t)
    rel = pos[:, None] - kpos[None, :]
    mask = (rel >= 0) & (rel < WINDOW)
    attn = sink_attention(q.reshape(b, t, N_KV_HEADS, GQA_GROUP, HEAD_DIM), k_all, v_all, mask[None, None], sinks)
    attn = attn.reshape(b, t, ATTN_WIDTH)
    gm, vn = gmlp_branch(pu, pv, gn_g, gn_b, w_s, b_s)
    return mix_output(attn, gm, out_g, w_o), (k_all[:, t:], v_all[:, t:], vn)


def swiglu(h, w_up, w_down):
    up = h @ w_up
    return (jax.nn.silu(up[..., D_FF:]) * up[..., :D_FF]) @ w_down


def run_layer(x, c, mixer, w_ada, b_ada, ln_g, ln_b, w_up, w_down):
    mod = (jax.nn.silu(c) @ w_ada + b_ada).reshape(c.shape[0], N_SUB, 3, D_MODEL)
    shift, scale, gate = mod[:, :, 0, None], mod[:, :, 1, None], mod[:, :, 2, None]

    def modulate(t, i):
        return t * (1.0 + scale[:, i]) + shift[:, i]

    x = layer_norm(ALPHA * x + 0.5 * gate[:, 0] * swiglu(modulate(x, 0), w_up[0], w_down[0]), ln_g[0], ln_b[0])
    mixed, states = mixer(modulate(x, 1))
    x = layer_norm(ALPHA * x + gate[:, 1] * mixed, ln_g[1], ln_b[1])
    x = layer_norm(ALPHA * x + 0.5 * gate[:, 2] * swiglu(modulate(x, 2), w_up[1], w_down[1]), ln_g[2], ln_b[2])
    return x, states


def setup_inputs(seed: int = 0) -> dict:
    key = jax.random.key(seed)
    ks = jax.random.split(key, 22)
    buf = min(WINDOW, PAST_LEN)

    def nrm(k, shape, scale=1.0):
        return scale * jax.random.normal(k, shape, jnp.float32)

    return {
        "x_prompt": nrm(ks[0], (BATCH, SEQ, D_MODEL)),
        "x_sample": nrm(ks[1], (DEC_BATCH, DEC_SEQ, D_MODEL)),
        "cache_k_win": nrm(ks[2], (DEPTH, DEC_BATCH, buf, N_KV_HEADS, HEAD_DIM)),
        "cache_v_win": nrm(ks[3], (DEPTH, DEC_BATCH, buf, N_KV_HEADS, HEAD_DIM)),
        "c_prompt": nrm(ks[4], (BATCH, D_MODEL)),
        "c_sample": nrm(ks[5], (DEC_BATCH, D_MODEL)),
        "w_ada": nrm(ks[6], (DEPTH, D_MODEL, N_SUB * 3 * D_MODEL), 0.5 * D_MODEL ** -0.5),
        "b_ada": nrm(ks[7], (DEPTH, N_SUB * 3 * D_MODEL), 0.02),
        "ln_g": 1.0 + nrm(ks[8], (DEPTH, N_SUB, D_MODEL), 0.02),
        "ln_b": nrm(ks[9], (DEPTH, N_SUB, D_MODEL), 0.02),
        "w_ffn_up": nrm(ks[10], (DEPTH, 2, D_MODEL, 2 * D_FF), D_MODEL ** -0.5),
        "w_ffn_down": nrm(ks[11], (DEPTH, 2, D_FF, D_MODEL), BETA * D_FF ** -0.5),
        "w_in": nrm(ks[12], (DEPTH, D_MODEL, IN_WIDTH), D_MODEL ** -0.5),
        "attn_sinks": nrm(ks[13], (DEPTH, N_HEADS), 0.5),
        "gmlp_norm_g": 1.0 + nrm(ks[14], (DEPTH, GMLP_WIDTH), 0.02),
        "gmlp_norm_b": nrm(ks[15], (DEPTH, GMLP_WIDTH), 0.02),
        "w_spatial": nrm(ks[16], (DEPTH, N_GMLP_GROUPS, CHUNK, CHUNK), CHUNK ** -0.5),
        "b_spatial": 1.0 + nrm(ks[17], (DEPTH, N_GMLP_GROUPS, CHUNK), 0.02),
        "out_norm_g": 1.0 + nrm(ks[18], (DEPTH, MIX_WIDTH), 0.02),
        "w_o": nrm(ks[19], (DEPTH, MIX_WIDTH, D_MODEL), BETA * MIX_WIDTH ** -0.5),
    }


def reference(x_prompt, x_sample, cache_k_win, cache_v_win, c_prompt, c_sample, w_ada, b_ada, ln_g, ln_b,
              w_ffn_up, w_ffn_down, w_in, attn_sinks, gmlp_norm_g, gmlp_norm_b, w_spatial, b_spatial,
              out_norm_g, w_o):
    yp, ys = x_prompt, x_sample
    kp, vp, kss, vss, gvs = [], [], [], [], []
    for l in range(DEPTH):
        mix_w = (w_in[l], attn_sinks[l], gmlp_norm_g[l], gmlp_norm_b[l], w_spatial[l], b_spatial[l], out_norm_g[l], w_o[l])
        common = (w_ada[l], b_ada[l], ln_g[l], ln_b[l], w_ffn_up[l], w_ffn_down[l])
        yp, (k_new, v_new) = run_layer(yp, c_prompt, functools.partial(mixer_prompt, w_in=mix_w[0], sinks=mix_w[1], gn_g=mix_w[2], gn_b=mix_w[3], w_s=mix_w[4], b_s=mix_w[5], out_g=mix_w[6], w_o=mix_w[7]), *common)
        ys, (k_s, v_s, gv_s) = run_layer(ys, c_sample, functools.partial(mixer_sample, cache_k=cache_k_win[l], cache_v=cache_v_win[l], w_in=mix_w[0], sinks=mix_w[1], gn_g=mix_w[2], gn_b=mix_w[3], w_s=mix_w[4], b_s=mix_w[5], out_g=mix_w[6], w_o=mix_w[7]), *common)
        kp.append(k_new)
        vp.append(v_new)
        kss.append(k_s)
        vss.append(v_s)
        gvs.append(gv_s)
    return (yp, ys, jnp.stack(kp), jnp.stack(vp), jnp.stack(kss), jnp.stack(vss), jnp.stack(gvs))
```

```cpp
#include <hip/hip_runtime.h>
#include <hip/hip_cooperative_groups.h>
#include <cstdio>
#include <cstdint>
namespace cg = cooperative_groups;
#ifndef DUP_P0
#define DUP_P0 0
#endif
#ifndef DUP_UP
#define DUP_UP 0
#endif
#ifndef DUP_DN
#define DUP_DN 0
#endif
#ifndef DUP_MIX
#define DUP_MIX 0
#endif
#ifndef DUP_IN
#define DUP_IN 0
#endif
#ifndef DUP_WO
#define DUP_WO 0
#endif
#ifndef DUP_ROW
#define DUP_ROW 0
#endif
namespace pg8 {
#define PG8_LAS __attribute__((address_space(3)))
typedef unsigned short bf16_t;
typedef short bf16x8 __attribute__((ext_vector_type(8)));
typedef float f32x4 __attribute__((ext_vector_type(4)));
typedef unsigned u32x4 __attribute__((ext_vector_type(4)));
constexpr int BM = 256, BK = 64, HALF = 128, HTB = HALF * BK * 2  , STAGE_BYTES = 8 * HTB, NXCD = 8, WGM = 8;

__host__ __device__ __forceinline__ int lds_byte(int r, int c) { const int st = (r >> 4) * 2 + (c >> 5), rr = r & 15, cc = c & 31, ob = rr * 64 + cc * 2; return st * 1024 + (ob ^ (((ob >> 9) & 1) << 5)); }
__host__ __device__ __forceinline__ void stage_rc(int b, int& R, int& C) { const int st = b / 1024, sb = b % 1024, swz = sb ^ (((sb >> 9) & 1) << 5); R = (st >> 1) * 16 + swz / 64; C = (st & 1) * 32 + (swz % 64) / 2; }
__host__ __device__ __forceinline__ int perm32(int rho) { const int n = rho >> 4, i = rho & 15; return 8 * (i >> 2) + 4 * n + (i & 3); }

struct Unit { int pm, pn; };
struct Gemm { const bf16_t* A; const bf16_t* Bt; int M, N, K; };

struct StaticOrder {
    int nM, nN, nwg, G, c;
    __host__ __device__ void init(int M, int N, int G_, int c_) { nM = M / BM; nN = N / BM; nwg = nM * nN; G = G_; c = c_; }
    __host__ __device__ bool next(int i, Unit& u) const {
        const long L = (long)i * G + c; if (L >= nwg) return false;
        int wgid = (int)L; { const int q = nwg / NXCD, r = nwg % NXCD, xcd = wgid % NXCD, off = wgid / NXCD; wgid = (xcd < r ? xcd * (q + 1) : r * (q + 1) + (xcd - r) * q) + off; }
        const int nig = WGM * nN, gid = wgid / nig, fm = gid * WGM, gsz = (nM - fm) < WGM ? (nM - fm) : WGM;
        u.pm = fm + ((wgid % nig) % gsz); u.pn = (wgid % nig) / gsz; return true;
    }
    __device__ __forceinline__ void a_ready(const Unit&) const {}
    __device__ __forceinline__ void done(const Unit&) const {}
};

__device__ __forceinline__ unsigned cvt_pk_bf16(float lo, float hi) { unsigned r; asm volatile("v_cvt_pk_bf16_f32 %0, %1, %2" : "=v"(r) : "v"(lo), "v"(hi)); return r; }
typedef int i32x4v __attribute__((ext_vector_type(4)));
typedef int i32x8v __attribute__((ext_vector_type(8)));
__device__ __forceinline__ f32x4 mma_fp8(const bf16x8 (&a)[2], const bf16x8 (&b)[2], f32x4 c) {
    const i32x8v A = __builtin_shufflevector(__builtin_bit_cast(i32x4v, a[0]), __builtin_bit_cast(i32x4v, a[1]), 0, 1, 2, 3, 4, 5, 6, 7);
    const i32x8v B = __builtin_shufflevector(__builtin_bit_cast(i32x4v, b[0]), __builtin_bit_cast(i32x4v, b[1]), 0, 1, 2, 3, 4, 5, 6, 7);
    asm volatile("v_mfma_f32_16x16x128_f8f6f4 %0, %1, %2, %0" : "+v"(c) : "v"(A), "v"(B));
    return c;
}
template <class Epi, class Sched, bool ALIGN_EPI = false, bool SP2 = false, bool FP8 = false>
__device__ __forceinline__ void gemm_phase(PG8_LAS unsigned char* lds, const Gemm g, const Sched& S, const Epi& E) {
    int tid_ = threadIdx.x; asm volatile("" : "+v"(tid_));
    const int tid = tid_, wid = __builtin_amdgcn_readfirstlane(tid >> 6), lane = tid & 63, wr = wid >> 2, wc = wid & 3, fr = lane & 15, fq = lane >> 4;
    const int K = g.K, nt = K / BK;
    unsigned voffA[2], voffB[2];
#pragma unroll
    for (int i = 0; i < 2; ++i) { int R, C; stage_rc(tid * 16 + i * 8192, R, C); const int Rb = Epi::PERM ? ((R & ~31) + perm32(R & 31)) : R;
        voffA[i] = (unsigned)(R * K + C) * 2u; voffB[i] = (unsigned)(Rb * K + C) * 2u; }
    const size_t kstep = (size_t)(BK * 2);
    const size_t hstep = (size_t)HALF * K * 2;
    const size_t tstep = 2 * hstep;
    const unsigned ldsw = (unsigned)wid * 1024u;
    const int aoff = lds_byte(wr * 64 + fr, fq * 8), boff = lds_byte(wc * 32 + fr, fq * 8);
#define PG8_SA(b, h) (((b) * 2 + (h)) * HTB)
#define PG8_SB(b, h) ((4 + (b) * 2 + (h)) * HTB)
#define PG8_STAGE(bufoff, gbase, voff) do { _Pragma("unroll") for (int _i = 0; _i < 2; ++_i) \
        __builtin_amdgcn_global_load_lds((const unsigned*)((const char*)(gbase) + (voff)[_i]), (PG8_LAS unsigned*)(lds + (bufoff) + ldsw + _i * 8192), 16, 0, 0); } while (0)
#define PG8_LDA(dst, b, h) do { _Pragma("unroll") for (int m = 0; m < 4; ++m) _Pragma("unroll") for (int k = 0; k < 2; ++k) dst[m][k] = *(const PG8_LAS bf16x8*)(lds + PG8_SA(b, h) + aoff + m * 2048 + k * 1024); } while (0)
#define PG8_LDB(dst, b, h) do { _Pragma("unroll") for (int n = 0; n < 2; ++n) _Pragma("unroll") for (int k = 0; k < 2; ++k) dst[n][k] = *(const PG8_LAS bf16x8*)(lds + PG8_SB(b, h) + boff + n * 2048 + k * 1024); } while (0)
#define PG8_MMA(ai, bj, At, Bt) do { __builtin_amdgcn_s_setprio(1); \
        if constexpr (FP8) { _Pragma("unroll") for (int m = 0; m < 4; ++m) _Pragma("unroll") for (int n = 0; n < 2; ++n) acc[ai][bj][m][n] = mma_fp8(Bt[n], At[m], acc[ai][bj][m][n]); } \
        else { _Pragma("unroll") for (int m = 0; m < 4; ++m) _Pragma("unroll") for (int n = 0; n < 2; ++n) _Pragma("unroll") for (int k = 0; k < 2; ++k) \
        acc[ai][bj][m][n] = __builtin_amdgcn_mfma_f32_16x16x32_bf16(Bt[n][k], At[m][k], acc[ai][bj][m][n], 0, 0, 0); } __builtin_amdgcn_s_setprio(0); } while (0)
#define PG8_WAIT_V(n) asm volatile("s_waitcnt vmcnt(" #n ")" ::: "memory")
#define PG8_WAIT_L(n) asm volatile("s_waitcnt lgkmcnt(" #n ")" ::: "memory")
#define PG8_BAR __builtin_amdgcn_s_barrier()
#define PG8_SCHED __builtin_amdgcn_sched_barrier(0)
    Unit cur, nxt; int ui = 0;
    if (!S.next(0, cur)) return;
    f32x4 acc[2][2][4][2];
#pragma unroll
    for (int a = 0; a < 2; ++a)
#pragma unroll
        for (int b = 0; b < 2; ++b)
#pragma unroll
            for (int m = 0; m < 4; ++m)
#pragma unroll
                for (int n = 0; n < 2; ++n) acc[a][b][m][n] = (f32x4){0.f, 0.f, 0.f, 0.f};
    bf16x8 At[4][2], B0[2][2], B1[2][2];
    const char* cA = (const char*)g.A + (size_t)cur.pm * tstep; const char* cB = (const char*)g.Bt + (size_t)cur.pn * tstep;
    S.a_ready(cur);
    if constexpr (SP2) {
        PG8_STAGE(PG8_SB(0, 0), cB, voffB); PG8_STAGE(PG8_SB(0, 1), cB + hstep, voffB); PG8_STAGE(PG8_SA(0, 0), cA, voffA); PG8_STAGE(PG8_SA(0, 1), cA + hstep, voffA);
        if (wr == 1) PG8_BAR;
        PG8_WAIT_V(2); PG8_BAR;
        PG8_STAGE(PG8_SB(1, 0), cB + kstep, voffB); PG8_STAGE(PG8_SA(1, 0), cA + kstep, voffA); PG8_STAGE(PG8_SB(1, 1), cB + hstep + kstep, voffB);
        PG8_WAIT_V(6); PG8_BAR;
    } else {
        PG8_STAGE(PG8_SB(0, 0), cB, voffB); PG8_STAGE(PG8_SA(0, 0), cA, voffA); PG8_STAGE(PG8_SB(0, 1), cB + hstep, voffB); PG8_STAGE(PG8_SA(0, 1), cA + hstep, voffA);
        if (wr == 1) PG8_BAR;
        PG8_WAIT_V(4); PG8_BAR;
        PG8_STAGE(PG8_SB(1, 0), cB + kstep, voffB); PG8_STAGE(PG8_SA(1, 0), cA + kstep, voffA); PG8_STAGE(PG8_SB(1, 1), cB + hstep + kstep, voffB);
        PG8_WAIT_V(6); PG8_BAR;
    }
    for (;;) {
        const bool has_next = S.next(ui + 1, nxt);
        const char* nA = has_next ? (const char*)g.A + (size_t)nxt.pm * tstep : cA; const char* nB = has_next ? (const char*)g.Bt + (size_t)nxt.pn * tstep : cB;
        for (int t = 0; t < nt; t += 2) {
            const bool last = (t == nt - 2);
            const char* a1 = cA + (size_t)(t + 1) * kstep;
            const char* a2 = last ? nA : cA + (size_t)(t + 2) * kstep; const char* b2 = last ? nB : cB + (size_t)(t + 2) * kstep;
            const char* a3 = a2 + kstep; const char* b3 = b2 + kstep;
            if (last && has_next) S.a_ready(nxt);
            if constexpr (SP2) {
            PG8_LDB(B0, 0, 0); PG8_LDB(B1, 0, 1); PG8_SCHED; PG8_LDA(At, 0, 0); PG8_STAGE(PG8_SA(1, 1), a1 + hstep, voffA);
            PG8_WAIT_V(8); PG8_WAIT_L(0); PG8_BAR; PG8_MMA(0, 0, At, B0); PG8_MMA(0, 1, At, B1); PG8_BAR; PG8_SCHED;
            PG8_LDA(At, 0, 1); PG8_STAGE(PG8_SB(0, 0), b2, voffB); PG8_STAGE(PG8_SB(0, 1), b2 + hstep, voffB); PG8_STAGE(PG8_SA(0, 0), a2, voffA);
            PG8_WAIT_V(8); PG8_WAIT_L(0); PG8_BAR; PG8_MMA(1, 0, At, B0); PG8_MMA(1, 1, At, B1); PG8_BAR; PG8_SCHED;
            PG8_LDB(B0, 1, 0); PG8_LDB(B1, 1, 1); PG8_SCHED; PG8_LDA(At, 1, 0); PG8_STAGE(PG8_SA(0, 1), a2 + hstep, voffA);
            PG8_WAIT_V(8); PG8_WAIT_L(0); PG8_BAR; PG8_MMA(0, 0, At, B0); PG8_MMA(0, 1, At, B1); PG8_BAR; PG8_SCHED;
            PG8_LDA(At, 1, 1); PG8_STAGE(PG8_SB(1, 0), b3, voffB); PG8_STAGE(PG8_SB(1, 1), b3 + hstep, voffB); PG8_STAGE(PG8_SA(1, 0), a3, voffA);
            PG8_WAIT_V(8); PG8_WAIT_L(0); PG8_BAR; PG8_MMA(1, 0, At, B0); PG8_MMA(1, 1, At, B1); PG8_BAR; PG8_SCHED;
            } else {
            PG8_LDB(B0, 0, 0); PG8_SCHED; PG8_LDA(At, 0, 0); PG8_STAGE(PG8_SA(1, 1), a1 + hstep, voffA);
            PG8_WAIT_L(8); PG8_BAR; PG8_WAIT_L(0); PG8_MMA(0, 0, At, B0); PG8_BAR; PG8_SCHED;
            PG8_LDB(B1, 0, 1); PG8_STAGE(PG8_SB(0, 0), b2, voffB);
            PG8_BAR; PG8_WAIT_L(0); PG8_MMA(0, 1, At, B1); PG8_BAR;
            PG8_LDA(At, 0, 1); PG8_STAGE(PG8_SA(0, 0), a2, voffA);
            PG8_BAR; PG8_WAIT_L(0); PG8_MMA(1, 0, At, B0); PG8_BAR; PG8_SCHED;
            PG8_STAGE(PG8_SB(0, 1), b2 + hstep, voffB);
            PG8_WAIT_V(6); PG8_BAR; PG8_MMA(1, 1, At, B1); PG8_BAR;
            PG8_LDB(B0, 1, 0); PG8_SCHED; PG8_LDA(At, 1, 0); PG8_STAGE(PG8_SA(0, 1), a2 + hstep, voffA);
            PG8_WAIT_L(8); PG8_BAR; PG8_WAIT_L(0); PG8_MMA(0, 0, At, B0); PG8_BAR; PG8_SCHED;
            PG8_LDB(B1, 1, 1); PG8_STAGE(PG8_SB(1, 0), b3, voffB);
            PG8_BAR; PG8_WAIT_L(0); PG8_MMA(0, 1, At, B1); PG8_BAR;
            PG8_LDA(At, 1, 1); PG8_STAGE(PG8_SA(1, 0), a3, voffA);
            PG8_BAR; PG8_WAIT_L(0); PG8_MMA(1, 0, At, B0); PG8_BAR; PG8_SCHED;
            PG8_STAGE(PG8_SB(1, 1), b3 + hstep, voffB);
            PG8_WAIT_V(6); PG8_BAR; PG8_MMA(1, 1, At, B1); PG8_BAR;
            }
        }
        if constexpr (FP8) asm volatile("s_nop 15\n\ts_nop 15\n\ts_nop 15\n\ts_nop 15" ::: "memory");
        if constexpr (ALIGN_EPI) { if (wr == 0) PG8_BAR; }
        if constexpr (!Epi::AFTER_DRAIN) { E(acc, cur, wr, wc, fr, fq); S.done(cur); }
        if (!has_next) break;
#pragma unroll
        for (int a = 0; a < 2; ++a)
#pragma unroll
            for (int b = 0; b < 2; ++b)
#pragma unroll
                for (int m = 0; m < 4; ++m)
#pragma unroll
                    for (int n = 0; n < 2; ++n) acc[a][b][m][n] = (f32x4){0.f, 0.f, 0.f, 0.f};
        cur = nxt; cA = nA; cB = nB; ++ui;
        if constexpr (ALIGN_EPI) { if (wr == 1) PG8_BAR; }
    }
    PG8_WAIT_V(0);
    if constexpr (!ALIGN_EPI) { if (wr == 0) PG8_BAR; }
    PG8_BAR;
    if constexpr (Epi::AFTER_DRAIN) { E.fused(acc, cur, wr, wc, fr, fq, lds, wid, lane); S.done(cur); }
#undef PG8_SA
#undef PG8_SB
#undef PG8_STAGE
#undef PG8_LDA
#undef PG8_LDB
#undef PG8_MMA
#undef PG8_WAIT_V
#undef PG8_WAIT_L
#undef PG8_BAR
#undef PG8_SCHED
}
}
#define LAS __attribute__((address_space(3)))
typedef unsigned short bf16_t;
typedef short bf16x8 __attribute__((ext_vector_type(8)));
typedef float f32x4 __attribute__((ext_vector_type(4)));
typedef float f32x16 __attribute__((ext_vector_type(16)));
typedef unsigned u32x4 __attribute__((ext_vector_type(4)));
typedef unsigned u32x2 __attribute__((ext_vector_type(2)));

constexpr int DM = 2048, SEQ = 2048, MP = 8192, NS = 32, MT = MP + NS, MPAD = 8448;
constexpr int DFF = 5504, NUP = 2 * DFF, INW = 3584, NMOD = 18432, NC = 36;
constexpr int DFFP = 5632;
constexpr float W_UP_SCALE = 32.f, W_DN_SCALE = 64.f, ACT_SCALE = 4.f, W_O_SCALE = 64.f;
constexpr float ALPHA = 1.189207115002721f;
constexpr float LN_EPS = 1e-5f;
constexpr int LDS_BYTES = 147456;
constexpr size_t OFF_YP = 0, OFF_YS = 16777216, OFF_KWP = OFF_YS + 65536, OFF_VWP = OFF_KWP + 131072, OFF_KWS = OFF_VWP + 131072, OFF_VWS = OFF_KWS + 1048576, OFF_GVS = OFF_VWS + 1048576;
constexpr size_t MiB = 1u << 20;
constexpr size_t WS_CTL = 0, WS_MOD = 1 * MiB, WS_ROPE = 4 * MiB, WS_SS = 5 * MiB, WS_WUP = 8 * MiB, WS_WDN = 96 * MiB, WS_WIN = 140 * MiB, WS_WO = 154 * MiB,
                 WS_H = 162 * MiB, WS_ACT = 196 * MiB, WS_Y = 286 * MiB, WS_X1 = 352 * MiB, WS_Q = 418 * MiB, WS_U = 436 * MiB, WS_GV = 453 * MiB, WS_K = 470 * MiB, WS_V = 475 * MiB,
                 WS_MIX = 480 * MiB, WS_H8 = 514 * MiB, WS_END = 532 * MiB;
constexpr size_t WS_PART = WS_Y + 40 * MiB;
constexpr size_t WUP_ELEMS = (size_t)NUP * DM, WDN_ELEMS = (size_t)DM * DFF, WDN8_BYTES = (size_t)DM * DFFP;

struct Args { const float* in[20]; float* out; unsigned char* ws; };
typedef const Args __attribute__((address_space(4)))* KArgsPtr;

__device__ __forceinline__ unsigned pk2(float lo, float hi) { return pg8::cvt_pk_bf16(lo, hi); }
__device__ __forceinline__ float bf2f(unsigned short b) { return __builtin_bit_cast(float, (unsigned)b << 16); }
__device__ __forceinline__ float bflo(unsigned w) { return __builtin_bit_cast(float, w << 16); }
__device__ __forceinline__ float bfhi(unsigned w) { return __builtin_bit_cast(float, w & 0xffff0000u); }
__device__ __forceinline__ float wave_sum(float v) {
#pragma unroll
    for (int o = 1; o < 64; o <<= 1) v += __shfl_xor(v, o);
    return v;
}
__device__ __forceinline__ float wave_max(float v) {
#pragma unroll
    for (int o = 1; o < 64; o <<= 1) v = fmaxf(v, __shfl_xor(v, o));
    return v;
}
__device__ __forceinline__ float silu_f(float g) { return g * __builtin_amdgcn_rcpf(1.f + __expf(-g)); }
__device__ __forceinline__ float gelu_f(float x) { const float t = 1.5957691216057308f * (x + 0.044715f * x * x * x); return x * __builtin_amdgcn_rcpf(1.f + __expf(-t)); }
__device__ __forceinline__ bf16x8 pack8(float a0, float a1, float a2, float a3, float a4, float a5, float a6, float a7) {
    u32x4 w; w.x = pk2(a0, a1); w.y = pk2(a2, a3); w.z = pk2(a4, a5); w.w = pk2(a6, a7); return __builtin_bit_cast(bf16x8, w);
}
__device__ __forceinline__ unsigned pk4_fp8(float a, float b, float c, float d) { return (unsigned)__builtin_amdgcn_cvt_pk_fp8_f32(c, d, __builtin_amdgcn_cvt_pk_fp8_f32(a, b, 0, false), true); }
#define MFMA16(A, B, C) __builtin_amdgcn_mfma_f32_16x16x32_bf16((A), (B), (C), 0, 0, 0)

using pg8::Unit;
struct EpiSwiGLU {
    static constexpr bool PERM = true, AFTER_DRAIN = false, MIDK = false;
    unsigned char* O;
    __device__ __forceinline__ void operator()(const f32x4 (&acc)[2][2][4][2], const Unit& u, int wr, int wc, int fr, int fq) const {
        const int row0 = u.pm * 256 + wr * 64 + fr, col0 = u.pn * 128 + wc * 32 + 8 * fq;
        constexpr float IS = 1.f / W_UP_SCALE, OS = ACT_SCALE / W_UP_SCALE;
#pragma unroll
        for (int ai = 0; ai < 2; ++ai)
#pragma unroll
            for (int m = 0; m < 4; ++m) {
                unsigned char* rowp = O + (unsigned)(row0 + ai * 128 + m * 16) * (unsigned)DFFP + (unsigned)col0;
                const f32x4 v0 = acc[ai][0][m][0] * OS, v1 = acc[ai][0][m][1] * OS, g0 = acc[ai][1][m][0] * IS, g1 = acc[ai][1][m][1] * IS;
                u32x2 w;
                w.x = pk4_fp8(silu_f(g0[0]) * v0[0], silu_f(g0[1]) * v0[1], silu_f(g0[2]) * v0[2], silu_f(g0[3]) * v0[3]);
                w.y = pk4_fp8(silu_f(g1[0]) * v1[0], silu_f(g1[1]) * v1[1], silu_f(g1[2]) * v1[2], silu_f(g1[3]) * v1[3]);
                *(u32x2*)rowp = w;
            }
    }
};
template <bool XB  > struct EpiResid {
    static constexpr bool PERM = false, AFTER_DRAIN = false;
    const void* xres; bf16_t* Y; const float* gate; float coef;
    __device__ __forceinline__ void operator()(const f32x4 (&acc)[2][2][4][2], const Unit& u, int wr, int wc, int fr, int fq) const {
        const int b = u.pm >> 3, col0 = u.pn * 256 + wc * 32 + 4 * fq, row0 = u.pm * 256 + wr * 64 + fr;
        f32x4 g4[2][2];
#pragma unroll
        for (int bj = 0; bj < 2; ++bj)
#pragma unroll
            for (int n = 0; n < 2; ++n) g4[bj][n] = *(const f32x4*)(gate + (size_t)b * NMOD + col0 + bj * 128 + n * 16) * coef;
#pragma unroll
        for (int ai = 0; ai < 2; ++ai)
#pragma unroll
            for (int m = 0; m < 4; ++m) {
                const unsigned off = (unsigned)(row0 + ai * 128 + m * 16) * (unsigned)DM + (unsigned)col0;
#pragma unroll
                for (int bj = 0; bj < 2; ++bj)
#pragma unroll
                    for (int n = 0; n < 2; ++n) {
                        f32x4 xr;
                        if (XB) { const u32x2 xw = *(const u32x2*)((const bf16_t*)xres + off + bj * 128 + n * 16); xr = (f32x4){bflo(xw.x), bfhi(xw.x), bflo(xw.y), bfhi(xw.y)}; }
                        else xr = *(const f32x4*)((const float*)xres + off + bj * 128 + n * 16);
                        const f32x4 y = xr * ALPHA + g4[bj][n] * acc[ai][bj][m][n]; u32x2 wv; wv.x = pk2(y[0], y[1]); wv.y = pk2(y[2], y[3]);
                        *(u32x2*)(Y + off + bj * 128 + n * 16) = wv;
                    }
            }
    }
};
struct EpiInProj {
    static constexpr bool PERM = false, AFTER_DRAIN = false;
    bf16_t *Q, *Kb, *Vb, *U, *GV; const float* rope; float* out;
    __device__ __forceinline__ void operator()(const f32x4 (&acc)[2][2][4][2], const Unit& u, int wr, int wc, int fr, int fq) const {
        const int pn = u.pn, pm = u.pm; const bool samp = (pm == 32);
        const unsigned cl = wc * 32 + 4 * fq;
        if (pn < 6) {
            bf16_t* dst = pn < 4 ? Q + pn * 256 : (pn == 4 ? Kb : Vb);
            const unsigned ld = pn < 4 ? 1024u : 256u;
            const float qs = pn < 4 ? 0.125f : 1.f;
            const bool rot = (pn != 5) && ((wc & 1) == 0);
            float* wout = out + (samp ? (pn == 4 ? OFF_KWS : OFF_VWS) : (pn == 4 ? OFF_KWP : OFF_VWP));
#pragma unroll
            for (int ai = 0; ai < 2; ++ai)
#pragma unroll
                for (int m = 0; m < 4; ++m) {
                    const unsigned rowl = ai * 128 + wr * 64 + m * 16 + fr, row = pm * 256 + rowl;
                    f32x4 cs = {1.f, 1.f, 1.f, 1.f}, sn = {0.f, 0.f, 0.f, 0.f};
                    if (rot) { const unsigned pi = samp ? 2048u : (row & 2047u); cs = *(const f32x4*)(rope + pi * 16u + 4u * (fq & 1)); sn = *(const f32x4*)(rope + pi * 16u + 8u + 4u * (fq & 1)); }
                    const bool wwin = (pn >= 4) && (samp ? (rowl < (unsigned)NS) : ((pm & 7) == 7 && ai == 1));
                    const unsigned wrow = samp ? (rowl * 128u + 127u) : ((unsigned)(pm >> 3) * 128u + rowl - 128u);
#pragma unroll
                    for (int bj = 0; bj < 2; ++bj)
#pragma unroll
                        for (int n = 0; n < 2; ++n) {
                            f32x4 v = acc[ai][bj][m][n];
                            if (n == 0 && rot) {
                                f32x4 p; p[0] = __shfl_xor(v[0], 32); p[1] = __shfl_xor(v[1], 32); p[2] = __shfl_xor(v[2], 32); p[3] = __shfl_xor(v[3], 32);
                                v = (fq < 2) ? (v * cs - p * sn) : (v * cs + p * sn);
                            }
                            const unsigned c = bj * 128 + n * 16 + cl;
                            if (wwin) *(f32x4*)(wout + wrow * 256u + c) = v;
                            v = v * qs; u32x2 w; w.x = pk2(v[0], v[1]); w.y = pk2(v[2], v[3]);
                            *(u32x2*)(dst + row * ld + c) = w;
                        }
                    asm volatile("" ::: "memory");
                }
        } else {
            bf16_t* base = (pn < 10) ? (U + (pn - 6) * 256) : (GV + (pn - 10) * 256);
#pragma unroll
            for (int ai = 0; ai < 2; ++ai)
#pragma unroll
                for (int m = 0; m < 4; ++m) {
                    const unsigned row = pm * 256 + ai * 128 + wr * 64 + m * 16 + fr;
#pragma unroll
                    for (int bj = 0; bj < 2; ++bj)
#pragma unroll
                        for (int n = 0; n < 2; ++n) {
                            const f32x4 v = acc[ai][bj][m][n];
                            u32x2 w; w.x = pk2(gelu_f(v[0]), gelu_f(v[1])); w.y = pk2(gelu_f(v[2]), gelu_f(v[3]));
                            *(u32x2*)(base + row * 1024u + bj * 128 + n * 16 + cl) = w;
                        }
                    asm volatile("" ::: "memory");
                }
        }
    }
};

__device__ __forceinline__ void ada_item(KArgsPtr a, LAS unsigned char* lds, int it, int tid) {
    const int w = __builtin_amdgcn_readfirstlane(tid >> 6), lane = tid & 63, fr = lane & 15, fq = lane >> 4;
    const int g = w & 1, kq = w >> 1;
    const float* W = a->in[6]; const int c0 = it * 128;
    f32x4 acc[4][3];
#pragma unroll
    for (int nt = 0; nt < 4; ++nt)
#pragma unroll
        for (int mt = 0; mt < 3; ++mt) acc[nt][mt] = (f32x4){0.f, 0.f, 0.f, 0.f};
    for (int i4 = 0; i4 < 4; ++i4) {
        const int kb = 512 * kq + 128 * i4 + 8 * fq;
        f32x4 wv[4][8];
#pragma unroll
        for (int sx = 0; sx < 4; ++sx)
#pragma unroll
            for (int e = 0; e < 8; ++e) wv[sx][e] = __builtin_nontemporal_load((const f32x4*)(W + (size_t)(kb + 32 * sx + e) * NMOD + c0 + 64 * g + 4 * fr));
#pragma unroll
        for (int sx = 0; sx < 4; ++sx) {
            const int k0 = kb + 32 * sx;
            bf16x8 sc[3];
#pragma unroll
            for (int mt = 0; mt < 3; ++mt) {
                const int r = 16 * mt + fr;
                if (r < NC) {
                    const float* cp = (r < 4 ? a->in[4] + (size_t)r * DM : a->in[5] + (size_t)(r - 4) * DM) + k0;
                    const f32x4 x0 = *(const f32x4*)cp, x1 = *(const f32x4*)(cp + 4);
                    sc[mt] = pack8(silu_f(x0[0]), silu_f(x0[1]), silu_f(x0[2]), silu_f(x0[3]), silu_f(x1[0]), silu_f(x1[1]), silu_f(x1[2]), silu_f(x1[3]));
                } else sc[mt] = (bf16x8){0, 0, 0, 0, 0, 0, 0, 0};
            }
#pragma unroll
            for (int nt = 0; nt < 4; ++nt) {
                const bf16x8 wf = pack8(wv[sx][0][nt], wv[sx][1][nt], wv[sx][2][nt], wv[sx][3][nt], wv[sx][4][nt], wv[sx][5][nt], wv[sx][6][nt], wv[sx][7][nt]);
#pragma unroll
                for (int mt = 0; mt < 3; ++mt) acc[nt][mt] = MFMA16(wf, sc[mt], acc[nt][mt]);
            }
        }
    }
    LAS float* red = (LAS float*)(lds + 69632);
    for (int ww = 0; ww < 8; ++ww) {
        if (w == ww) {
#pragma unroll
            for (int nt = 0; nt < 4; ++nt)
#pragma unroll
                for (int mt = 0; mt < 3; ++mt)
#pragma unroll
                    for (int rg = 0; rg < 4; ++rg) {
                        const int idx = (16 * mt + fr) * 132 + 64 * g + 16 * fq + 4 * rg + nt;
                        if (kq == 0) red[idx] = acc[nt][mt][rg]; else red[idx] += acc[nt][mt][rg];
                    }
        }
        __syncthreads();
    }
    float* mod = (float*)(a->ws + WS_MOD);
    for (int e = tid; e < NC * 128; e += 512) { const int r = e >> 7, c = e & 127; mod[(size_t)r * NMOD + c0 + c] = red[r * 132 + c] + a->in[7][c0 + c]; }
    __syncthreads();
}
constexpr int I_UP = (DM / 64) * (NUP / 32), I_DN = (DFF / 64) * (DM / 32), I_IN = (DM / 64) * (INW / 32), I_WO = (DM / 64) * (DM / 32);
constexpr int N_TR = 2 * I_UP + 2 * I_DN + I_IN + I_WO;
constexpr int N_UP1_DEF = 2304;
constexpr int N_TR_P0 = 2 * I_UP - N_UP1_DEF + I_IN;
constexpr int N_TR_TAIL = 2048;
struct TrItem { const float* src; unsigned char* dst; int N, rowb; float scale; };
__device__ __forceinline__ void tr_decode(KArgsPtr a, int it, int lane, TrItem& d) {
    const float* W; unsigned char* WT; int N, kind = 0, r = it, rowb, esz; float scale = 0.f;
    if (r < 2 * I_UP) { const int l = r >= I_UP ? 1 : 0; r -= l * I_UP; W = a->in[10] + (size_t)l * WUP_ELEMS; WT = a->ws + WS_WUP + (size_t)l * WUP_ELEMS; rowb = DM; esz = 1; N = NUP; kind = 1; scale = W_UP_SCALE; }
    else if ((r -= 2 * I_UP) < 2 * I_DN) { const int l = r >= I_DN ? 1 : 0; r -= l * I_DN; W = a->in[11] + (size_t)l * WDN_ELEMS; WT = a->ws + WS_WDN + (size_t)l * WDN8_BYTES; rowb = DFFP; esz = 1; N = DM; scale = W_DN_SCALE; }
    else if ((r -= 2 * I_DN) < I_IN) { W = a->in[12]; WT = a->ws + WS_WIN; rowb = 2 * DM; esz = 2; N = INW; }
    else { r -= I_IN; W = a->in[19]; WT = a->ws + WS_WO; rowb = DM; esz = 1; N = DM; scale = W_O_SCALE; }
    const int nblk = N / 32, kb = r / nblk, nb = r - kb * nblk, k0 = 64 * kb, n0 = 32 * nb;
    int d0 = n0;
    if (kind) { const int bj = n0 >= DFF ? 1 : 0, q = n0 - bj * DFF; d0 = 256 * (q >> 7) + 128 * bj + (q & 127); }
    d.src = W + (size_t)(k0 + (lane >> 5)) * N + n0 + (lane & 31);
    d.dst = WT + (size_t)(d0 + (lane >> 3)) * rowb + (size_t)(k0 + 8 * (lane & 7)) * esz;
    d.N = N; d.rowb = rowb; d.scale = scale;
}
__device__ __forceinline__ void tr_load(const TrItem& d, float (&v)[32]) {
#pragma unroll
    for (int i = 0; i < 32; ++i) v[i] = __builtin_nontemporal_load(d.src + (size_t)(2 * i) * d.N);
}
__device__ __forceinline__ void tr_store(const TrItem& d, const float (&v)[32], LAS float* scr, int lane) {
#pragma unroll
    for (int i = 0; i < 32; ++i) scr[(2 * i + (lane >> 5)) * 33 + (lane & 31)] = v[i];
    asm volatile("s_waitcnt lgkmcnt(0)" ::: "memory");
    const int c = lane & 7;
    if (d.scale == 0.f) {
#pragma unroll
        for (int j = 0; j < 4; ++j) { const LAS float* sp = scr + (8 * c) * 33 + (lane >> 3) + 8 * j;
            u32x4 o; o.x = pk2(sp[0 * 33], sp[1 * 33]); o.y = pk2(sp[2 * 33], sp[3 * 33]); o.z = pk2(sp[4 * 33], sp[5 * 33]); o.w = pk2(sp[6 * 33], sp[7 * 33]);
            *(u32x4*)(d.dst + (size_t)(8 * j) * d.rowb) = o; }
    } else {
        const float sc = d.scale;
#pragma unroll
        for (int j = 0; j < 4; ++j) { const LAS float* sp = scr + (8 * c) * 33 + (lane >> 3) + 8 * j;
            u32x2 o; o.x = pk4_fp8(sp[0 * 33] * sc, sp[1 * 33] * sc, sp[2 * 33] * sc, sp[3 * 33] * sc); o.y = pk4_fp8(sp[4 * 33] * sc, sp[5 * 33] * sc, sp[6 * 33] * sc, sp[7 * 33] * sc);
            *(u32x2*)(d.dst + (size_t)(8 * j) * d.rowb) = o; }
    }
    asm volatile("s_waitcnt lgkmcnt(0)" ::: "memory");
}
__device__ __forceinline__ void p0_phase(KArgsPtr a, LAS unsigned char* lds, int tid, int rep) {
    const int w = __builtin_amdgcn_readfirstlane(tid >> 6), lane = tid & 63, G = gridDim.x;
    const int NADA = NMOD / 128;
#ifndef DUP_ADA
#define DUP_ADA 0
#endif
    if ((int)blockIdx.x < NADA) { for (int rr = 0; rr <= DUP_ADA; ++rr) for (int it = blockIdx.x; it < NADA; it += G) ada_item(a, lds, it, tid); }
    if ((int)blockIdx.x >= NADA || G <= NADA) {
        const int nb = (G > NADA) ? (G - NADA) : G, bi = (G > NADA) ? ((int)blockIdx.x - NADA) : (int)blockIdx.x;
        float* rope = (float*)(a->ws + WS_ROPE);
        for (int e = bi * 512 + tid; e < 2049 * 8; e += nb * 512) {
            const int pi = e >> 3, i = e & 7;
            const float pos = (pi == 2048) ? 16384.f : (float)pi;
            const float inv = (float)exp2(-(double)i * 0.125 * 18.931568569324174);
            const float angf = pos * inv;
            double ang = (double)angf;
            const double k = rint(ang * 0.15915494309189535);
            double r = fma(-k, 6.283185307179586, ang); r = fma(-k, 2.4492935982947064e-16, r);
            const double r2 = r * r;
            double s = -1.0 / 51090942171709440000.0;
            s = s * r2 + 1.0 / 121645100408832000.0; s = s * r2 - 1.0 / 355687428096000.0; s = s * r2 + 1.0 / 1307674368000.0; s = s * r2 - 1.0 / 6227020800.0;
            s = s * r2 + 1.0 / 39916800.0; s = s * r2 - 1.0 / 362880.0; s = s * r2 + 1.0 / 5040.0; s = s * r2 - 1.0 / 120.0; s = s * r2 + 1.0 / 6.0; s = -s * r2 + 1.0; s = s * r;
            double c = 1.0 / 2432902008176640000.0;
            c = c * r2 - 1.0 / 6402373705728000.0; c = c * r2 + 1.0 / 20922789888000.0; c = c * r2 - 1.0 / 87178291200.0; c = c * r2 + 1.0 / 479001600.0;
            c = c * r2 - 1.0 / 3628800.0; c = c * r2 + 1.0 / 40320.0; c = c * r2 - 1.0 / 720.0; c = c * r2 + 1.0 / 24.0; c = c * r2 - 0.5; c = c * r2 + 1.0;
            rope[pi * 16 + i] = (float)c; rope[pi * 16 + 8 + i] = (float)s;
        }
        for (int e = bi * 512 + tid; e < (2 * DM + MPAD) * 8; e += nb * 512) {
            const int rw = e >> 3, q = e & 7;
            unsigned char* base = rw < 2 * DM ? a->ws + WS_WDN + (size_t)rw * DFFP : a->ws + WS_ACT + (size_t)(rw - 2 * DM) * DFFP;
            *(u32x4*)(base + DFF + 16 * q) = (u32x4){0u, 0u, 0u, 0u};
        }
        for (int e = bi * 512 + tid; e < 2 * NS * 127 * 64; e += nb * 512) {
            const int t = e / (NS * 127 * 64), r = e % (NS * 127 * 64), b = r / (127 * 64), q = r % (127 * 64);
            const f32x4 v = *((const f32x4*)(a->in[2 + t] + (size_t)b * 128 * 256 + 256) + q);
            *((f32x4*)(a->out + (t ? OFF_VWS : OFF_KWS) + (size_t)b * 128 * 256) + q) = v;
        }
    }
    {
        const int gw = blockIdx.x * 8 + w, NGW = G * 8;
        LAS float* scr = (LAS float*)(lds + w * 8448);
        const bool has_tail = (G > NADA) && ((int)blockIdx.x >= NADA);
        const int n_main = (G > NADA) ? (N_TR_P0 - N_TR_TAIL) : N_TR_P0;
        const int nm_w = (gw < n_main) ? (n_main - gw + NGW - 1) / NGW : 0;
        const int tw = ((int)blockIdx.x - NADA) * 8 + w, TNW = (G - NADA) * 8;
        const int nt_w = (has_tail && tw < N_TR_TAIL) ? (N_TR_TAIL - tw + TNW - 1) / TNW : 0;
        const int n_w = nm_w + nt_w;
        for (int k = 0; k < n_w; k += 4) {
            TrItem d[4]; float v[4][32];
#pragma unroll
            for (int q = 0; q < 4; ++q) if (k + q < n_w) { const int kk = k + q; int it = kk < nm_w ? gw + kk * NGW : n_main + tw + (kk - nm_w) * TNW; if (it >= 2 * I_UP - N_UP1_DEF) it += 2 * I_DN + N_UP1_DEF;     tr_decode(a, it, lane, d[q]); tr_load(d[q], v[q]); }
#pragma unroll
            for (int q = 0; q < 4; ++q) if (k + q < n_w) tr_store(d[q], v[q], scr, lane);
        }
    }
}
__device__ __forceinline__ void tr_deferred(KArgsPtr a, LAS unsigned char* lds, int tid, int first, int count, int bi, int nblk) {
    const int w = __builtin_amdgcn_readfirstlane(tid >> 6), lane = tid & 63;
    LAS float* scr = (LAS float*)(lds + w * 8448);
    const int tw = bi * 8 + w, TNW = nblk * 8;
    const int n_w = (tw < count) ? (count - tw + TNW - 1) / TNW : 0;
    for (int k = 0; k < n_w; k += 4) {
        TrItem d[4]; float v[4][32];
#pragma unroll
        for (int q = 0; q < 4; ++q) if (k + q < n_w) { tr_decode(a, first + tw + (k + q) * TNW, lane, d[q]); tr_load(d[q], v[q]); }
#pragma unroll
        for (int q = 0; q < 4; ++q) if (k + q < n_w) tr_store(d[q], v[q], scr, lane);
    }
}
__device__ __forceinline__ const float* mod_row(KArgsPtr a, int row, int sub) {
    const int b = row < MP ? (row >> 11) : (4 + row - MP);
    return (const float*)(a->ws + WS_MOD) + (size_t)b * NMOD + sub * 6144;
}
__device__ __forceinline__ void h0_phase(KArgsPtr a, int tid) {
    const unsigned lane = tid & 63; const int gw = blockIdx.x * 8 + __builtin_amdgcn_readfirstlane(tid >> 6), NGW = gridDim.x * 8;
    unsigned char* H8 = a->ws + WS_H8;
    for (int r0 = gw; r0 < MP; r0 += 4 * NGW) {
        f32x4 xv[4][8];
#pragma unroll
        for (int q = 0; q < 4; ++q) { const int row = r0 + q * NGW; if (row < MP) {
            const f32x4* xr = (const f32x4*)(row < MP ? a->in[0] + (size_t)row * DM : a->in[1] + (size_t)(row - MP) * DM);
#pragma unroll
            for (int j = 0; j < 8; ++j) xv[q][j] = __builtin_nontemporal_load(xr + (64u * j + lane)); } }
#pragma unroll
        for (int q = 0; q < 4; ++q) { const int row = r0 + q * NGW; if (row < MP) {
            const f32x4* sh = (const f32x4*)mod_row(a, row, 0); const f32x4* scl = sh + 512;
            unsigned* o = (unsigned*)(H8 + (size_t)row * DM);
#pragma unroll
            for (int j = 0; j < 8; ++j) { const unsigned c = 64u * j + lane; const f32x4 h = xv[q][j] * (scl[c] + 1.f) + sh[c]; o[c] = pk4_fp8(h[0], h[1], h[2], h[3]); } } }
    }
    const int w = __builtin_amdgcn_readfirstlane(tid >> 6);
    for (int t = blockIdx.x; t < NS; t += gridDim.x) {
        const int row = MP + t; const unsigned c = 64u * w + lane;
        const f32x4 x = ((const f32x4*)(a->in[1] + (size_t)t * DM))[c];
        const f32x4* sh = (const f32x4*)mod_row(a, row, 0); const f32x4* scl = sh + 512;
        const f32x4 h = x * (scl[c] + 1.f) + sh[c];
        ((unsigned*)(H8 + (size_t)row * DM))[c] = pk4_fp8(h[0], h[1], h[2], h[3]);
    }
}
__device__ __forceinline__ void ln_finish(KArgsPtr a, f32x4 (&v)[8], int row, unsigned lane, int li, bool final_out, int next_sub) {
    const f32x4* g4 = (const f32x4*)(a->in[8] + li * DM); const f32x4* b4 = (const f32x4*)(a->in[9] + li * DM);
    bf16_t* X1 = (bf16_t*)(a->ws + WS_X1); bf16_t* H = (bf16_t*)(a->ws + WS_H);
    float s = 0.f;
#pragma unroll
    for (int j = 0; j < 8; ++j) s += (v[j][0] + v[j][1]) + (v[j][2] + v[j][3]);
    const float mean = wave_sum(s) * (1.f / DM); float q = 0.f;
#pragma unroll
    for (int j = 0; j < 8; ++j) { v[j] = v[j] - mean; q += (v[j][0] * v[j][0] + v[j][1] * v[j][1]) + (v[j][2] * v[j][2] + v[j][3] * v[j][3]); }
    const float rstd = 1.f / sqrtf(wave_sum(q) * (1.f / DM) + LN_EPS);
    f32x4* xo = (f32x4*)(row < MP ? a->out + OFF_YP + (size_t)row * DM : a->out + OFF_YS + (size_t)(row - MP) * DM); u32x2* xb = (u32x2*)(X1 + (size_t)row * DM);
    const f32x4* sh = (const f32x4*)mod_row(a, row, final_out ? 0 : next_sub); const f32x4* scl = sh + 512;
    u32x2* ho = (u32x2*)(H + (size_t)row * DM); unsigned* ho8 = (unsigned*)(a->ws + WS_H8 + (size_t)row * DM);
#pragma unroll
    for (int j = 0; j < 8; ++j) {
        const unsigned c = 64u * j + lane; const f32x4 x = v[j] * rstd * g4[c] + b4[c]; if (final_out) xo[c] = x; else { u32x2 xw; xw.x = pk2(x[0], x[1]); xw.y = pk2(x[2], x[3]); xb[c] = xw; }
        if (!final_out) { const f32x4 h = x * (scl[c] + 1.f) + sh[c];
            if (next_sub == 2) ho8[c] = pk4_fp8(h[0], h[1], h[2], h[3]);
            else { u32x2 wv; wv.x = pk2(h[0], h[1]); wv.y = pk2(h[2], h[3]); ho[c] = wv; } }
        if (j & 1) asm volatile("" ::: "memory");
    }
}
__device__ __forceinline__ void ln_phase(KArgsPtr a, LAS unsigned char* lds, int tid, int li, bool final_out, int next_sub) {
    const unsigned lane = tid & 63; const int gw = blockIdx.x * 8 + __builtin_amdgcn_readfirstlane(tid >> 6), NGW = gridDim.x * 8;
    const bf16_t* Y = (const bf16_t*)(a->ws + WS_Y); const bf16_t* X1 = (const bf16_t*)(a->ws + WS_X1);
    for (int r0 = gw; r0 < MP; r0 += 4 * NGW) {
        f32x4 v[4][8];
#pragma unroll
        for (int q = 0; q < 4; ++q) { const int row = r0 + q * NGW; if (row < MP) { const u32x2* yr = (const u32x2*)(Y + (size_t)row * DM);
#pragma unroll
            for (int j = 0; j < 8; ++j) { const u32x2 yw = yr[64u * j + lane]; v[q][j] = (f32x4){bflo(yw.x), bfhi(yw.x), bflo(yw.y), bfhi(yw.y)}; } } }
#pragma unroll
        for (int q = 0; q < 4; ++q) { const int row = r0 + q * NGW; if (row < MP) ln_finish(a, v[q], row, lane, li, final_out, next_sub); }
    }
    const int w = __builtin_amdgcn_readfirstlane(tid >> 6);
    LAS float* red = (LAS float*)lds;
    for (int t = blockIdx.x; t < NS; t += gridDim.x) {
        const int row = MP + t; const float coef = (li == 1) ? 1.0f / W_O_SCALE : 0.5f / (W_DN_SCALE * ACT_SCALE);
        const unsigned c = 64u * w + lane;
        const f32x4* xs = (const f32x4*)(a->in[1] + (size_t)t * DM); const u32x2* xsb = (const u32x2*)(X1 + (size_t)row * DM);
        const f32x4* gt = (const f32x4*)(mod_row(a, row, li) + 4096);
        const f32x4* pp = (const f32x4*)((const float*)(a->ws + WS_PART) + (size_t)t * DM);
        const f32x4 sm = (pp[c] + pp[c + 32 * 512]) + (pp[c + 64 * 512] + pp[c + 96 * 512]);
        f32x4 xv; if (li == 0) xv = xs[c]; else { const u32x2 xw = xsb[c]; xv = (f32x4){bflo(xw.x), bfhi(xw.x), bflo(xw.y), bfhi(xw.y)}; }
        f32x4 v = xv * ALPHA + gt[c] * coef * sm;
        const float s = wave_sum((v[0] + v[1]) + (v[2] + v[3]));
        if (lane == 0) red[w] = s;
        __syncthreads();
        const float mean = (((red[0] + red[1]) + (red[2] + red[3])) + ((red[4] + red[5]) + (red[6] + red[7]))) * (1.f / DM);
        v = v - mean;
        const float q = wave_sum((v[0] * v[0] + v[1] * v[1]) + (v[2] * v[2] + v[3] * v[3]));
        if (lane == 0) red[8 + w] = q;
        __syncthreads();
        const float rstd = 1.f / sqrtf((((red[8] + red[9]) + (red[10] + red[11])) + ((red[12] + red[13]) + (red[14] + red[15]))) * (1.f / DM) + LN_EPS);
        const f32x4* g4 = (const f32x4*)(a->in[8] + li * DM); const f32x4* b4 = (const f32x4*)(a->in[9] + li * DM);
        const f32x4 x = v * rstd * g4[c] + b4[c];
        if (final_out) ((f32x4*)(a->out + OFF_YS + (size_t)t * DM))[c] = x;
        else {
            u32x2 xw; xw.x = pk2(x[0], x[1]); xw.y = pk2(x[2], x[3]); ((u32x2*)(a->ws + WS_X1 + (size_t)row * DM * 2))[c] = xw;
            const f32x4* sh = (const f32x4*)mod_row(a, row, next_sub); const f32x4* scl = sh + 512;
            const f32x4 h = x * (scl[c] + 1.f) + sh[c];
            if (next_sub == 2) ((unsigned*)(a->ws + WS_H8 + (size_t)row * DM))[c] = pk4_fp8(h[0], h[1], h[2], h[3]);
            else { u32x2 hw; hw.x = pk2(h[0], h[1]); hw.y = pk2(h[2], h[3]); ((u32x2*)(a->ws + WS_H + (size_t)row * DM * 2))[c] = hw; }
        }
        __syncthreads();
    }
}
__device__ __forceinline__ void merge_phase(KArgsPtr a, int tid) {
    const unsigned lane = tid & 63; const int gw = blockIdx.x * 8 + __builtin_amdgcn_readfirstlane(tid >> 6), NGW = gridDim.x * 8;
    const bf16_t* MIX = (const bf16_t*)(a->ws + WS_MIX); const float* SS = (const float*)(a->ws + WS_SS); unsigned char* H8 = a->ws + WS_H8;
    const float* og = a->in[18];
    for (int r0 = gw; r0 < MP; r0 += 4 * NGW) {
        u32x4 mv[4][4]; float sv[4];
#pragma unroll
        for (int q = 0; q < 4; ++q) { const int row = r0 + q * NGW; if (row < MP) {
            sv[q] = (lane < 24) ? SS[(size_t)row * 24 + lane] : 0.f;
            const u32x4* mr = (const u32x4*)(MIX + (size_t)row * DM);
#pragma unroll
            for (int j = 0; j < 4; ++j) mv[q][j] = mr[64u * j + lane]; } }
#pragma unroll
        for (int q = 0; q < 4; ++q) { const int row = r0 + q * NGW; if (row < MP) {
            float sa = (lane < 16) ? sv[q] : 0.f, sg = (lane >= 16) ? sv[q] : 0.f;
            sa = wave_sum(sa); sg = wave_sum(sg);
            const float ra = 1.f / sqrtf(sa * (1.f / 1024.f) + LN_EPS), rg = 1.f / sqrtf(sg * (1.f / 1024.f) + LN_EPS);
            u32x2* ho = (u32x2*)(H8 + (size_t)row * DM);
#pragma unroll
            for (int j = 0; j < 4; ++j) {
                const unsigned c = 64u * j + lane; const u32x4 m = mv[q][j]; const float r = (j < 2) ? ra : rg;
                const f32x4 g0 = *(const f32x4*)(og + 8 * c), g1 = *(const f32x4*)(og + 8 * c + 4);
                u32x2 o;
                o.x = pk4_fp8(bflo(m.x) * r * g0[0], bfhi(m.x) * r * g0[1], bflo(m.y) * r * g0[2], bfhi(m.y) * r * g0[3]);
                o.y = pk4_fp8(bflo(m.z) * r * g1[0], bfhi(m.z) * r * g1[1], bflo(m.w) * r * g1[2], bfhi(m.w) * r * g1[3]);
                ho[c] = o;
            } } }
    }
    const int w = __builtin_amdgcn_readfirstlane(tid >> 6);
    for (int t = blockIdx.x; t < NS; t += gridDim.x) {
        const int row = MP + t;
        const float sv = (lane < 24) ? SS[(size_t)row * 24 + lane] : 0.f;
        const float sa = wave_sum(lane < 16 ? sv : 0.f), sg = wave_sum(lane >= 16 ? sv : 0.f);
        const float ra = 1.f / sqrtf(sa * (1.f / 1024.f) + LN_EPS), rg = 1.f / sqrtf(sg * (1.f / 1024.f) + LN_EPS);
        if (lane < 32) {
            const unsigned c = 32u * w + lane;
            const u32x4 m = ((const u32x4*)(MIX + (size_t)row * DM))[c]; const float r = (c < 128u) ? ra : rg;
            const f32x4 g0 = *(const f32x4*)(og + 8 * c), g1 = *(const f32x4*)(og + 8 * c + 4);
            u32x2 o;
            o.x = pk4_fp8(bflo(m.x) * r * g0[0], bfhi(m.x) * r * g0[1], bflo(m.y) * r * g0[2], bfhi(m.y) * r * g0[3]);
            o.y = pk4_fp8(bflo(m.z) * r * g1[0], bfhi(m.z) * r * g1[1], bflo(m.w) * r * g1[2], bfhi(m.w) * r * g1[3]);
            ((u32x2*)(H8 + (size_t)row * DM))[c] = o;
        }
    }
}
template <bool FP8  >
__device__ __forceinline__ void small_part(LAS unsigned char* lds, int tid, const void* Av, const void* Btv, int K, float* PART) {
    const int w = __builtin_amdgcn_readfirstlane(tid >> 6), lane = tid & 63, S = K / 16;
    LAS float* part = (LAS float*)lds;
    for (int it = blockIdx.x; it < 256; it += gridDim.x) {
        const int n0 = 32 * (it & 63), kq = it >> 6, sl = kq * 8 + w;
        const int s0 = (sl * S) >> 5, s1 = ((sl + 1) * S) >> 5;
        f32x16 acc;
#pragma unroll
        for (int i = 0; i < 16; ++i) acc[i] = 0.f;
        if constexpr (FP8) {
            const unsigned char* ap = (const unsigned char*)Av + (size_t)(lane & 31) * K + 8 * (lane >> 5);
            const unsigned char* bp = (const unsigned char*)Btv + (size_t)(n0 + (lane & 31)) * K + 8 * (lane >> 5);
            long af[11], bfr[11];
#pragma unroll
            for (int i = 0; i < 11; ++i) { const int st = (s0 + i < s1) ? s0 + i : s0; af[i] = *(const long*)(ap + 16 * st); bfr[i] = *(const long*)(bp + 16 * st); }
#pragma unroll
            for (int i = 0; i < 11; ++i) if (s0 + i < s1) acc = __builtin_amdgcn_mfma_f32_32x32x16_fp8_fp8(af[i], bfr[i], acc, 0, 0, 0);
        } else {
            const bf16_t* ap = (const bf16_t*)Av + (size_t)(lane & 31) * K + 8 * (lane >> 5);
            const bf16_t* bp = (const bf16_t*)Btv + (size_t)(n0 + (lane & 31)) * K + 8 * (lane >> 5);
            bf16x8 af[11], bfr[11];
#pragma unroll
            for (int i = 0; i < 11; ++i) { const int st = (s0 + i < s1) ? s0 + i : s0; af[i] = *(const bf16x8*)(ap + 16 * st); bfr[i] = *(const bf16x8*)(bp + 16 * st); }
#pragma unroll
            for (int i = 0; i < 11; ++i) if (s0 + i < s1) acc = __builtin_amdgcn_mfma_f32_32x32x16_bf16(af[i], bfr[i], acc, 0, 0, 0);
        }
#pragma unroll
        for (int rg = 0; rg < 16; ++rg) { const int i = 8 * (rg >> 2) + 4 * (lane >> 5) + (rg & 3); part[w * 1024 + i * 32 + (lane & 31)] = acc[rg]; }
        __syncthreads();
        for (int e = tid; e < 1024; e += 512) {
            const int t = e >> 5, n = e & 31; float sm = 0.f;
#pragma unroll
            for (int ww = 0; ww < 8; ++ww) sm += part[ww * 1024 + e];
            PART[(size_t)(kq * 32 + t) * DM + n0 + n] = sm;
        }
        __syncthreads();
    }
}
struct AttnRegs { u32x4 kv[4], vv[4]; bf16x8 qf[2]; };
__device__ __forceinline__ void attn_load(KArgsPtr a, int item, int tid, AttnRegs& R) {
    const int h = item & 15, nb = (item >> 4) & 15, b = item >> 8, kvh = h >> 2;
    const bf16_t* Q = (const bf16_t*)(a->ws + WS_Q); const bf16_t* Kb = (const bf16_t*)(a->ws + WS_K); const bf16_t* Vb = (const bf16_t*)(a->ws + WS_V);
    const int w = __builtin_amdgcn_readfirstlane(tid >> 6), lane = tid & 63, fr = lane & 15, fq = lane >> 4;
    const unsigned qrow = b * SEQ + nb * 128 + 16 * w + fr;
#pragma unroll
    for (int ks = 0; ks < 2; ++ks) R.qf[ks] = *(const bf16x8*)(Q + qrow * 1024u + h * 64 + ks * 32 + 8 * fq);
    const int rowk0 = b * SEQ + (nb - 1) * 128;
#pragma unroll
    for (int i = 0; i < 4; ++i) {
        const int ch = tid + 512 * i, c = ch >> 3, part = ch & 7;
        R.kv[i] = (u32x4){0u, 0u, 0u, 0u}; R.vv[i] = (u32x4){0u, 0u, 0u, 0u};
        if (nb > 0 || c >= 128) { const unsigned off = (unsigned)(rowk0 + c) * 256u + kvh * 64 + part * 8; R.kv[i] = *(const u32x4*)(Kb + off); R.vv[i] = *(const u32x4*)(Vb + off); }
    }
}
__device__ __forceinline__ void attn_stage(LAS unsigned char* lds, int tid, const AttnRegs& R) {
    LAS bf16_t* Kl = (LAS bf16_t*)lds; LAS bf16_t* Vl = Kl + 256 * 72;
#pragma unroll
    for (int i = 0; i < 4; ++i) { const int ch = tid + 512 * i, c = ch >> 3, part = ch & 7; *(LAS u32x4*)(Kl + c * 72 + part * 8) = R.kv[i]; *(LAS u32x4*)(Vl + c * 72 + part * 8) = R.vv[i]; }
}
__device__ __forceinline__ void attn_compute(KArgsPtr a, LAS unsigned char* lds, int item, int tid, const bf16x8 (&qf)[2]) {
    const int h = item & 15, nb = (item >> 4) & 15, b = item >> 8;
    bf16_t* MIX = (bf16_t*)(a->ws + WS_MIX); float* SS = (float*)(a->ws + WS_SS);
    LAS bf16_t* Kl = (LAS bf16_t*)lds; LAS bf16_t* Vl = Kl + 256 * 72;
    const int w = __builtin_amdgcn_readfirstlane(tid >> 6), lane = tid & 63, fr = lane & 15, fq = lane >> 4;
    const size_t qrow = (size_t)b * SEQ + nb * 128 + 16 * w + fr;
    f32x4 s[9];
#pragma unroll
    for (int t = 0; t < 9; ++t) {
        s[t] = (f32x4){0.f, 0.f, 0.f, 0.f};
#pragma unroll
        for (int ks = 0; ks < 2; ++ks) { const bf16x8 kf = *(const LAS bf16x8*)(Kl + (16 * (w + t) + fr) * 72 + ks * 32 + 8 * fq); s[t] = MFMA16(kf, qf[ks], s[t]); }
    }
    const float sink = a->in[13][h];
    float mx = sink;
#pragma unroll
    for (int t = 0; t < 9; ++t)
#pragma unroll
        for (int rg = 0; rg < 4; ++rg) {
            bool valid = (nb > 0) || (w + t >= 8);
            if (t == 0) valid = valid && (4 * fq + rg > fr);
            if (t == 8) valid = valid && (4 * fq + rg <= fr);
            const float v = valid ? s[t][rg] : -INFINITY; s[t][rg] = v; mx = fmaxf(mx, v);
        }
    mx = fmaxf(mx, __shfl_xor(mx, 16)); mx = fmaxf(mx, __shfl_xor(mx, 32));
    float sum = 0.f;
#pragma unroll
    for (int t = 0; t < 9; ++t)
#pragma unroll
        for (int rg = 0; rg < 4; ++rg) { const float p = __expf(s[t][rg] - mx); s[t][rg] = p; sum += p; }
    sum += __shfl_xor(sum, 16); sum += __shfl_xor(sum, 32);
    const float inv = 1.f / (sum + __expf(sink - mx));
    f32x4 o[4];
#pragma unroll
    for (int dt = 0; dt < 4; ++dt) o[dt] = (f32x4){0.f, 0.f, 0.f, 0.f};
#pragma unroll
    for (int st = 0; st < 5; ++st) {
        u32x4 pw; pw.x = pk2(s[2 * st][0], s[2 * st][1]); pw.y = pk2(s[2 * st][2], s[2 * st][3]);
        if (st < 4) { pw.z = pk2(s[2 * st + 1][0], s[2 * st + 1][1]); pw.w = pk2(s[2 * st + 1][2], s[2 * st + 1][3]); } else { pw.z = 0u; pw.w = 0u; }
        const bf16x8 pf = __builtin_bit_cast(bf16x8, pw);
        const int ca = 16 * (w + 2 * st) + 4 * fq, cb = ca + 16;
#pragma unroll
        for (int dt = 0; dt < 4; ++dt) {
            const LAS bf16_t* vp = Vl + 16 * dt + fr;
            u32x4 vw;
            vw.x = (unsigned)vp[(ca + 0) * 72] | ((unsigned)vp[(ca + 1) * 72] << 16); vw.y = (unsigned)vp[(ca + 2) * 72] | ((unsigned)vp[(ca + 3) * 72] << 16);
            if (st < 4) { vw.z = (unsigned)vp[(cb + 0) * 72] | ((unsigned)vp[(cb + 1) * 72] << 16); vw.w = (unsigned)vp[(cb + 2) * 72] | ((unsigned)vp[(cb + 3) * 72] << 16); } else { vw.z = 0u; vw.w = 0u; }
            o[dt] = MFMA16(__builtin_bit_cast(bf16x8, vw), pf, o[dt]);
        }
    }
    float ssq = 0.f;
#pragma unroll
    for (int dt = 0; dt < 4; ++dt) {
        const f32x4 v = o[dt] * inv; ssq += (v[0] * v[0] + v[1] * v[1]) + (v[2] * v[2] + v[3] * v[3]);
        u32x2 wv; wv.x = pk2(v[0], v[1]); wv.y = pk2(v[2], v[3]);
        *(u32x2*)(MIX + qrow * DM + h * 64 + 16 * dt + 4 * fq) = wv;
    }
    ssq += __shfl_xor(ssq, 16); ssq += __shfl_xor(ssq, 32);
    if (fq == 0) SS[qrow * 24 + h] = ssq;
}
__device__ __forceinline__ void gmlp_item(KArgsPtr a, LAS unsigned char* lds, int item, int tid) {
    const int g = item & 7, ch = (item >> 3) & 15, b = item >> 7; const size_t r0 = (size_t)b * SEQ + ch * 128;
    const bf16_t* GV = (const bf16_t*)(a->ws + WS_GV); const bf16_t* U = (const bf16_t*)(a->ws + WS_U);
    bf16_t* MIX = (bf16_t*)(a->ws + WS_MIX); float* SS = (float*)(a->ws + WS_SS);
    LAS bf16_t* vT = (LAS bf16_t*)lds;
    const int w = __builtin_amdgcn_readfirstlane(tid >> 6), lane = tid & 63, fr = lane & 15, fq = lane >> 4;
    const int irow = 16 * w + fr;
    const int nks = (16 * w + 15) / 32 + 1;
    const float* Wrow = a->in[16] + ((size_t)g * 128 + irow) * 128;
    f32x4 wq[4][2];
#pragma unroll
    for (int ks = 0; ks < 4; ++ks) if (ks < nks) { wq[ks][0] = *(const f32x4*)(Wrow + ks * 32 + 8 * fq); wq[ks][1] = *(const f32x4*)(Wrow + ks * 32 + 8 * fq + 4); }
    const size_t row = r0 + irow;
    u32x2 uw[8];
#pragma unroll
    for (int ct = 0; ct < 8; ++ct) uw[ct] = *(const u32x2*)(U + row * 1024 + g * 128 + 16 * ct + 4 * fq);
    const float bsp = a->in[17][g * 128 + irow];
    {
        const int p = tid >> 2, qd = tid & 3;
        const u32x4* src = (const u32x4*)(GV + (r0 + p) * 1024 + g * 128 + 32 * qd);
        float x[32];
#pragma unroll
        for (int i = 0; i < 4; ++i) { const u32x4 rw = src[i];
            x[8 * i + 0] = bflo(rw.x); x[8 * i + 1] = bfhi(rw.x); x[8 * i + 2] = bflo(rw.y); x[8 * i + 3] = bfhi(rw.y);
            x[8 * i + 4] = bflo(rw.z); x[8 * i + 5] = bfhi(rw.z); x[8 * i + 6] = bflo(rw.w); x[8 * i + 7] = bfhi(rw.w); }
        float s = 0.f;
#pragma unroll
        for (int i = 0; i < 32; ++i) s += x[i];
        s += __shfl_xor(s, 1); s += __shfl_xor(s, 2);
        const float mean = s * (1.f / 128.f); float q = 0.f;
#pragma unroll
        for (int i = 0; i < 32; ++i) { x[i] -= mean; q += x[i] * x[i]; }
        q += __shfl_xor(q, 1); q += __shfl_xor(q, 2);
        const float rstd = 1.f / sqrtf(q * (1.f / 128.f) + LN_EPS);
        const float* gg = a->in[14] + g * 128 + 32 * qd; const float* gb = a->in[15] + g * 128 + 32 * qd;
#pragma unroll
        for (int i = 0; i < 32; i += 2) {
            const unsigned pr = pk2(x[i] * rstd * gg[i] + gb[i], x[i + 1] * rstd * gg[i + 1] + gb[i + 1]);
            vT[(32 * qd + i) * 136 + p] = (bf16_t)(pr & 0xffffu); vT[(32 * qd + i + 1) * 136 + p] = (bf16_t)(pr >> 16);
        }
    }
    __syncthreads();
    f32x4 acc[8];
#pragma unroll
    for (int ct = 0; ct < 8; ++ct) acc[ct] = (f32x4){0.f, 0.f, 0.f, 0.f};
#pragma unroll
    for (int ks = 0; ks < 4; ++ks) if (ks < nks) {
        const int j0 = ks * 32 + 8 * fq;
        const f32x4 w0 = wq[ks][0], w1 = wq[ks][1];
        const bf16x8 wf = pack8(j0 + 0 <= irow ? w0[0] : 0.f, j0 + 1 <= irow ? w0[1] : 0.f, j0 + 2 <= irow ? w0[2] : 0.f, j0 + 3 <= irow ? w0[3] : 0.f,
                                j0 + 4 <= irow ? w1[0] : 0.f, j0 + 5 <= irow ? w1[1] : 0.f, j0 + 6 <= irow ? w1[2] : 0.f, j0 + 7 <= irow ? w1[3] : 0.f);
#pragma unroll
        for (int ct = 0; ct < 8; ++ct) { const bf16x8 vf = *(const LAS bf16x8*)(vT + (16 * ct + fr) * 136 + ks * 32 + 8 * fq); acc[ct] = MFMA16(vf, wf, acc[ct]); }
    }
    float ssq = 0.f;
#pragma unroll
    for (int ct = 0; ct < 8; ++ct) {
        const float o0 = bflo(uw[ct].x) * (acc[ct][0] + bsp), o1 = bfhi(uw[ct].x) * (acc[ct][1] + bsp), o2 = bflo(uw[ct].y) * (acc[ct][2] + bsp), o3 = bfhi(uw[ct].y) * (acc[ct][3] + bsp);
        ssq += (o0 * o0 + o1 * o1) + (o2 * o2 + o3 * o3);
        u32x2 wv; wv.x = pk2(o0, o1); wv.y = pk2(o2, o3);
        *(u32x2*)(MIX + row * DM + 1024 + g * 128 + 16 * ct + 4 * fq) = wv;
    }
    ssq += __shfl_xor(ssq, 16); ssq += __shfl_xor(ssq, 32);
    if (fq == 0) SS[row * 24 + 16 + g] = ssq;
    __syncthreads();
}
__device__ __forceinline__ void sattn_wave(KArgsPtr a, LAS float* wl, int si, int lane) {
    const int bs = si >> 4, h = si & 15, kvh = h >> 2; const size_t row = MP + bs;
    const bf16_t* Q = (const bf16_t*)(a->ws + WS_Q); const bf16_t* Kb = (const bf16_t*)(a->ws + WS_K); const bf16_t* Vb = (const bf16_t*)(a->ws + WS_V);
    bf16_t* MIX = (bf16_t*)(a->ws + WS_MIX); float* SS = (float*)(a->ws + WS_SS);
    LAS float* ql = wl; LAS float* pl = wl + 64;
    const float qv = bf2f(Q[row * 1024 + h * 64 + lane]);
    ql[lane] = qv;
    const float dotnew = wave_sum(qv * bf2f(Kb[row * 256 + kvh * 64 + lane]));
    const float* ck = a->in[2] + (size_t)bs * 128 * 256 + kvh * 64; const float* cv = a->in[3] + (size_t)bs * 128 * 256 + kvh * 64;
    const int j0 = lane + 1, j1 = (lane + 65 < 128) ? (lane + 65) : 127;
    float s0 = 0.f, s1 = 0.f;
#pragma unroll
    for (int hf = 0; hf < 2; ++hf) {
        f32x4 k0[8], k1[8];
#pragma unroll
        for (int d4 = 0; d4 < 8; ++d4) { k0[d4] = *(const f32x4*)(ck + (size_t)j0 * 256 + 32 * hf + 4 * d4); k1[d4] = *(const f32x4*)(ck + (size_t)j1 * 256 + 32 * hf + 4 * d4); }
#pragma unroll
        for (int d4 = 0; d4 < 8; ++d4) {
            const f32x4 qq = *(const LAS f32x4*)(ql + 32 * hf + 4 * d4);
            s0 += (qq[0] * k0[d4][0] + qq[1] * k0[d4][1]) + (qq[2] * k0[d4][2] + qq[3] * k0[d4][3]);
            s1 += (qq[0] * k1[d4][0] + qq[1] * k1[d4][1]) + (qq[2] * k1[d4][2] + qq[3] * k1[d4][3]);
        }
    }
    if (lane == 63) s1 = dotnew;
    const float sink = a->in[13][h];
    const float mx = fmaxf(wave_max(fmaxf(s0, s1)), sink);
    const float p0 = __expf(s0 - mx), p1 = __expf(s1 - mx);
    const float denom = wave_sum(p0 + p1) + __expf(sink - mx);
    pl[lane] = p0; pl[lane + 64] = p1;
    float o = 0.f;
    const float vnew = bf2f(Vb[row * 256 + kvh * 64 + lane]);
    for (int jb = 0; jb < 128; jb += 32) {
        float vv[32];
#pragma unroll
        for (int u = 0; u < 32; ++u) { const int j = jb + u; vv[u] = cv[(size_t)(j < 127 ? j + 1 : 127) * 256 + lane]; }
#pragma unroll
        for (int u = 0; u < 32; ++u) { const int j = jb + u; o += pl[j] * (j < 127 ? vv[u] : vnew); }
    }
    o = o / denom;
    const unsigned pr = pk2(o, 0.f);
    MIX[row * DM + h * 64 + lane] = (bf16_t)(pr & 0xffffu);
    const float ss = wave_sum(o * o);
    if (lane == 0) SS[row * 24 + h] = ss;
}
__device__ __forceinline__ void sgmlp_wave(KArgsPtr a, int bs, int lane) {
    const size_t row = MP + bs;
    const bf16_t* GV = (const bf16_t*)(a->ws + WS_GV); const bf16_t* U = (const bf16_t*)(a->ws + WS_U);
    bf16_t* MIX = (bf16_t*)(a->ws + WS_MIX); float* SS = (float*)(a->ws + WS_SS);
    unsigned gwv[8], uwv[8]; float gn0[8], gn1[8], gb0[8], gb1[8], wsv[8], bsv[8], og0[8], og1[8];
#pragma unroll
    for (int g = 0; g < 8; ++g) {
        const int c = g * 128 + 2 * lane;
        gwv[g] = *(const unsigned*)(GV + row * 1024 + c); uwv[g] = *(const unsigned*)(U + row * 1024 + c);
        gn0[g] = a->in[14][c]; gn1[g] = a->in[14][c + 1]; gb0[g] = a->in[15][c]; gb1[g] = a->in[15][c + 1];
        wsv[g] = a->in[16][(size_t)g * 128 * 128]; bsv[g] = a->in[17][g * 128];
    }
#pragma unroll
    for (int g = 0; g < 8; ++g) {
        const int c = g * 128 + 2 * lane;
        float x0 = bflo(gwv[g]), x1 = bfhi(gwv[g]);
        const float mean = wave_sum(x0 + x1) * (1.f / 128.f); x0 -= mean; x1 -= mean;
        const float rstd = 1.f / sqrtf(wave_sum(x0 * x0 + x1 * x1) * (1.f / 128.f) + LN_EPS);
        const float v0 = x0 * rstd * gn0[g] + gb0[g], v1 = x1 * rstd * gn1[g] + gb1[g];
        a->out[OFF_GVS + (size_t)bs * 1024 + c] = v0; a->out[OFF_GVS + (size_t)bs * 1024 + c + 1] = v1;
        const float o0 = bflo(uwv[g]) * (wsv[g] * v0 + bsv[g]), o1 = bfhi(uwv[g]) * (wsv[g] * v1 + bsv[g]);
        *(unsigned*)(MIX + row * DM + 1024 + c) = pk2(o0, o1);
        const float ss = wave_sum(o0 * o0 + o1 * o1);
        if (lane == 0) SS[row * 24 + 16 + g] = ss;
    }
}
__device__ __forceinline__ void mix_phase(KArgsPtr a, LAS unsigned char* lds, int tid) {
    const int NA = 1024, NG = 512, NSA = 64, NSG = 4, NTOT = NA + NG + NSA + NSG;
    const int w = __builtin_amdgcn_readfirstlane(tid >> 6), lane = tid & 63;
    int it = blockIdx.x;
    {
        AttnRegs R, Rn;
        if (it < NA) attn_load(a, it, tid, R);
        while (it < NA) {
            attn_stage(lds, tid, R);
            __syncthreads();
            const int itn = it + gridDim.x;
            if (itn < NA) attn_load(a, itn, tid, Rn);
            attn_compute(a, lds, it, tid, R.qf);
            __syncthreads();
            R = Rn; it = itn;
        }
    }
    for (; it < NTOT; it += gridDim.x) {
        if (it < NA + NG) gmlp_item(a, lds, it - NA, tid);
        else if (it < NA + NG + NSA) sattn_wave(a, (LAS float*)(lds + w * 1024), (it - NA - NG) * 8 + w, lane);
        else sgmlp_wave(a, (it - NA - NG - NSA) * 8 + w, lane);
    }
}

#define XB_TMO      128
#define XB_XCNT(j)  (256  + 64 * (j))
#define XB_XSUB(j)  (1280 + 64 * (j))
#define XB_XGEN(j)  (2304 + 64 * (j))
#define XB_TOP      3328
#define XB_TOPGEN   3392
#define XCD_BAR_WORDS 3456
#define XB_SPIN_CAP (1u << 18)

__device__ __forceinline__ unsigned xb_ld(unsigned* p)              { return __hip_atomic_load(p, __ATOMIC_RELAXED, __HIP_MEMORY_SCOPE_AGENT); }
__device__ __forceinline__ unsigned xb_add(unsigned* p, unsigned v) { return __hip_atomic_fetch_add(p, v, __ATOMIC_RELAXED, __HIP_MEMORY_SCOPE_AGENT); }
__device__ __forceinline__ unsigned xb_xcc_id() { return (unsigned)__builtin_amdgcn_s_getreg((3 << 11) | 20) & 0xFu; }
#define XB_SPIN(cond, bar) do { unsigned _sp = 0; while (cond) { __builtin_amdgcn_s_sleep(1); \
    if ((++_sp & 255u) == 0u) { if (xb_ld(&(bar)[XB_TMO])) break; if (_sp > XB_SPIN_CAP) { atomicAdd(&(bar)[XB_TMO], 1u); break; } } } } while (0)

struct XcdBarrier {
    unsigned* bar; unsigned x;
    volatile LAS unsigned* st;
};

__device__ __forceinline__ XcdBarrier xcd_barrier_post(unsigned* bar, volatile LAS unsigned* st) {
    XcdBarrier b; b.bar = bar; b.x = xb_xcc_id(); b.st = st;
    if (threadIdx.x == 0) (void)xb_add(&bar[XB_XCNT(b.x)], 1u);
    return b;
}
__device__ __forceinline__ void xcd_barrier_complete(unsigned* bar, unsigned x, unsigned& nloc, unsigned& nx) {
    const unsigned G = gridDim.x * gridDim.y * gridDim.z;
    unsigned sum, cnt, mine, sp = 0u;
    for (;;) {
        sum = 0u; cnt = 0u; mine = 0u;
#pragma unroll
        for (unsigned j = 0; j < 16; ++j) { const unsigned c = xb_ld(&bar[XB_XCNT(j)]); sum += c; cnt += (c > 0u) ? 1u : 0u; mine = (j == x) ? c : mine; }
        if (sum == G) break;
        __builtin_amdgcn_s_sleep(1);
        if ((++sp & 255u) == 0u) { if (xb_ld(&bar[XB_TMO])) break; if (sp > XB_SPIN_CAP) { atomicAdd(&bar[XB_TMO], 1u); break; } }
    }
    nloc = mine > 0u ? mine : 1u; nx = cnt > 0u ? cnt : 1u;
}

__device__ __forceinline__ void xcd_barrier(const XcdBarrier& b) {
    asm volatile("s_waitcnt vmcnt(0)" ::: "memory");
    __syncthreads();
    if (threadIdx.x == 0) {
        unsigned* bar = b.bar;
        __builtin_amdgcn_s_waitcnt(0);
        unsigned nloc = b.st[0], nx = b.st[1];
        if (nloc == 0u) { xcd_barrier_complete(bar, b.x, nloc, nx); b.st[0] = nloc; b.st[1] = nx; }
        const unsigned old = xb_add(&bar[XB_XSUB(b.x)], 1u);
        const unsigned gen = old / nloc;
        if (old + 1u == (gen + 1u) * nloc) {
            __builtin_amdgcn_fence(__ATOMIC_RELEASE, "agent");
            asm volatile("s_waitcnt vmcnt(0)" ::: "memory");
            const unsigned og = xb_add(&bar[XB_TOP], 1u);
            const unsigned tg = og / nx;
            if (og + 1u == (tg + 1u) * nx) xb_add(&bar[XB_TOPGEN], 1u);
            else XB_SPIN(xb_ld(&bar[XB_TOPGEN]) == tg, bar);
            __builtin_amdgcn_fence(__ATOMIC_ACQUIRE, "agent");
            xb_add(&bar[XB_XGEN(b.x)], 1u);
            asm volatile("s_waitcnt vmcnt(0)" ::: "memory");
        } else {
            XB_SPIN(xb_ld(&bar[XB_XGEN(b.x)]) == gen, bar);
            __builtin_amdgcn_fence(__ATOMIC_ACQUIRE, "agent");
            asm volatile("s_waitcnt vmcnt(0)" ::: "memory");
        }
    }
    __syncthreads();
}

__device__ __forceinline__ int fresh_tid() { int t = threadIdx.x; asm volatile("" : "+v"(t)); return t; }
__device__ __forceinline__ KArgsPtr load_args() { KArgsPtr p = (KArgsPtr)__builtin_amdgcn_kernarg_segment_ptr(); asm volatile("" : "+s"(p)); return p; }
#define LA load_args()
__global__ void __launch_bounds__(512, 2) fwd(Args kernarg_only) {
    extern __shared__ __attribute__((aligned(16))) unsigned char lds_raw[];
    LAS unsigned char* lds = (LAS unsigned char*)lds_raw;
    cg::grid_group grid = cg::this_grid();
    volatile LAS unsigned* MISC = (volatile LAS unsigned*)(lds + 131072 + 320);
    if (threadIdx.x < 32) MISC[threadIdx.x] = 0u;
    __syncthreads();
    XcdBarrier xbar = xcd_barrier_post((unsigned*)(LA->ws + WS_CTL) + 4096, MISC + 8);
    if (gridDim.x == 0x7fffffffu) grid.sync();
#define GRID_SYNC() xcd_barrier(xbar)
    const int G = gridDim.x, c = blockIdx.x;
#define tid fresh_tid()
#define mod ((float*)(LA->ws + WS_MOD))
#define WUP ((bf16_t*)(LA->ws + WS_WUP))
#define WDN ((bf16_t*)(LA->ws + WS_WDN))
#define WIN ((bf16_t*)(LA->ws + WS_WIN))
#define WO ((bf16_t*)(LA->ws + WS_WO))
#define H ((bf16_t*)(LA->ws + WS_H))
#define ACT ((bf16_t*)(LA->ws + WS_ACT))
#define Y ((bf16_t*)(LA->ws + WS_Y))
#define PARTP ((float*)(LA->ws + WS_PART))
#define X1 ((bf16_t*)(LA->ws + WS_X1))

#ifndef NO_P0
    for (int rep = 0; rep <= DUP_P0; ++rep) { p0_phase(LA, lds, tid, rep); if (rep < DUP_P0) GRID_SYNC(); }
#endif
    GRID_SYNC();
#ifndef NO_ROW
    h0_phase(LA, tid);
#if DUP_ROW
    GRID_SYNC();
    h0_phase(LA, tid);
#endif
#endif
    GRID_SYNC();
#define UP_PHASE(l) { pg8::Gemm g{(const bf16_t*)(LA->ws + WS_H8), (const bf16_t*)(LA->ws + WS_WUP + (size_t)(l) * WUP_ELEMS), MPAD, NUP, DM / 2}; pg8::StaticOrder S; S.init(MPAD, NUP, G, c); EpiSwiGLU E{LA->ws + WS_ACT}; \
      pg8::gemm_phase<EpiSwiGLU, pg8::StaticOrder, true, true, true>(lds, g, S, E);       \
      { const int rem = ((MPAD / 256) * (NUP / 256)) % G; if (rem != 0 && c >= rem) tr_deferred(LA, lds, tid, 2 * I_UP + (l) * I_DN, I_DN, c - rem, G - rem); else if (rem == 0) tr_deferred(LA, lds, tid, 2 * I_UP + (l) * I_DN, I_DN, c, G); } }
#define DOWN_PHASE(l, sub, xres, XB) { pg8::Gemm g{(const bf16_t*)(LA->ws + WS_ACT), (const bf16_t*)(LA->ws + WS_WDN + (size_t)(l) * WDN8_BYTES), MP, DM, DFFP / 2}; pg8::StaticOrder S; S.init(MP, DM, G, c); \
      EpiResid<XB> E{xres, Y, mod + (sub) * 6144 + 4096, 0.5f / (W_DN_SCALE * ACT_SCALE)}; \
      small_part<true>(lds, tid, LA->ws + WS_ACT + (size_t)MP * DFFP, LA->ws + WS_WDN + (size_t)(l) * WDN8_BYTES, DFFP, PARTP); \
      pg8::gemm_phase<EpiResid<XB>, pg8::StaticOrder, true, true, true>(lds, g, S, E); }
#ifndef NO_UP
    UP_PHASE(0)
#if DUP_UP
    GRID_SYNC();
    UP_PHASE(0)
#endif
#endif
    GRID_SYNC();
#ifndef NO_DN
    DOWN_PHASE(0, 0, LA->in[0], false)
#if DUP_DN
    GRID_SYNC();
    DOWN_PHASE(0, 0, LA->in[0], false)
#endif
#endif
    GRID_SYNC();
#ifndef NO_ROW
    ln_phase(LA, lds, tid, 0, false, 1);
#if DUP_ROW
    GRID_SYNC();
    ln_phase(LA, lds, tid, 0, false, 1);
#endif
#endif
    GRID_SYNC();
    { pg8::Gemm g{H, WIN, MPAD, INW, DM}; pg8::StaticOrder S; S.init(MPAD, INW, G, c);
      EpiInProj E{(bf16_t*)(LA->ws + WS_Q), (bf16_t*)(LA->ws + WS_K), (bf16_t*)(LA->ws + WS_V), (bf16_t*)(LA->ws + WS_U), (bf16_t*)(LA->ws + WS_GV), (const float*)(LA->ws + WS_ROPE), LA->out};

#ifndef NO_IN
      pg8::gemm_phase<EpiInProj, pg8::StaticOrder, true, true>(lds, g, S, E);
#endif
      { const int rem = ((MPAD / 256) * (INW / 256)) % G; const int bi_ = rem != 0 ? c - rem : c, nb_ = rem != 0 ? G - rem : G;
        if (rem == 0 || c >= rem) { tr_deferred(LA, lds, tid, 2 * I_UP + 2 * I_DN + I_IN, I_WO, bi_, nb_); tr_deferred(LA, lds, tid, 2 * I_UP - N_UP1_DEF, N_UP1_DEF, bi_, nb_); } }
    }
    GRID_SYNC();
#ifndef NO_MIX
    mix_phase(LA, lds, tid);
#if DUP_MIX
    GRID_SYNC();
    mix_phase(LA, lds, tid);
#endif
#endif
    GRID_SYNC();
#ifndef NO_ROW
    merge_phase(LA, tid);
#if DUP_ROW
    GRID_SYNC();
    merge_phase(LA, tid);
#endif
#endif
    GRID_SYNC();
#ifndef NO_WO
    { pg8::Gemm g{(const bf16_t*)(LA->ws + WS_H8), (const bf16_t*)(LA->ws + WS_WO), MP, DM, DM / 2}; pg8::StaticOrder S; S.init(MP, DM, G, c); EpiResid<true> E{X1, Y, mod + 1 * 6144 + 4096, 1.0f / W_O_SCALE};
      small_part<true>(lds, tid, LA->ws + WS_H8 + (size_t)MP * DM, LA->ws + WS_WO, DM, PARTP);
      pg8::gemm_phase<EpiResid<true>, pg8::StaticOrder, true, true, true>(lds, g, S, E); }
#endif
    GRID_SYNC();
#ifndef NO_ROW
    ln_phase(LA, lds, tid, 1, false, 2);
#endif
    GRID_SYNC();
#ifndef NO_UP
    UP_PHASE(1)
#if DUP_UP
    GRID_SYNC();
    UP_PHASE(1)
#endif
#endif
    GRID_SYNC();
#ifndef NO_DN
    DOWN_PHASE(1, 2, X1, true)
#if DUP_DN
    GRID_SYNC();
    DOWN_PHASE(1, 2, X1, true)
#endif
#endif
    GRID_SYNC();
#ifndef DUP_SYNC
#define DUP_SYNC 0
#endif
    for (int i = 0; i < DUP_SYNC; ++i) GRID_SYNC();
    ln_phase(LA, lds, tid, 2, true, 0);
#if DUP_ROW
    GRID_SYNC();
    ln_phase(LA, lds, tid, 2, true, 0);
#endif
#undef tid
#undef mod
#undef WUP
#undef WDN
#undef WIN
#undef WO
#undef H
#undef ACT
#undef Y
#undef X1
}

extern "C" void kernel_launch(void* const* d_in, const int* in_sizes, int n_in, void* d_out, int out_size, void* d_ws, size_t ws_size, hipStream_t stream) {
    static int grid = 0;
    if (grid == 0) {
        if (n_in != 20 || ws_size < WS_END) { fprintf(stderr, "kernel_launch: unexpected n_in %d / ws %zu\n", n_in, ws_size); grid = -1; return; }
        int dev = 0, cus = 0, per_cu = 0;
        if (hipGetDevice(&dev) != hipSuccess || hipDeviceGetAttribute(&cus, hipDeviceAttributeMultiprocessorCount, dev) != hipSuccess) { grid = -1; return; }
        if (hipFuncSetAttribute((const void*)fwd, hipFuncAttributeMaxDynamicSharedMemorySize, LDS_BYTES) != hipSuccess) { fprintf(stderr, "kernel_launch: hipFuncSetAttribute failed\n"); grid = -1; return; }
        if (hipOccupancyMaxActiveBlocksPerMultiprocessor(&per_cu, (const void*)fwd, 512, LDS_BYTES) != hipSuccess || per_cu < 1) { fprintf(stderr, "kernel_launch: occupancy query says %d\n", per_cu); }
        (void)hipGetLastError();
        grid = cus;
    }
    if (grid < 0) return;
    (void)hipMemsetAsync((char*)d_ws + WS_CTL, 0, 65536, stream);
    Args a{};
    for (int i = 0; i < 20; ++i) a.in[i] = (const float*)d_in[i];
    a.out = (float*)d_out; a.ws = (unsigned char*)d_ws;
    void* args[] = {&a};
    hipError_t e = hipLaunchCooperativeKernel((const void*)fwd, dim3(grid), dim3(512), args, LDS_BYTES, stream);
    if (e != hipSuccess) fprintf(stderr, "kernel_launch: cooperative launch failed: %s (grid %d)\n", hipGetErrorString(e), grid);
}
```

```cpp
#include <hip/hip_runtime.h>
#include <hip/hip_cooperative_groups.h>
#include <cstdio>
#include <cstdint>
namespace cg = cooperative_groups;
#ifndef DUP_P0
#define DUP_P0 0
#endif
#ifndef DUP_UP
#define DUP_UP 0
#endif
#ifndef DUP_DN
#define DUP_DN 0
#endif
#ifndef DUP_MIX
#define DUP_MIX 0
#endif
#ifndef DUP_IN
#define DUP_IN 0
#endif
#ifndef DUP_WO
#define DUP_WO 0
#endif
#ifndef DUP_ROW
#define DUP_ROW 0
#endif
namespace pg8 {
#define PG8_LAS __attribute__((address_space(3)))
typedef unsigned short bf16_t;
typedef short bf16x8 __attribute__((ext_vector_type(8)));
typedef float f32x4 __attribute__((ext_vector_type(4)));
typedef unsigned u32x4 __attribute__((ext_vector_type(4)));
constexpr int BM = 256, BK = 64, HALF = 128, HTB = HALF * BK * 2  , STAGE_BYTES = 8 * HTB, NXCD = 8, WGM = 8;

__host__ __device__ __forceinline__ int lds_byte(int r, int c) { const int st = (r >> 4) * 2 + (c >> 5), rr = r & 15, cc = c & 31, ob = rr * 64 + cc * 2; return st * 1024 + (ob ^ (((ob >> 9) & 1) << 5)); }
__host__ __device__ __forceinline__ void stage_rc(int b, int& R, int& C) { const int st = b / 1024, sb = b % 1024, swz = sb ^ (((sb >> 9) & 1) << 5); R = (st >> 1) * 16 + swz / 64; C = (st & 1) * 32 + (swz % 64) / 2; }
__host__ __device__ __forceinline__ int perm32(int rho) { const int n = rho >> 4, i = rho & 15; return 8 * (i >> 2) + 4 * n + (i & 3); }

struct Unit { int pm, pn; };
struct Gemm { const bf16_t* A; const bf16_t* Bt; int M, N, K; };

struct StaticOrder {
    int nM, nN, nwg, G, c;
    __host__ __device__ void init(int M, int N, int G_, int c_) { nM = M / BM; nN = N / BM; nwg = nM * nN; G = G_; c = c_; }
    __host__ __device__ bool next(int i, Unit& u) const {
        const long L = (long)i * G + c; if (L >= nwg) return false;
        int wgid = (int)L; { const int q = nwg / NXCD, r = nwg % NXCD, xcd = wgid % NXCD, off = wgid / NXCD; wgid = (xcd < r ? xcd * (q + 1) : r * (q + 1) + (xcd - r) * q) + off; }
        const int nig = WGM * nN, gid = wgid / nig, fm = gid * WGM, gsz = (nM - fm) < WGM ? (nM - fm) : WGM;
        u.pm = fm + ((wgid % nig) % gsz); u.pn = (wgid % nig) / gsz; return true;
    }
    __device__ __forceinline__ void a_ready(const Unit&) const {}
    __device__ __forceinline__ void done(const Unit&) const {}
};

__device__ __forceinline__ unsigned cvt_pk_bf16(float lo, float hi) { unsigned r; asm volatile("v_cvt_pk_bf16_f32 %0, %1, %2" : "=v"(r) : "v"(lo), "v"(hi)); return r; }
typedef int i32x4v __attribute__((ext_vector_type(4)));
typedef int i32x8v __attribute__((ext_vector_type(8)));
__device__ __forceinline__ f32x4 mma_fp8(const bf16x8 (&a)[2], const bf16x8 (&b)[2], f32x4 c) {
    const i32x8v A = __builtin_shufflevector(__builtin_bit_cast(i32x4v, a[0]), __builtin_bit_cast(i32x4v, a[1]), 0, 1, 2, 3, 4, 5, 6, 7);
    const i32x8v B = __builtin_shufflevector(__builtin_bit_cast(i32x4v, b[0]), __builtin_bit_cast(i32x4v, b[1]), 0, 1, 2, 3, 4, 5, 6, 7);
    asm volatile("v_mfma_f32_16x16x128_f8f6f4 %0, %1, %2, %0" : "+v"(c) : "v"(A), "v"(B));
    return c;
}
template <class Epi, class Sched, bool ALIGN_EPI = false, bool SP2 = false, bool FP8 = false>
__device__ __forceinline__ void gemm_phase(PG8_LAS unsigned char* lds, const Gemm g, const Sched& S, const Epi& E) {
    int tid_ = threadIdx.x; asm volatile("" : "+v"(tid_));
    const int tid = tid_, wid = __builtin_amdgcn_readfirstlane(tid >> 6), lane = tid & 63, wr = wid >> 2, wc = wid & 3, fr = lane & 15, fq = lane >> 4;
    const int K = g.K, nt = K / BK;
    unsigned voffA[2], voffB[2];
#pragma unroll
    for (int i = 0; i < 2; ++i) { int R, C; stage_rc(tid * 16 + i * 8192, R, C); const int Rb = Epi::PERM ? ((R & ~31) + perm32(R & 31)) : R;
        voffA[i] = (unsigned)(R * K + C) * 2u; voffB[i] = (unsigned)(Rb * K + C) * 2u; }
    const size_t kstep = (size_t)(BK * 2);
    const size_t hstep = (size_t)HALF * K * 2;
    const size_t tstep = 2 * hstep;
    const unsigned ldsw = (unsigned)wid * 1024u;
    const int aoff = lds_byte(wr * 64 + fr, fq * 8), boff = lds_byte(wc * 32 + fr, fq * 8);
#define PG8_SA(b, h) (((b) * 2 + (h)) * HTB)
#define PG8_SB(b, h) ((4 + (b) * 2 + (h)) * HTB)
#define PG8_STAGE(bufoff, gbase, voff) do { _Pragma("unroll") for (int _i = 0; _i < 2; ++_i) \
        __builtin_amdgcn_global_load_lds((const unsigned*)((const char*)(gbase) + (voff)[_i]), (PG8_LAS unsigned*)(lds + (bufoff) + ldsw + _i * 8192), 16, 0, 0); } while (0)
#define PG8_LDA(dst, b, h) do { _Pragma("unroll") for (int m = 0; m < 4; ++m) _Pragma("unroll") for (int k = 0; k < 2; ++k) dst[m][k] = *(const PG8_LAS bf16x8*)(lds + PG8_SA(b, h) + aoff + m * 2048 + k * 1024); } while (0)
#define PG8_LDB(dst, b, h) do { _Pragma("unroll") for (int n = 0; n < 2; ++n) _Pragma("unroll") for (int k = 0; k < 2; ++k) dst[n][k] = *(const PG8_LAS bf16x8*)(lds + PG8_SB(b, h) + boff + n * 2048 + k * 1024); } while (0)
#define PG8_MMA(ai, bj, At, Bt) do { __builtin_amdgcn_s_setprio(1); \
        if constexpr (FP8) { _Pragma("unroll") for (int m = 0; m < 4; ++m) _Pragma("unroll") for (int n = 0; n < 2; ++n) acc[ai][bj][m][n] = mma_fp8(Bt[n], At[m], acc[ai][bj][m][n]); } \
        else { _Pragma("unroll") for (int m = 0; m < 4; ++m) _Pragma("unroll") for (int n = 0; n < 2; ++n) _Pragma("unroll") for (int k = 0; k < 2; ++k) \
        acc[ai][bj][m][n] = __builtin_amdgcn_mfma_f32_16x16x32_bf16(Bt[n][k], At[m][k], acc[ai][bj][m][n], 0, 0, 0); } __builtin_amdgcn_s_setprio(0); } while (0)
#define PG8_WAIT_V(n) asm volatile("s_waitcnt vmcnt(" #n ")" ::: "memory")
#define PG8_WAIT_L(n) asm volatile("s_waitcnt lgkmcnt(" #n ")" ::: "memory")
#define PG8_BAR __builtin_amdgcn_s_barrier()
#define PG8_SCHED __builtin_amdgcn_sched_barrier(0)
    Unit cur, nxt; int ui = 0;
    if (!S.next(0, cur)) return;
    f32x4 acc[2][2][4][2];
#pragma unroll
    for (int a = 0; a < 2; ++a)
#pragma unroll
        for (int b = 0; b < 2; ++b)
#pragma unroll
            for (int m = 0; m < 4; ++m)
#pragma unroll
                for (int n = 0; n < 2; ++n) acc[a][b][m][n] = (f32x4){0.f, 0.f, 0.f, 0.f};
    bf16x8 At[4][2], B0[2][2], B1[2][2];
    const char* cA = (const char*)g.A + (size_t)cur.pm * tstep; const char* cB = (const char*)g.Bt + (size_t)cur.pn * tstep;
    S.a_ready(cur);
    if constexpr (SP2) {
        PG8_STAGE(PG8_SB(0, 0), cB, voffB); PG8_STAGE(PG8_SB(0, 1), cB + hstep, voffB); PG8_STAGE(PG8_SA(0, 0), cA, voffA); PG8_STAGE(PG8_SA(0, 1), cA + hstep, voffA);
        if (wr == 1) PG8_BAR;
        PG8_WAIT_V(2); PG8_BAR;
        PG8_STAGE(PG8_SB(1, 0), cB + kstep, voffB); PG8_STAGE(PG8_SA(1, 0), cA + kstep, voffA); PG8_STAGE(PG8_SB(1, 1), cB + hstep + kstep, voffB);
        PG8_WAIT_V(6); PG8_BAR;
    } else {
        PG8_STAGE(PG8_SB(0, 0), cB, voffB); PG8_STAGE(PG8_SA(0, 0), cA, voffA); PG8_STAGE(PG8_SB(0, 1), cB + hstep, voffB); PG8_STAGE(PG8_SA(0, 1), cA + hstep, voffA);
        if (wr == 1) PG8_BAR;
        PG8_WAIT_V(4); PG8_BAR;
        PG8_STAGE(PG8_SB(1, 0), cB + kstep, voffB); PG8_STAGE(PG8_SA(1, 0), cA + kstep, voffA); PG8_STAGE(PG8_SB(1, 1), cB + hstep + kstep, voffB);
        PG8_WAIT_V(6); PG8_BAR;
    }
    for (;;) {
        const bool has_next = S.next(ui + 1, nxt);
        const char* nA = has_next ? (const char*)g.A + (size_t)nxt.pm * tstep : cA; const char* nB = has_next ? (const char*)g.Bt + (size_t)nxt.pn * tstep : cB;
        for (int t = 0; t < nt; t += 2) {
            if constexpr (Epi::MIDK) { if (t == nt / 2) E.mid(acc, ui, wr, fr); }
            const bool last = (t == nt - 2);
            const char* a1 = cA + (size_t)(t + 1) * kstep;
            const char* a2 = last ? nA : cA + (size_t)(t + 2) * kstep; const char* b2 = last ? nB : cB + (size_t)(t + 2) * kstep;
            const char* a3 = a2 + kstep; const char* b3 = b2 + kstep;
            if (last && has_next) S.a_ready(nxt);
            if constexpr (SP2) {
            PG8_LDB(B0, 0, 0); PG8_LDB(B1, 0, 1); PG8_SCHED; PG8_LDA(At, 0, 0); PG8_STAGE(PG8_SA(1, 1), a1 + hstep, voffA);
            PG8_WAIT_V(8); PG8_WAIT_L(0); PG8_BAR; PG8_MMA(0, 0, At, B0); PG8_MMA(0, 1, At, B1); PG8_BAR; PG8_SCHED;
            PG8_LDA(At, 0, 1); PG8_STAGE(PG8_SB(0, 0), b2, voffB); PG8_STAGE(PG8_SB(0, 1), b2 + hstep, voffB); PG8_STAGE(PG8_SA(0, 0), a2, voffA);
            PG8_WAIT_V(8); PG8_WAIT_L(0); PG8_BAR; PG8_MMA(1, 0, At, B0); PG8_MMA(1, 1, At, B1); PG8_BAR; PG8_SCHED;
            PG8_LDB(B0, 1, 0); PG8_LDB(B1, 1, 1); PG8_SCHED; PG8_LDA(At, 1, 0); PG8_STAGE(PG8_SA(0, 1), a2 + hstep, voffA);
            PG8_WAIT_V(8); PG8_WAIT_L(0); PG8_BAR; PG8_MMA(0, 0, At, B0); PG8_MMA(0, 1, At, B1); PG8_BAR; PG8_SCHED;
            PG8_LDA(At, 1, 1); PG8_STAGE(PG8_SB(1, 0), b3, voffB); PG8_STAGE(PG8_SB(1, 1), b3 + hstep, voffB); PG8_STAGE(PG8_SA(1, 0), a3, voffA);
            PG8_WAIT_V(8); PG8_WAIT_L(0); PG8_BAR; PG8_MMA(1, 0, At, B0); PG8_MMA(1, 1, At, B1); PG8_BAR; PG8_SCHED;
            } else {
            PG8_LDB(B0, 0, 0); PG8_SCHED; PG8_LDA(At, 0, 0); PG8_STAGE(PG8_SA(1, 1), a1 + hstep, voffA);
            PG8_WAIT_L(8); PG8_BAR; PG8_WAIT_L(0); PG8_MMA(0, 0, At, B0); PG8_BAR; PG8_SCHED;
            PG8_LDB(B1, 0, 1); PG8_STAGE(PG8_SB(0, 0), b2, voffB);
            PG8_BAR; PG8_WAIT_L(0); PG8_MMA(0, 1, At, B1); PG8_BAR;
            PG8_LDA(At, 0, 1); PG8_STAGE(PG8_SA(0, 0), a2, voffA);
            PG8_BAR; PG8_WAIT_L(0); PG8_MMA(1, 0, At, B0); PG8_BAR; PG8_SCHED;
            PG8_STAGE(PG8_SB(0, 1), b2 + hstep, voffB);
            PG8_WAIT_V(6); PG8_BAR; PG8_MMA(1, 1, At, B1); PG8_BAR;
            PG8_LDB(B0, 1, 0); PG8_SCHED; PG8_LDA(At, 1, 0); PG8_STAGE(PG8_SA(0, 1), a2 + hstep, voffA);
            PG8_WAIT_L(8); PG8_BAR; PG8_WAIT_L(0); PG8_MMA(0, 0, At, B0); PG8_BAR; PG8_SCHED;
            PG8_LDB(B1, 1, 1); PG8_STAGE(PG8_SB(1, 0), b3, voffB);
            PG8_BAR; PG8_WAIT_L(0); PG8_MMA(0, 1, At, B1); PG8_BAR;
            PG8_LDA(At, 1, 1); PG8_STAGE(PG8_SA(1, 0), a3, voffA);
            PG8_BAR; PG8_WAIT_L(0); PG8_MMA(1, 0, At, B0); PG8_BAR; PG8_SCHED;
            PG8_STAGE(PG8_SB(1, 1), b3 + hstep, voffB);
            PG8_WAIT_V(6); PG8_BAR; PG8_MMA(1, 1, At, B1); PG8_BAR;
            }
        }
        if constexpr (FP8) asm volatile("s_nop 15\n\ts_nop 15\n\ts_nop 15\n\ts_nop 15" ::: "memory");
        if constexpr (ALIGN_EPI) { if (wr == 0) PG8_BAR; }
        if constexpr (!Epi::AFTER_DRAIN) { if constexpr (Epi::MIDK) E(acc, cur, wr, wc, fr, fq, ui); else E(acc, cur, wr, wc, fr, fq); S.done(cur); }
        if (!has_next) break;
#pragma unroll
        for (int a = 0; a < 2; ++a)
#pragma unroll
            for (int b = 0; b < 2; ++b)
#pragma unroll
                for (int m = 0; m < 4; ++m)
#pragma unroll
                    for (int n = 0; n < 2; ++n) acc[a][b][m][n] = (f32x4){0.f, 0.f, 0.f, 0.f};
        cur = nxt; cA = nA; cB = nB; ++ui;
        if constexpr (ALIGN_EPI) { if (wr == 1) PG8_BAR; }
    }
    PG8_WAIT_V(0);
    if constexpr (!ALIGN_EPI) { if (wr == 0) PG8_BAR; }
    PG8_BAR;
    if constexpr (Epi::AFTER_DRAIN) { E.fused(acc, cur, wr, wc, fr, fq, lds, wid, lane); S.done(cur); }
#undef PG8_SA
#undef PG8_SB
#undef PG8_STAGE
#undef PG8_LDA
#undef PG8_LDB
#undef PG8_MMA
#undef PG8_WAIT_V
#undef PG8_WAIT_L
#undef PG8_BAR
#undef PG8_SCHED
}
}
#define LAS __attribute__((address_space(3)))
typedef unsigned short bf16_t;
typedef short bf16x8 __attribute__((ext_vector_type(8)));
typedef float f32x4 __attribute__((ext_vector_type(4)));
typedef float f32x16 __attribute__((ext_vector_type(16)));
typedef unsigned u32x4 __attribute__((ext_vector_type(4)));
typedef unsigned u32x2 __attribute__((ext_vector_type(2)));

constexpr int DM = 2048, SEQ = 2048, MP = 8192, NS = 32, MT = MP + NS, MPAD = 8448;
constexpr int DFF = 5504, NUP = 2 * DFF, INW = 3584, NMOD = 18432, NC = 36;
constexpr int DFFP = 5632;
constexpr float W_UP_SCALE = 32.f, W_DN_SCALE = 64.f, ACT_SCALE = 4.f, W_O_SCALE = 64.f, MIX_SCALE = 4.f;
constexpr float ALPHA = 1.189207115002721f;
constexpr float LN_EPS = 1e-5f;
constexpr int LDS_BYTES = 147456;
constexpr size_t OFF_YP = 0, OFF_YS = 16777216, OFF_KWP = OFF_YS + 65536, OFF_VWP = OFF_KWP + 131072, OFF_KWS = OFF_VWP + 131072, OFF_VWS = OFF_KWS + 1048576, OFF_GVS = OFF_VWS + 1048576;
constexpr size_t MiB = 1u << 20;
constexpr size_t WS_CTL = 0, WS_MOD = 1 * MiB, WS_ROPE = 4 * MiB, WS_SS = 5 * MiB, WS_WUP = 8 * MiB, WS_WDN = 96 * MiB, WS_WIN = 140 * MiB, WS_WO = 154 * MiB,
                 WS_H = 162 * MiB, WS_ACT = 196 * MiB, WS_Y = 286 * MiB, WS_X1 = 352 * MiB, WS_Q = 418 * MiB, WS_U = 436 * MiB, WS_GV = 453 * MiB, WS_K = 470 * MiB, WS_V = 475 * MiB,
                 WS_MIX = 480 * MiB, WS_H8 = 514 * MiB, WS_END = 532 * MiB;
constexpr size_t WS_PART = WS_Y + 40 * MiB;
constexpr size_t WUP_ELEMS = (size_t)NUP * DM, WDN_ELEMS = (size_t)DM * DFF, WDN8_BYTES = (size_t)DM * DFFP;

struct Args { const float* in[20]; float* out; unsigned char* ws; };
typedef const Args __attribute__((address_space(4)))* KArgsPtr;

__device__ __forceinline__ unsigned pk2(float lo, float hi) { return pg8::cvt_pk_bf16(lo, hi); }
__device__ __forceinline__ float bf2f(unsigned short b) { return __builtin_bit_cast(float, (unsigned)b << 16); }
__device__ __forceinline__ float bflo(unsigned w) { return __builtin_bit_cast(float, w << 16); }
__device__ __forceinline__ float bfhi(unsigned w) { return __builtin_bit_cast(float, w & 0xffff0000u); }
__device__ __forceinline__ float wave_sum(float v) {
#pragma unroll
    for (int o = 1; o < 64; o <<= 1) v += __shfl_xor(v, o);
    return v;
}
__device__ __forceinline__ float wave_max(float v) {
#pragma unroll
    for (int o = 1; o < 64; o <<= 1) v = fmaxf(v, __shfl_xor(v, o));
    return v;
}
__device__ __forceinline__ float silu_f(float g) { return g * __builtin_amdgcn_rcpf(1.f + __expf(-g)); }
__device__ __forceinline__ float gelu_f(float x) { const float t = 1.5957691216057308f * (x + 0.044715f * x * x * x); return x * __builtin_amdgcn_rcpf(1.f + __expf(-t)); }
__device__ __forceinline__ bf16x8 pack8(float a0, float a1, float a2, float a3, float a4, float a5, float a6, float a7) {
    u32x4 w; w.x = pk2(a0, a1); w.y = pk2(a2, a3); w.z = pk2(a4, a5); w.w = pk2(a6, a7); return __builtin_bit_cast(bf16x8, w);
}
__device__ __forceinline__ unsigned pk4_fp8(float a, float b, float c, float d) { return (unsigned)__builtin_amdgcn_cvt_pk_fp8_f32(c, d, __builtin_amdgcn_cvt_pk_fp8_f32(a, b, 0, false), true); }
#define MFMA16(A, B, C) __builtin_amdgcn_mfma_f32_16x16x32_bf16((A), (B), (C), 0, 0, 0)

using pg8::Unit;
struct EpiSwiGLU {
    static constexpr bool PERM = true, AFTER_DRAIN = false, MIDK = false;
    unsigned char* O;
    __device__ __forceinline__ void operator()(const f32x4 (&acc)[2][2][4][2], const Unit& u, int wr, int wc, int fr, int fq) const {
        const int row0 = u.pm * 256 + wr * 64 + fr, col0 = u.pn * 128 + wc * 32 + 8 * fq;
        constexpr float IS = 1.f / W_UP_SCALE, OS = ACT_SCALE / W_UP_SCALE;
#pragma unroll
        for (int ai = 0; ai < 2; ++ai)
#pragma unroll
            for (int m = 0; m < 4; ++m) {
                unsigned char* rowp = O + (unsigned)(row0 + ai * 128 + m * 16) * (unsigned)DFFP + (unsigned)col0;
                const f32x4 v0 = acc[ai][0][m][0] * OS, v1 = acc[ai][0][m][1] * OS, g0 = acc[ai][1][m][0] * IS, g1 = acc[ai][1][m][1] * IS;
                u32x2 w;
                w.x = pk4_fp8(silu_f(g0[0]) * v0[0], silu_f(g0[1]) * v0[1], silu_f(g0[2]) * v0[2], silu_f(g0[3]) * v0[3]);
                w.y = pk4_fp8(silu_f(g1[0]) * v1[0], silu_f(g1[1]) * v1[1], silu_f(g1[2]) * v1[2], silu_f(g1[3]) * v1[3]);
                *(u32x2*)rowp = w;
            }
    }
};
template <bool XB  > struct EpiResid {
    static constexpr bool PERM = false, AFTER_DRAIN = false, MIDK = false;
    const void* xres; bf16_t* Y; const float* gate; float coef;
    __device__ __forceinline__ void operator()(const f32x4 (&acc)[2][2][4][2], const Unit& u, int wr, int wc, int fr, int fq) const {
        const int b = u.pm >> 3, col0 = u.pn * 256 + wc * 32 + 4 * fq, row0 = u.pm * 256 + wr * 64 + fr;
        f32x4 g4[2][2];
#pragma unroll
        for (int bj = 0; bj < 2; ++bj)
#pragma unroll
            for (int n = 0; n < 2; ++n) g4[bj][n] = *(const f32x4*)(gate + (size_t)b * NMOD + col0 + bj * 128 + n * 16) * coef;
#pragma unroll
        for (int ai = 0; ai < 2; ++ai)
#pragma unroll
            for (int m = 0; m < 4; ++m) {
                const unsigned off = (unsigned)(row0 + ai * 128 + m * 16) * (unsigned)DM + (unsigned)col0;
#pragma unroll
                for (int bj = 0; bj < 2; ++bj)
#pragma unroll
                    for (int n = 0; n < 2; ++n) {
                        f32x4 xr;
                        if (XB) { const u32x2 xw = *(const u32x2*)((const bf16_t*)xres + off + bj * 128 + n * 16); xr = (f32x4){bflo(xw.x), bfhi(xw.x), bflo(xw.y), bfhi(xw.y)}; }
                        else xr = *(const f32x4*)((const float*)xres + off + bj * 128 + n * 16);
                        const f32x4 y = xr * ALPHA + g4[bj][n] * acc[ai][bj][m][n]; u32x2 wv; wv.x = pk2(y[0], y[1]); wv.y = pk2(y[2], y[3]);
                        *(u32x2*)(Y + off + bj * 128 + n * 16) = wv;
                    }
            }
    }
};
struct EpiResidMix {
    static constexpr bool PERM = false, AFTER_DRAIN = false, MIDK = true;
    const bf16_t* xres; bf16_t* Y; const float* gate; const LAS float* rs;
    __device__ __forceinline__ void mid(f32x4 (&acc)[2][2][4][2], int ui, int wr, int fr) const {
#pragma unroll
        for (int ai = 0; ai < 2; ++ai)
#pragma unroll
            for (int m = 0; m < 4; ++m) {
                const float f = rs[((ui & 3) * 256 + ai * 128 + wr * 64 + m * 16 + fr) * 2];
#pragma unroll
                for (int bj = 0; bj < 2; ++bj)
#pragma unroll
                    for (int n = 0; n < 2; ++n) acc[ai][bj][m][n] = acc[ai][bj][m][n] * f;
            }
    }
    __device__ __forceinline__ void operator()(const f32x4 (&acc)[2][2][4][2], const Unit& u, int wr, int wc, int fr, int fq, int ui) const {
        const int b = u.pm >> 3, col0 = u.pn * 256 + wc * 32 + 4 * fq, row0 = u.pm * 256 + wr * 64 + fr;
        f32x4 g4[2][2];
#pragma unroll
        for (int bj = 0; bj < 2; ++bj)
#pragma unroll
            for (int n = 0; n < 2; ++n) g4[bj][n] = *(const f32x4*)(gate + (size_t)b * NMOD + col0 + bj * 128 + n * 16) * (1.0f / (W_O_SCALE * MIX_SCALE));
#pragma unroll
        for (int ai = 0; ai < 2; ++ai)
#pragma unroll
            for (int m = 0; m < 4; ++m) {
                const unsigned off = (unsigned)(row0 + ai * 128 + m * 16) * (unsigned)DM + (unsigned)col0;
                const float rg = rs[((ui & 3) * 256 + ai * 128 + wr * 64 + m * 16 + fr) * 2 + 1];
#pragma unroll
                for (int bj = 0; bj < 2; ++bj)
#pragma unroll
                    for (int n = 0; n < 2; ++n) {
                        const u32x2 xw = *(const u32x2*)(xres + off + bj * 128 + n * 16);
                        const f32x4 xr = (f32x4){bflo(xw.x), bfhi(xw.x), bflo(xw.y), bfhi(xw.y)};
                        const f32x4 y = xr * ALPHA + g4[bj][n] * (acc[ai][bj][m][n] * rg); u32x2 wv; wv.x = pk2(y[0], y[1]); wv.y = pk2(y[2], y[3]);
                        *(u32x2*)(Y + off + bj * 128 + n * 16) = wv;
                    }
            }
    }
};
__device__ __forceinline__ void rs_table(KArgsPtr a, LAS float* rs, const pg8::StaticOrder& S, int tid) {
    const float* SS = (const float*)(a->ws + WS_SS);
    const int rl = tid >> 1, hf = tid & 1;
    Unit u;
    for (int i = 0; i < 4 && S.next(i, u); ++i) {
        const f32x4* sp = (const f32x4*)(SS + (size_t)(u.pm * 256 + rl) * 24);
        float sum;
        if (hf == 0) { const f32x4 a0 = sp[0], a1 = sp[1], a2 = sp[2], a3 = sp[3]; sum = ((a0[0] + a0[1]) + (a0[2] + a0[3])) + ((a1[0] + a1[1]) + (a1[2] + a1[3])) + ((a2[0] + a2[1]) + (a2[2] + a2[3])) + ((a3[0] + a3[1]) + (a3[2] + a3[3])); }
        else { const f32x4 b0 = sp[4], b1 = sp[5]; sum = ((b0[0] + b0[1]) + (b0[2] + b0[3])) + ((b1[0] + b1[1]) + (b1[2] + b1[3])); }
        const float r = 1.f / sqrtf(sum * (1.f / 1024.f) + LN_EPS);
        const float other = __shfl_xor(r, 1);
        if (hf == 0) { rs[(i * 256 + rl) * 2] = r / other; rs[(i * 256 + rl) * 2 + 1] = other; }
    }
    __syncthreads();
}
struct EpiInProj {
    static constexpr bool PERM = false, AFTER_DRAIN = false, MIDK = false;
    bf16_t *Q, *Kb, *Vb, *U, *GV; const float* rope; float* out;
    __device__ __forceinline__ void operator()(const f32x4 (&acc)[2][2][4][2], const Unit& u, int wr, int wc, int fr, int fq) const {
        const int pn = u.pn, pm = u.pm; const bool samp = (pm == 32);
        const unsigned cl = wc * 32 + 4 * fq;
        if (pn < 6) {
            bf16_t* dst = pn < 4 ? Q + pn * 256 : (pn == 4 ? Kb : Vb);
            const unsigned ld = pn < 4 ? 1024u : 256u;
            const float qs = pn < 4 ? 0.125f : 1.f;
            const bool rot = (pn != 5) && ((wc & 1) == 0);
            float* wout = out + (samp ? (pn == 4 ? OFF_KWS : OFF_VWS) : (pn == 4 ? OFF_KWP : OFF_VWP));
#pragma unroll
            for (int ai = 0; ai < 2; ++ai)
#pragma unroll
                for (int m = 0; m < 4; ++m) {
                    const unsigned rowl = ai * 128 + wr * 64 + m * 16 + fr, row = pm * 256 + rowl;
                    f32x4 cs = {1.f, 1.f, 1.f, 1.f}, sn = {0.f, 0.f, 0.f, 0.f};
                    if (rot) { const unsigned pi = samp ? 2048u : (row & 2047u); cs = *(const f32x4*)(rope + pi * 16u + 4u * (fq & 1)); sn = *(const f32x4*)(rope + pi * 16u + 8u + 4u * (fq & 1)); }
                    const bool wwin = (pn >= 4) && (samp ? (rowl < (unsigned)NS) : ((pm & 7) == 7 && ai == 1));
                    const unsigned wrow = samp ? (rowl * 128u + 127u) : ((unsigned)(pm >> 3) * 128u + rowl - 128u);
#pragma unroll
                    for (int bj = 0; bj < 2; ++bj)
#pragma unroll
                        for (int n = 0; n < 2; ++n) {
                            f32x4 v = acc[ai][bj][m][n];
                            if (n == 0 && rot) {
                                f32x4 p; p[0] = __shfl_xor(v[0], 32); p[1] = __shfl_xor(v[1], 32); p[2] = __shfl_xor(v[2], 32); p[3] = __shfl_xor(v[3], 32);
                                v = (fq < 2) ? (v * cs - p * sn) : (v * cs + p * sn);
                            }
                            const unsigned c = bj * 128 + n * 16 + cl;
                            if (wwin) *(f32x4*)(wout + wrow * 256u + c) = v;
                            v = v * qs; u32x2 w; w.x = pk2(v[0], v[1]); w.y = pk2(v[2], v[3]);
                            *(u32x2*)(dst + row * ld + c) = w;
                        }
                    asm volatile("" ::: "memory");
                }
        } else {
            bf16_t* base = (pn < 10) ? (U + (pn - 6) * 256) : (GV + (pn - 10) * 256);
#pragma unroll
            for (int ai = 0; ai < 2; ++ai)
#pragma unroll
                for (int m = 0; m < 4; ++m) {
                    const unsigned row = pm * 256 + ai * 128 + wr * 64 + m * 16 + fr;
#pragma unroll
                    for (int bj = 0; bj < 2; ++bj)
#pragma unroll
                        for (int n = 0; n < 2; ++n) {
                            const f32x4 v = acc[ai][bj][m][n];
                            u32x2 w; w.x = pk2(gelu_f(v[0]), gelu_f(v[1])); w.y = pk2(gelu_f(v[2]), gelu_f(v[3]));
                            *(u32x2*)(base + row * 1024u + bj * 128 + n * 16 + cl) = w;
                        }
                    asm volatile("" ::: "memory");
                }
        }
    }
};

__device__ __forceinline__ void ada_item(KArgsPtr a, LAS unsigned char* lds, int it, int tid) {
    const int w = __builtin_amdgcn_readfirstlane(tid >> 6), lane = tid & 63, fr = lane & 15, fq = lane >> 4;
    const int g = w & 1, kq = w >> 1;
    const float* W = a->in[6]; const int c0 = it * 128;
    f32x4 acc[4][3];
#pragma unroll
    for (int nt = 0; nt < 4; ++nt)
#pragma unroll
        for (int mt = 0; mt < 3; ++mt) acc[nt][mt] = (f32x4){0.f, 0.f, 0.f, 0.f};
    for (int i4 = 0; i4 < 4; ++i4) {
        const int kb = 512 * kq + 128 * i4 + 8 * fq;
        f32x4 wv[4][8];
#pragma unroll
        for (int sx = 0; sx < 4; ++sx)
#pragma unroll
            for (int e = 0; e < 8; ++e) wv[sx][e] = __builtin_nontemporal_load((const f32x4*)(W + (size_t)(kb + 32 * sx + e) * NMOD + c0 + 64 * g + 4 * fr));
#pragma unroll
        for (int sx = 0; sx < 4; ++sx) {
            const int k0 = kb + 32 * sx;
            bf16x8 sc[3];
#pragma unroll
            for (int mt = 0; mt < 3; ++mt) {
                const int r = 16 * mt + fr;
                if (r < NC) {
                    const float* cp = (r < 4 ? a->in[4] + (size_t)r * DM : a->in[5] + (size_t)(r - 4) * DM) + k0;
                    const f32x4 x0 = *(const f32x4*)cp, x1 = *(const f32x4*)(cp + 4);
                    sc[mt] = pack8(silu_f(x0[0]), silu_f(x0[1]), silu_f(x0[2]), silu_f(x0[3]), silu_f(x1[0]), silu_f(x1[1]), silu_f(x1[2]), silu_f(x1[3]));
                } else sc[mt] = (bf16x8){0, 0, 0, 0, 0, 0, 0, 0};
            }
#pragma unroll
            for (int nt = 0; nt < 4; ++nt) {
                const bf16x8 wf = pack8(wv[sx][0][nt], wv[sx][1][nt], wv[sx][2][nt], wv[sx][3][nt], wv[sx][4][nt], wv[sx][5][nt], wv[sx][6][nt], wv[sx][7][nt]);
#pragma unroll
                for (int mt = 0; mt < 3; ++mt) acc[nt][mt] = MFMA16(wf, sc[mt], acc[nt][mt]);
            }
        }
    }
    LAS float* red = (LAS float*)(lds + 69632);
    for (int ww = 0; ww < 8; ++ww) {
        if (w == ww) {
#pragma unroll
            for (int nt = 0; nt < 4; ++nt)
#pragma unroll
                for (int mt = 0; mt < 3; ++mt)
#pragma unroll
                    for (int rg = 0; rg < 4; ++rg) {
                        const int idx = (16 * mt + fr) * 132 + 64 * g + 16 * fq + 4 * rg + nt;
                        if (kq == 0) red[idx] = acc[nt][mt][rg]; else red[idx] += acc[nt][mt][rg];
                    }
        }
        __syncthreads();
    }
    float* mod = (float*)(a->ws + WS_MOD);
    for (int e = tid; e < NC * 128; e += 512) { const int r = e >> 7, c = e & 127; mod[(size_t)r * NMOD + c0 + c] = red[r * 132 + c] + a->in[7][c0 + c]; }
    __syncthreads();
}
constexpr int I_UP = (DM / 64) * (NUP / 32), I_DN = (DFF / 64) * (DM / 32), I_IN = (DM / 64) * (INW / 32), I_WO = (DM / 64) * (DM / 32);
constexpr int N_TR = 2 * I_UP + 2 * I_DN + I_IN + I_WO;
constexpr int N_UP1_DEF = 4096;
constexpr int N_TR_P0 = 2 * I_UP - N_UP1_DEF + I_IN;
constexpr int N_TR_TAIL = 2048;
struct TrItem { const float* src; unsigned char* dst; int N, rowb; float scale; };
__device__ __forceinline__ void tr_decode(KArgsPtr a, int it, int lane, TrItem& d) {
    const float* W; unsigned char* WT; int N, kind = 0, r = it, rowb, esz; float scale = 0.f;
    if (r < 2 * I_UP) { const int l = r >= I_UP ? 1 : 0; r -= l * I_UP; W = a->in[10] + (size_t)l * WUP_ELEMS; WT = a->ws + WS_WUP + (size_t)l * WUP_ELEMS; rowb = DM; esz = 1; N = NUP; kind = 1; scale = W_UP_SCALE; }
    else if ((r -= 2 * I_UP) < 2 * I_DN) { const int l = r >= I_DN ? 1 : 0; r -= l * I_DN; W = a->in[11] + (size_t)l * WDN_ELEMS; WT = a->ws + WS_WDN + (size_t)l * WDN8_BYTES; rowb = DFFP; esz = 1; N = DM; scale = W_DN_SCALE; }
    else if ((r -= 2 * I_DN) < I_IN) { W = a->in[12]; WT = a->ws + WS_WIN; rowb = 2 * DM; esz = 2; N = INW; }
    else { r -= I_IN; W = a->in[19]; WT = a->ws + WS_WO; rowb = DM; esz = 1; N = DM; scale = W_O_SCALE; }
    const int nblk = N / 32, kb = r / nblk, nb = r - kb * nblk, k0 = 64 * kb, n0 = 32 * nb;
    int d0 = n0;
    if (kind) { const int bj = n0 >= DFF ? 1 : 0, q = n0 - bj * DFF; d0 = 256 * (q >> 7) + 128 * bj + (q & 127); }
    d.src = W + (size_t)(k0 + (lane >> 5)) * N + n0 + (lane & 31);
    d.dst = WT + (size_t)(d0 + (lane >> 3)) * rowb + (size_t)(k0 + 8 * (lane & 7)) * esz;
    d.N = N; d.rowb = rowb; d.scale = scale;
}
__device__ __forceinline__ void tr_load(const TrItem& d, float (&v)[32]) {
#pragma unroll
    for (int i = 0; i < 32; ++i) v[i] = __builtin_nontemporal_load(d.src + (size_t)(2 * i) * d.N);
}
__device__ __forceinline__ void tr_store(const TrItem& d, const float (&v)[32], LAS float* scr, int lane) {
#pragma unroll
    for (int i = 0; i < 32; ++i) scr[(2 * i + (lane >> 5)) * 33 + (lane & 31)] = v[i];
    asm volatile("s_waitcnt lgkmcnt(0)" ::: "memory");
    const int c = lane & 7;
    if (d.scale == 0.f) {
#pragma unroll
        for (int j = 0; j < 4; ++j) { const LAS float* sp = scr + (8 * c) * 33 + (lane >> 3) + 8 * j;
            u32x4 o; o.x = pk2(sp[0 * 33], sp[1 * 33]); o.y = pk2(sp[2 * 33], sp[3 * 33]); o.z = pk2(sp[4 * 33], sp[5 * 33]); o.w = pk2(sp[6 * 33], sp[7 * 33]);
            *(u32x4*)(d.dst + (size_t)(8 * j) * d.rowb) = o; }
    } else {
        const float sc = d.scale;
#pragma unroll
        for (int j = 0; j < 4; ++j) { const LAS float* sp = scr + (8 * c) * 33 + (lane >> 3) + 8 * j;
            u32x2 o; o.x = pk4_fp8(sp[0 * 33] * sc, sp[1 * 33] * sc, sp[2 * 33] * sc, sp[3 * 33] * sc); o.y = pk4_fp8(sp[4 * 33] * sc, sp[5 * 33] * sc, sp[6 * 33] * sc, sp[7 * 33] * sc);
            *(u32x2*)(d.dst + (size_t)(8 * j) * d.rowb) = o; }
    }
    asm volatile("s_waitcnt lgkmcnt(0)" ::: "memory");
}
__device__ __forceinline__ void p0_phase(KArgsPtr a, LAS unsigned char* lds, int tid, int rep) {
    const int w = __builtin_amdgcn_readfirstlane(tid >> 6), lane = tid & 63, G = gridDim.x;
    const int NADA = NMOD / 128;
#ifndef DUP_ADA
#define DUP_ADA 0
#endif
    if ((int)blockIdx.x < NADA) { for (int rr = 0; rr <= DUP_ADA; ++rr) for (int it = blockIdx.x; it < NADA; it += G) ada_item(a, lds, it, tid); }
    if ((int)blockIdx.x >= NADA || G <= NADA) {
        const int nb = (G > NADA) ? (G - NADA) : G, bi = (G > NADA) ? ((int)blockIdx.x - NADA) : (int)blockIdx.x;
        float* rope = (float*)(a->ws + WS_ROPE);
        for (int e = bi * 512 + tid; e < 2049 * 8; e += nb * 512) {
            const int pi = e >> 3, i = e & 7;
            const float pos = (pi == 2048) ? 16384.f : (float)pi;
            const float inv = (float)exp2(-(double)i * 0.125 * 18.931568569324174);
            const float angf = pos * inv;
            double ang = (double)angf;
            const double k = rint(ang * 0.15915494309189535);
            double r = fma(-k, 6.283185307179586, ang); r = fma(-k, 2.4492935982947064e-16, r);
            const double r2 = r * r;
            double s = -1.0 / 51090942171709440000.0;
            s = s * r2 + 1.0 / 121645100408832000.0; s = s * r2 - 1.0 / 355687428096000.0; s = s * r2 + 1.0 / 1307674368000.0; s = s * r2 - 1.0 / 6227020800.0;
            s = s * r2 + 1.0 / 39916800.0; s = s * r2 - 1.0 / 362880.0; s = s * r2 + 1.0 / 5040.0; s = s * r2 - 1.0 / 120.0; s = s * r2 + 1.0 / 6.0; s = -s * r2 + 1.0; s = s * r;
            double c = 1.0 / 2432902008176640000.0;
            c = c * r2 - 1.0 / 6402373705728000.0; c = c * r2 + 1.0 / 20922789888000.0; c = c * r2 - 1.0 / 87178291200.0; c = c * r2 + 1.0 / 479001600.0;
            c = c * r2 - 1.0 / 3628800.0; c = c * r2 + 1.0 / 40320.0; c = c * r2 - 1.0 / 720.0; c = c * r2 + 1.0 / 24.0; c = c * r2 - 0.5; c = c * r2 + 1.0;
            rope[pi * 16 + i] = (float)c; rope[pi * 16 + 8 + i] = (float)s;
        }
        for (int e = bi * 512 + tid; e < (2 * DM + MPAD) * 8; e += nb * 512) {
            const int rw = e >> 3, q = e & 7;
            unsigned char* base = rw < 2 * DM ? a->ws + WS_WDN + (size_t)rw * DFFP : a->ws + WS_ACT + (size_t)(rw - 2 * DM) * DFFP;
            *(u32x4*)(base + DFF + 16 * q) = (u32x4){0u, 0u, 0u, 0u};
        }
        for (int e = bi * 512 + tid; e < 2 * NS * 127 * 64; e += nb * 512) {
            const int t = e / (NS * 127 * 64), r = e % (NS * 127 * 64), b = r / (127 * 64), q = r % (127 * 64);
            const f32x4 v = *((const f32x4*)(a->in[2 + t] + (size_t)b * 128 * 256 + 256) + q);
            *((f32x4*)(a->out + (t ? OFF_VWS : OFF_KWS) + (size_t)b * 128 * 256) + q) = v;
        }
    }
    {
        const int gw = blockIdx.x * 8 + w, NGW = G * 8;
        LAS float* scr = (LAS float*)(lds + w * 8448);
        const bool has_tail = (G > NADA) && ((int)blockIdx.x >= NADA);
        const int n_main = (G > NADA) ? (N_TR_P0 - N_TR_TAIL) : N_TR_P0;
        const int nm_w = (gw < n_main) ? (n_main - gw + NGW - 1) / NGW : 0;
        const int tw = ((int)blockIdx.x - NADA) * 8 + w, TNW = (G - NADA) * 8;
        const int nt_w = (has_tail && tw < N_TR_TAIL) ? (N_TR_TAIL - tw + TNW - 1) / TNW : 0;
        const int n_w = nm_w + nt_w;
        for (int k = 0; k < n_w; k += 4) {
            TrItem d[4]; float v[4][32];
#pragma unroll
            for (int q = 0; q < 4; ++q) if (k + q < n_w) { const int kk = k + q; int it = kk < nm_w ? gw + kk * NGW : n_main + tw + (kk - nm_w) * TNW; if (it >= 2 * I_UP - N_UP1_DEF) it += 2 * I_DN + N_UP1_DEF;     tr_decode(a, it, lane, d[q]); tr_load(d[q], v[q]); }
#pragma unroll
            for (int q = 0; q < 4; ++q) if (k + q < n_w) tr_store(d[q], v[q], scr, lane);
        }
    }
}
__device__ __forceinline__ void tr_deferred(KArgsPtr a, LAS unsigned char* lds, int tid, int first, int count, int bi, int nblk) {
    const int w = __builtin_amdgcn_readfirstlane(tid >> 6), lane = tid & 63;
    LAS float* scr = (LAS float*)(lds + w * 8448);
    const int tw = bi * 8 + w, TNW = nblk * 8;
    const int n_w = (tw < count) ? (count - tw + TNW - 1) / TNW : 0;
    for (int k = 0; k < n_w; k += 4) {
        TrItem d[4]; float v[4][32];
#pragma unroll
        for (int q = 0; q < 4; ++q) if (k + q < n_w) { tr_decode(a, first + tw + (k + q) * TNW, lane, d[q]); tr_load(d[q], v[q]); }
#pragma unroll
        for (int q = 0; q < 4; ++q) if (k + q < n_w) tr_store(d[q], v[q], scr, lane);
    }
}
__device__ __forceinline__ const float* mod_row(KArgsPtr a, int row, int sub) {
    const int b = row < MP ? (row >> 11) : (4 + row - MP);
    return (const float*)(a->ws + WS_MOD) + (size_t)b * NMOD + sub * 6144;
}
__device__ __forceinline__ void h0_phase(KArgsPtr a, int tid) {
    const unsigned lane = tid & 63; const int gw = blockIdx.x * 8 + __builtin_amdgcn_readfirstlane(tid >> 6), NGW = gridDim.x * 8;
    unsigned char* H8 = a->ws + WS_H8;
    for (int r0 = gw; r0 < MP; r0 += 4 * NGW) {
        f32x4 xv[4][8];
#pragma unroll
        for (int q = 0; q < 4; ++q) { const int row = r0 + q * NGW; if (row < MP) {
            const f32x4* xr = (const f32x4*)(row < MP ? a->in[0] + (size_t)row * DM : a->in[1] + (size_t)(row - MP) * DM);
#pragma unroll
            for (int j = 0; j < 8; ++j) xv[q][j] = __builtin_nontemporal_load(xr + (64u * j + lane)); } }
#pragma unroll
        for (int q = 0; q < 4; ++q) { const int row = r0 + q * NGW; if (row < MP) {
            const f32x4* sh = (const f32x4*)mod_row(a, row, 0); const f32x4* scl = sh + 512;
            unsigned* o = (unsigned*)(H8 + (size_t)row * DM);
#pragma unroll
            for (int j = 0; j < 8; ++j) { const unsigned c = 64u * j + lane; const f32x4 h = xv[q][j] * (scl[c] + 1.f) + sh[c]; o[c] = pk4_fp8(h[0], h[1], h[2], h[3]); } } }
    }
    const int w = __builtin_amdgcn_readfirstlane(tid >> 6);
    for (int t = blockIdx.x; t < NS; t += gridDim.x) {
        const int row = MP + t; const unsigned c = 64u * w + lane;
        const f32x4 x = ((const f32x4*)(a->in[1] + (size_t)t * DM))[c];
        const f32x4* sh = (const f32x4*)mod_row(a, row, 0); const f32x4* scl = sh + 512;
        const f32x4 h = x * (scl[c] + 1.f) + sh[c];
        ((unsigned*)(H8 + (size_t)row * DM))[c] = pk4_fp8(h[0], h[1], h[2], h[3]);
    }
}
__device__ __forceinline__ void ln_finish(KArgsPtr a, f32x4 (&v)[8], int row, unsigned lane, int li, bool final_out, int next_sub) {
    const f32x4* g4 = (const f32x4*)(a->in[8] + li * DM); const f32x4* b4 = (const f32x4*)(a->in[9] + li * DM);
    bf16_t* X1 = (bf16_t*)(a->ws + WS_X1); bf16_t* H = (bf16_t*)(a->ws + WS_H);
    float s = 0.f;
#pragma unroll
    for (int j = 0; j < 8; ++j) s += (v[j][0] + v[j][1]) + (v[j][2] + v[j][3]);
    const float mean = wave_sum(s) * (1.f / DM); float q = 0.f;
#pragma unroll
    for (int j = 0; j < 8; ++j) { v[j] = v[j] - mean; q += (v[j][0] * v[j][0] + v[j][1] * v[j][1]) + (v[j][2] * v[j][2] + v[j][3] * v[j][3]); }
    const float rstd = 1.f / sqrtf(wave_sum(q) * (1.f / DM) + LN_EPS);
    f32x4* xo = (f32x4*)(row < MP ? a->out + OFF_YP + (size_t)row * DM : a->out + OFF_YS + (size_t)(row - MP) * DM); u32x2* xb = (u32x2*)(X1 + (size_t)row * DM);
    const f32x4* sh = (const f32x4*)mod_row(a, row, final_out ? 0 : next_sub); const f32x4* scl = sh + 512;
    u32x2* ho = (u32x2*)(H + (size_t)row * DM); unsigned* ho8 = (unsigned*)(a->ws + WS_H8 + (size_t)row * DM);
#pragma unroll
    for (int j = 0; j < 8; ++j) {
        const unsigned c = 64u * j + lane; const f32x4 x = v[j] * rstd * g4[c] + b4[c]; if (final_out) xo[c] = x; else { u32x2 xw; xw.x = pk2(x[0], x[1]); xw.y = pk2(x[2], x[3]); xb[c] = xw; }
        if (!final_out) { const f32x4 h = x * (scl[c] + 1.f) + sh[c];
            if (next_sub == 2) ho8[c] = pk4_fp8(h[0], h[1], h[2], h[3]);
            else { u32x2 wv; wv.x = pk2(h[0], h[1]); wv.y = pk2(h[2], h[3]); ho[c] = wv; } }
        if (j & 1) asm volatile("" ::: "memory");
    }
}
__device__ __forceinline__ void ln_phase(KArgsPtr a, LAS unsigned char* lds, int tid, int li, bool final_out, int next_sub) {
    const unsigned lane = tid & 63; const int gw = blockIdx.x * 8 + __builtin_amdgcn_readfirstlane(tid >> 6), NGW = gridDim.x * 8;
    const bf16_t* Y = (const bf16_t*)(a->ws + WS_Y); const bf16_t* X1 = (const bf16_t*)(a->ws + WS_X1);
    for (int r0 = gw; r0 < MP; r0 += 4 * NGW) {
        f32x4 v[4][8];
#pragma unroll
        for (int q = 0; q < 4; ++q) { const int row = r0 + q * NGW; if (row < MP) { const u32x2* yr = (const u32x2*)(Y + (size_t)row * DM);
#pragma unroll
            for (int j = 0; j < 8; ++j) { const u32x2 yw = yr[64u * j + lane]; v[q][j] = (f32x4){bflo(yw.x), bfhi(yw.x), bflo(yw.y), bfhi(yw.y)}; } } }
#pragma unroll
        for (int q = 0; q < 4; ++q) { const int row = r0 + q * NGW; if (row < MP) ln_finish(a, v[q], row, lane, li, final_out, next_sub); }
    }
    const int w = __builtin_amdgcn_readfirstlane(tid >> 6);
    LAS float* red = (LAS float*)lds;
    for (int t = blockIdx.x; t < NS; t += gridDim.x) {
        const int row = MP + t; const float coef = (li == 1) ? 1.0f / (W_O_SCALE * MIX_SCALE) : 0.5f / (W_DN_SCALE * ACT_SCALE);
        const unsigned c = 64u * w + lane;
        float ra = 1.f, rg = 1.f;
        if (li == 1) {
            const float sv = (lane < 24) ? ((const float*)(a->ws + WS_SS))[(size_t)row * 24 + lane] : 0.f;
            const float sa = wave_sum(lane < 16 ? sv : 0.f), sg = wave_sum(lane >= 16 ? sv : 0.f);
            ra = 1.f / sqrtf(sa * (1.f / 1024.f) + LN_EPS); rg = 1.f / sqrtf(sg * (1.f / 1024.f) + LN_EPS);
        }
        const f32x4* xs = (const f32x4*)(a->in[1] + (size_t)t * DM); const u32x2* xsb = (const u32x2*)(X1 + (size_t)row * DM);
        const f32x4* gt = (const f32x4*)(mod_row(a, row, li) + 4096);
        const f32x4* pp = (const f32x4*)((const float*)(a->ws + WS_PART) + (size_t)t * DM);
        const f32x4 sm = (pp[c] + pp[c + 32 * 512]) * ra + (pp[c + 64 * 512] + pp[c + 96 * 512]) * rg;
        f32x4 xv; if (li == 0) xv = xs[c]; else { const u32x2 xw = xsb[c]; xv = (f32x4){bflo(xw.x), bfhi(xw.x), bflo(xw.y), bfhi(xw.y)}; }
        f32x4 v = xv * ALPHA + gt[c] * coef * sm;
        const float s = wave_sum((v[0] + v[1]) + (v[2] + v[3]));
        if (lane == 0) red[w] = s;
        __syncthreads();
        const float mean = (((red[0] + red[1]) + (red[2] + red[3])) + ((red[4] + red[5]) + (red[6] + red[7]))) * (1.f / DM);
        v = v - mean;
        const float q = wave_sum((v[0] * v[0] + v[1] * v[1]) + (v[2] * v[2] + v[3] * v[3]));
        if (lane == 0) red[8 + w] = q;
        __syncthreads();
        const float rstd = 1.f / sqrtf((((red[8] + red[9]) + (red[10] + red[11])) + ((red[12] + red[13]) + (red[14] + red[15]))) * (1.f / DM) + LN_EPS);
        const f32x4* g4 = (const f32x4*)(a->in[8] + li * DM); const f32x4* b4 = (const f32x4*)(a->in[9] + li * DM);
        const f32x4 x = v * rstd * g4[c] + b4[c];
        if (final_out) ((f32x4*)(a->out + OFF_YS + (size_t)t * DM))[c] = x;
        else {
            u32x2 xw; xw.x = pk2(x[0], x[1]); xw.y = pk2(x[2], x[3]); ((u32x2*)(a->ws + WS_X1 + (size_t)row * DM * 2))[c] = xw;
            const f32x4* sh = (const f32x4*)mod_row(a, row, next_sub); const f32x4* scl = sh + 512;
            const f32x4 h = x * (scl[c] + 1.f) + sh[c];
            if (next_sub == 2) ((unsigned*)(a->ws + WS_H8 + (size_t)row * DM))[c] = pk4_fp8(h[0], h[1], h[2], h[3]);
            else { u32x2 hw; hw.x = pk2(h[0], h[1]); hw.y = pk2(h[2], h[3]); ((u32x2*)(a->ws + WS_H + (size_t)row * DM * 2))[c] = hw; }
        }
        __syncthreads();
    }
}
__device__ __forceinline__ void merge_phase(KArgsPtr a, int tid) {
    const unsigned lane = tid & 63; const int gw = blockIdx.x * 8 + __builtin_amdgcn_readfirstlane(tid >> 6), NGW = gridDim.x * 8;
    const bf16_t* MIX = (const bf16_t*)(a->ws + WS_MIX); const float* SS = (const float*)(a->ws + WS_SS); unsigned char* H8 = a->ws + WS_H8;
    const float* og = a->in[18];
    for (int r0 = gw; r0 < MP; r0 += 4 * NGW) {
        u32x4 mv[4][4]; float sv[4];
#pragma unroll
        for (int q = 0; q < 4; ++q) { const int row = r0 + q * NGW; if (row < MP) {
            sv[q] = (lane < 24) ? SS[(size_t)row * 24 + lane] : 0.f;
            const u32x4* mr = (const u32x4*)(MIX + (size_t)row * DM);
#pragma unroll
            for (int j = 0; j < 4; ++j) mv[q][j] = mr[64u * j + lane]; } }
#pragma unroll
        for (int q = 0; q < 4; ++q) { const int row = r0 + q * NGW; if (row < MP) {
            float sa = (lane < 16) ? sv[q] : 0.f, sg = (lane >= 16) ? sv[q] : 0.f;
            sa = wave_sum(sa); sg = wave_sum(sg);
            const float ra = 1.f / sqrtf(sa * (1.f / 1024.f) + LN_EPS), rg = 1.f / sqrtf(sg * (1.f / 1024.f) + LN_EPS);
            u32x2* ho = (u32x2*)(H8 + (size_t)row * DM);
#pragma unroll
            for (int j = 0; j < 4; ++j) {
                const unsigned c = 64u * j + lane; const u32x4 m = mv[q][j]; const float r = (j < 2) ? ra : rg;
                const f32x4 g0 = *(const f32x4*)(og + 8 * c), g1 = *(const f32x4*)(og + 8 * c + 4);
                u32x2 o;
                o.x = pk4_fp8(bflo(m.x) * r * g0[0], bfhi(m.x) * r * g0[1], bflo(m.y) * r * g0[2], bfhi(m.y) * r * g0[3]);
                o.y = pk4_fp8(bflo(m.z) * r * g1[0], bfhi(m.z) * r * g1[1], bflo(m.w) * r * g1[2], bfhi(m.w) * r * g1[3]);
                ho[c] = o;
            } } }
    }
    const int w = __builtin_amdgcn_readfirstlane(tid >> 6);
    for (int t = blockIdx.x; t < NS; t += gridDim.x) {
        const int row = MP + t;
        const float sv = (lane < 24) ? SS[(size_t)row * 24 + lane] : 0.f;
        const float sa = wave_sum(lane < 16 ? sv : 0.f), sg = wave_sum(lane >= 16 ? sv : 0.f);
        const float ra = 1.f / sqrtf(sa * (1.f / 1024.f) + LN_EPS), rg = 1.f / sqrtf(sg * (1.f / 1024.f) + LN_EPS);
        if (lane < 32) {
            const unsigned c = 32u * w + lane;
            const u32x4 m = ((const u32x4*)(MIX + (size_t)row * DM))[c]; const float r = (c < 128u) ? ra : rg;
            const f32x4 g0 = *(const f32x4*)(og + 8 * c), g1 = *(const f32x4*)(og + 8 * c + 4);
            u32x2 o;
            o.x = pk4_fp8(bflo(m.x) * r * g0[0], bfhi(m.x) * r * g0[1], bflo(m.y) * r * g0[2], bfhi(m.y) * r * g0[3]);
            o.y = pk4_fp8(bflo(m.z) * r * g1[0], bfhi(m.z) * r * g1[1], bflo(m.w) * r * g1[2], bfhi(m.w) * r * g1[3]);
            ((u32x2*)(H8 + (size_t)row * DM))[c] = o;
        }
    }
}
template <bool FP8  >
__device__ __forceinline__ void small_part(LAS unsigned char* lds, int tid, const void* Av, const void* Btv, int K, float* PART) {
    const int w = __builtin_amdgcn_readfirstlane(tid >> 6), lane = tid & 63, S = K / 16;
    LAS float* part = (LAS float*)lds;
    for (int it = blockIdx.x; it < 256; it += gridDim.x) {
        const int n0 = 32 * (it & 63), kq = it >> 6, sl = kq * 8 + w;
        const int s0 = (sl * S) >> 5, s1 = ((sl + 1) * S) >> 5;
        f32x16 acc;
#pragma unroll
        for (int i = 0; i < 16; ++i) acc[i] = 0.f;
        if constexpr (FP8) {
            const unsigned char* ap = (const unsigned char*)Av + (size_t)(lane & 31) * K + 8 * (lane >> 5);
            const unsigned char* bp = (const unsigned char*)Btv + (size_t)(n0 + (lane & 31)) * K + 8 * (lane >> 5);
            long af[11], bfr[11];
#pragma unroll
            for (int i = 0; i < 11; ++i) { const int st = (s0 + i < s1) ? s0 + i : s0; af[i] = *(const long*)(ap + 16 * st); bfr[i] = *(const long*)(bp + 16 * st); }
#pragma unroll
            for (int i = 0; i < 11; ++i) if (s0 + i < s1) acc = __builtin_amdgcn_mfma_f32_32x32x16_fp8_fp8(af[i], bfr[i], acc, 0, 0, 0);
        } else {
            const bf16_t* ap = (const bf16_t*)Av + (size_t)(lane & 31) * K + 8 * (lane >> 5);
            const bf16_t* bp = (const bf16_t*)Btv + (size_t)(n0 + (lane & 31)) * K + 8 * (lane >> 5);
            bf16x8 af[11], bfr[11];
#pragma unroll
            for (int i = 0; i < 11; ++i) { const int st = (s0 + i < s1) ? s0 + i : s0; af[i] = *(const bf16x8*)(ap + 16 * st); bfr[i] = *(const bf16x8*)(bp + 16 * st); }
#pragma unroll
            for (int i = 0; i < 11; ++i) if (s0 + i < s1) acc = __builtin_amdgcn_mfma_f32_32x32x16_bf16(af[i], bfr[i], acc, 0, 0, 0);
        }
#pragma unroll
        for (int rg = 0; rg < 16; ++rg) { const int i = 8 * (rg >> 2) + 4 * (lane >> 5) + (rg & 3); part[w * 1024 + i * 32 + (lane & 31)] = acc[rg]; }
        __syncthreads();
        for (int e = tid; e < 1024; e += 512) {
            const int t = e >> 5, n = e & 31; float sm = 0.f;
#pragma unroll
            for (int ww = 0; ww < 8; ++ww) sm += part[ww * 1024 + e];
            PART[(size_t)(kq * 32 + t) * DM + n0 + n] = sm;
        }
        __syncthreads();
    }
}
struct AttnRegs { u32x4 kv[4], vv[4]; bf16x8 qf[2]; };
__device__ __forceinline__ void attn_load(KArgsPtr a, int item, int tid, AttnRegs& R) {
    const int h = item & 15, nb = (item >> 4) & 15, b = item >> 8, kvh = h >> 2;
    const bf16_t* Q = (const bf16_t*)(a->ws + WS_Q); const bf16_t* Kb = (const bf16_t*)(a->ws + WS_K); const bf16_t* Vb = (const bf16_t*)(a->ws + WS_V);
    const int w = __builtin_amdgcn_readfirstlane(tid >> 6), lane = tid & 63, fr = lane & 15, fq = lane >> 4;
    const unsigned qrow = b * SEQ + nb * 128 + 16 * w + fr;
#pragma unroll
    for (int ks = 0; ks < 2; ++ks) R.qf[ks] = *(const bf16x8*)(Q + qrow * 1024u + h * 64 + ks * 32 + 8 * fq);
    const int rowk0 = b * SEQ + (nb - 1) * 128;
#pragma unroll
    for (int i = 0; i < 4; ++i) {
        const int ch = tid + 512 * i, c = ch >> 3, part = ch & 7;
        R.kv[i] = (u32x4){0u, 0u, 0u, 0u}; R.vv[i] = (u32x4){0u, 0u, 0u, 0u};
        if (nb > 0 || c >= 128) { const unsigned off = (unsigned)(rowk0 + c) * 256u + kvh * 64 + part * 8; R.kv[i] = *(const u32x4*)(Kb + off); R.vv[i] = *(const u32x4*)(Vb + off); }
    }
}
__device__ __forceinline__ void attn_stage(LAS unsigned char* lds, int tid, const AttnRegs& R) {
    LAS bf16_t* Kl = (LAS bf16_t*)lds; LAS bf16_t* Vl = Kl + 256 * 72;
#pragma unroll
    for (int i = 0; i < 4; ++i) { const int ch = tid + 512 * i, c = ch >> 3, part = ch & 7; *(LAS u32x4*)(Kl + c * 72 + part * 8) = R.kv[i]; *(LAS u32x4*)(Vl + c * 72 + part * 8) = R.vv[i]; }
}
__device__ __forceinline__ void attn_compute(KArgsPtr a, LAS unsigned char* lds, int item, int tid, const bf16x8 (&qf)[2]) {
    const int h = item & 15, nb = (item >> 4) & 15, b = item >> 8;
    bf16_t* MIX = (bf16_t*)(a->ws + WS_MIX); float* SS = (float*)(a->ws + WS_SS);
    LAS bf16_t* Kl = (LAS bf16_t*)lds; LAS bf16_t* Vl = Kl + 256 * 72;
    const int w = __builtin_amdgcn_readfirstlane(tid >> 6), lane = tid & 63, fr = lane & 15, fq = lane >> 4;
    const size_t qrow = (size_t)b * SEQ + nb * 128 + 16 * w + fr;
    f32x4 s[9];
#pragma unroll
    for (int t = 0; t < 9; ++t) {
        s[t] = (f32x4){0.f, 0.f, 0.f, 0.f};
#pragma unroll
        for (int ks = 0; ks < 2; ++ks) { const bf16x8 kf = *(const LAS bf16x8*)(Kl + (16 * (w + t) + fr) * 72 + ks * 32 + 8 * fq); s[t] = MFMA16(kf, qf[ks], s[t]); }
    }
    const float sink = a->in[13][h];
    float mx = sink;
#pragma unroll
    for (int t = 0; t < 9; ++t)
#pragma unroll
        for (int rg = 0; rg < 4; ++rg) {
            bool valid = (nb > 0) || (w + t >= 8);
            if (t == 0) valid = valid && (4 * fq + rg > fr);
            if (t == 8) valid = valid && (4 * fq + rg <= fr);
            const float v = valid ? s[t][rg] : -INFINITY; s[t][rg] = v; mx = fmaxf(mx, v);
        }
    mx = fmaxf(mx, __shfl_xor(mx, 16)); mx = fmaxf(mx, __shfl_xor(mx, 32));
    float sum = 0.f;
#pragma unroll
    for (int t = 0; t < 9; ++t)
#pragma unroll
        for (int rg = 0; rg < 4; ++rg) { const float p = __expf(s[t][rg] - mx); s[t][rg] = p; sum += p; }
    sum += __shfl_xor(sum, 16); sum += __shfl_xor(sum, 32);
    const float inv = 1.f / (sum + __expf(sink - mx));
    f32x4 o[4];
#pragma unroll
    for (int dt = 0; dt < 4; ++dt) o[dt] = (f32x4){0.f, 0.f, 0.f, 0.f};
#pragma unroll
    for (int st = 0; st < 5; ++st) {
        u32x4 pw; pw.x = pk2(s[2 * st][0], s[2 * st][1]); pw.y = pk2(s[2 * st][2], s[2 * st][3]);
        if (st < 4) { pw.z = pk2(s[2 * st + 1][0], s[2 * st + 1][1]); pw.w = pk2(s[2 * st + 1][2], s[2 * st + 1][3]); } else { pw.z = 0u; pw.w = 0u; }
        const bf16x8 pf = __builtin_bit_cast(bf16x8, pw);
        const int ca = 16 * (w + 2 * st) + 4 * fq, cb = ca + 16;
#pragma unroll
        for (int dt = 0; dt < 4; ++dt) {
            const LAS bf16_t* vp = Vl + 16 * dt + fr;
            u32x4 vw;
            vw.x = (unsigned)vp[(ca + 0) * 72] | ((unsigned)vp[(ca + 1) * 72] << 16); vw.y = (unsigned)vp[(ca + 2) * 72] | ((unsigned)vp[(ca + 3) * 72] << 16);
            if (st < 4) { vw.z = (unsigned)vp[(cb + 0) * 72] | ((unsigned)vp[(cb + 1) * 72] << 16); vw.w = (unsigned)vp[(cb + 2) * 72] | ((unsigned)vp[(cb + 3) * 72] << 16); } else { vw.z = 0u; vw.w = 0u; }
            o[dt] = MFMA16(__builtin_bit_cast(bf16x8, vw), pf, o[dt]);
        }
    }
    float ssq = 0.f;
#pragma unroll
    for (int dt = 0; dt < 4; ++dt) {
        const f32x4 v = o[dt] * inv; ssq += (v[0] * v[0] + v[1] * v[1]) + (v[2] * v[2] + v[3] * v[3]);
        const f32x4 vg = v * *(const f32x4*)(a->in[18] + h * 64 + 16 * dt + 4 * fq) * MIX_SCALE;
        *(unsigned*)(a->ws + WS_H8 + qrow * DM + h * 64 + 16 * dt + 4 * fq) = pk4_fp8(vg[0], vg[1], vg[2], vg[3]);
    }
    ssq += __shfl_xor(ssq, 16); ssq += __shfl_xor(ssq, 32);
    if (fq == 0) SS[qrow * 24 + h] = ssq;
}
__device__ __forceinline__ void gmlp_item(KArgsPtr a, LAS unsigned char* lds, int item, int tid) {
    const int g = item & 7, ch = (item >> 3) & 15, b = item >> 7; const size_t r0 = (size_t)b * SEQ + ch * 128;
    const bf16_t* GV = (const bf16_t*)(a->ws + WS_GV); const bf16_t* U = (const bf16_t*)(a->ws + WS_U);
    bf16_t* MIX = (bf16_t*)(a->ws + WS_MIX); float* SS = (float*)(a->ws + WS_SS);
    LAS bf16_t* vT = (LAS bf16_t*)lds;
    const int w = __builtin_amdgcn_readfirstlane(tid >> 6), lane = tid & 63, fr = lane & 15, fq = lane >> 4;
    const int irow = 16 * w + fr;
    const int nks = (16 * w + 15) / 32 + 1;
    const float* Wrow = a->in[16] + ((size_t)g * 128 + irow) * 128;
    f32x4 wq[4][2];
#pragma unroll
    for (int ks = 0; ks < 4; ++ks) if (ks < nks) { wq[ks][0] = *(const f32x4*)(Wrow + ks * 32 + 8 * fq); wq[ks][1] = *(const f32x4*)(Wrow + ks * 32 + 8 * fq + 4); }
    const size_t row = r0 + irow;
    u32x2 uw[8];
#pragma unroll
    for (int ct = 0; ct < 8; ++ct) uw[ct] = *(const u32x2*)(U + row * 1024 + g * 128 + 16 * ct + 4 * fq);
    const float bsp = a->in[17][g * 128 + irow];
    {
        const int p = tid >> 2, qd = tid & 3;
        const u32x4* src = (const u32x4*)(GV + (r0 + p) * 1024 + g * 128 + 32 * qd);
        float x[32];
#pragma unroll
        for (int i = 0; i < 4; ++i) { const u32x4 rw = src[i];
            x[8 * i + 0] = bflo(rw.x); x[8 * i + 1] = bfhi(rw.x); x[8 * i + 2] = bflo(rw.y); x[8 * i + 3] = bfhi(rw.y);
            x[8 * i + 4] = bflo(rw.z); x[8 * i + 5] = bfhi(rw.z); x[8 * i + 6] = bflo(rw.w); x[8 * i + 7] = bfhi(rw.w); }
        float s = 0.f;
#pragma unroll
        for (int i = 0; i < 32; ++i) s += x[i];
        s += __shfl_xor(s, 1); s += __shfl_xor(s, 2);
        const float mean = s * (1.f / 128.f); float q = 0.f;
#pragma unroll
        for (int i = 0; i < 32; ++i) { x[i] -= mean; q += x[i] * x[i]; }
        q += __shfl_xor(q, 1); q += __shfl_xor(q, 2);
        const float rstd = 1.f / sqrtf(q * (1.f / 128.f) + LN_EPS);
        const float* gg = a->in[14] + g * 128 + 32 * qd; const float* gb = a->in[15] + g * 128 + 32 * qd;
#pragma unroll
        for (int i = 0; i < 32; i += 2) {
            const unsigned pr = pk2(x[i] * rstd * gg[i] + gb[i], x[i + 1] * rstd * gg[i + 1] + gb[i + 1]);
            vT[(32 * qd + i) * 136 + p] = (bf16_t)(pr & 0xffffu); vT[(32 * qd + i + 1) * 136 + p] = (bf16_t)(pr >> 16);
        }
    }
    __syncthreads();
    f32x4 acc[8];
#pragma unroll
    for (int ct = 0; ct < 8; ++ct) acc[ct] = (f32x4){0.f, 0.f, 0.f, 0.f};
#pragma unroll
    for (int ks = 0; ks < 4; ++ks) if (ks < nks) {
        const int j0 = ks * 32 + 8 * fq;
        const f32x4 w0 = wq[ks][0], w1 = wq[ks][1];
        const bf16x8 wf = pack8(j0 + 0 <= irow ? w0[0] : 0.f, j0 + 1 <= irow ? w0[1] : 0.f, j0 + 2 <= irow ? w0[2] : 0.f, j0 + 3 <= irow ? w0[3] : 0.f,
                                j0 + 4 <= irow ? w1[0] : 0.f, j0 + 5 <= irow ? w1[1] : 0.f, j0 + 6 <= irow ? w1[2] : 0.f, j0 + 7 <= irow ? w1[3] : 0.f);
#pragma unroll
        for (int ct = 0; ct < 8; ++ct) { const bf16x8 vf = *(const LAS bf16x8*)(vT + (16 * ct + fr) * 136 + ks * 32 + 8 * fq); acc[ct] = MFMA16(vf, wf, acc[ct]); }
    }
    float ssq = 0.f;
#pragma unroll
    for (int ct = 0; ct < 8; ++ct) {
        const float o0 = bflo(uw[ct].x) * (acc[ct][0] + bsp), o1 = bfhi(uw[ct].x) * (acc[ct][1] + bsp), o2 = bflo(uw[ct].y) * (acc[ct][2] + bsp), o3 = bfhi(uw[ct].y) * (acc[ct][3] + bsp);
        ssq += (o0 * o0 + o1 * o1) + (o2 * o2 + o3 * o3);
        const f32x4 og = *(const f32x4*)(a->in[18] + 1024 + g * 128 + 16 * ct + 4 * fq) * MIX_SCALE;
        *(unsigned*)(a->ws + WS_H8 + row * DM + 1024 + g * 128 + 16 * ct + 4 * fq) = pk4_fp8(o0 * og[0], o1 * og[1], o2 * og[2], o3 * og[3]);
    }
    ssq += __shfl_xor(ssq, 16); ssq += __shfl_xor(ssq, 32);
    if (fq == 0) SS[row * 24 + 16 + g] = ssq;
    __syncthreads();
}
__device__ __forceinline__ void sattn_wave(KArgsPtr a, LAS float* wl, int si, int lane) {
    const int bs = si >> 4, h = si & 15, kvh = h >> 2; const size_t row = MP + bs;
    const bf16_t* Q = (const bf16_t*)(a->ws + WS_Q); const bf16_t* Kb = (const bf16_t*)(a->ws + WS_K); const bf16_t* Vb = (const bf16_t*)(a->ws + WS_V);
    bf16_t* MIX = (bf16_t*)(a->ws + WS_MIX); float* SS = (float*)(a->ws + WS_SS);
    LAS float* ql = wl; LAS float* pl = wl + 64;
    const float qv = bf2f(Q[row * 1024 + h * 64 + lane]);
    ql[lane] = qv;
    const float dotnew = wave_sum(qv * bf2f(Kb[row * 256 + kvh * 64 + lane]));
    const float* ck = a->in[2] + (size_t)bs * 128 * 256 + kvh * 64; const float* cv = a->in[3] + (size_t)bs * 128 * 256 + kvh * 64;
    const int j0 = lane + 1, j1 = (lane + 65 < 128) ? (lane + 65) : 127;
    float s0 = 0.f, s1 = 0.f;
#pragma unroll
    for (int hf = 0; hf < 2; ++hf) {
        f32x4 k0[8], k1[8];
#pragma unroll
        for (int d4 = 0; d4 < 8; ++d4) { k0[d4] = *(const f32x4*)(ck + (size_t)j0 * 256 + 32 * hf + 4 * d4); k1[d4] = *(const f32x4*)(ck + (size_t)j1 * 256 + 32 * hf + 4 * d4); }
#pragma unroll
        for (int d4 = 0; d4 < 8; ++d4) {
            const f32x4 qq = *(const LAS f32x4*)(ql + 32 * hf + 4 * d4);
            s0 += (qq[0] * k0[d4][0] + qq[1] * k0[d4][1]) + (qq[2] * k0[d4][2] + qq[3] * k0[d4][3]);
            s1 += (qq[0] * k1[d4][0] + qq[1] * k1[d4][1]) + (qq[2] * k1[d4][2] + qq[3] * k1[d4][3]);
        }
    }
    if (lane == 63) s1 = dotnew;
    const float sink = a->in[13][h];
    const float mx = fmaxf(wave_max(fmaxf(s0, s1)), sink);
    const float p0 = __expf(s0 - mx), p1 = __expf(s1 - mx);
    const float denom = wave_sum(p0 + p1) + __expf(sink - mx);
    pl[lane] = p0; pl[lane + 64] = p1;
    float o = 0.f;
    const float vnew = bf2f(Vb[row * 256 + kvh * 64 + lane]);
    for (int jb = 0; jb < 128; jb += 32) {
        float vv[32];
#pragma unroll
        for (int u = 0; u < 32; ++u) { const int j = jb + u; vv[u] = cv[(size_t)(j < 127 ? j + 1 : 127) * 256 + lane]; }
#pragma unroll
        for (int u = 0; u < 32; ++u) { const int j = jb + u; o += pl[j] * (j < 127 ? vv[u] : vnew); }
    }
    o = o / denom;
    *(unsigned char*)(a->ws + WS_H8 + row * DM + h * 64 + lane) = (unsigned char)(pk4_fp8(o * a->in[18][h * 64 + lane] * MIX_SCALE, 0.f, 0.f, 0.f) & 0xffu);
    const float ss = wave_sum(o * o);
    if (lane == 0) SS[row * 24 + h] = ss;
}
__device__ __forceinline__ void sgmlp_wave(KArgsPtr a, int bs, int lane) {
    const size_t row = MP + bs;
    const bf16_t* GV = (const bf16_t*)(a->ws + WS_GV); const bf16_t* U = (const bf16_t*)(a->ws + WS_U);
    bf16_t* MIX = (bf16_t*)(a->ws + WS_MIX); float* SS = (float*)(a->ws + WS_SS);
    unsigned gwv[8], uwv[8]; float gn0[8], gn1[8], gb0[8], gb1[8], wsv[8], bsv[8], og0[8], og1[8];
#pragma unroll
    for (int g = 0; g < 8; ++g) {
        const int c = g * 128 + 2 * lane;
        gwv[g] = *(const unsigned*)(GV + row * 1024 + c); uwv[g] = *(const unsigned*)(U + row * 1024 + c);
        gn0[g] = a->in[14][c]; gn1[g] = a->in[14][c + 1]; gb0[g] = a->in[15][c]; gb1[g] = a->in[15][c + 1];
        wsv[g] = a->in[16][(size_t)g * 128 * 128]; bsv[g] = a->in[17][g * 128];
    }
#pragma unroll
    for (int g = 0; g < 8; ++g) {
        const int c = g * 128 + 2 * lane;
        float x0 = bflo(gwv[g]), x1 = bfhi(gwv[g]);
        const float mean = wave_sum(x0 + x1) * (1.f / 128.f); x0 -= mean; x1 -= mean;
        const float rstd = 1.f / sqrtf(wave_sum(x0 * x0 + x1 * x1) * (1.f / 128.f) + LN_EPS);
        const float v0 = x0 * rstd * gn0[g] + gb0[g], v1 = x1 * rstd * gn1[g] + gb1[g];
        a->out[OFF_GVS + (size_t)bs * 1024 + c] = v0; a->out[OFF_GVS + (size_t)bs * 1024 + c + 1] = v1;
        const float o0 = bflo(uwv[g]) * (wsv[g] * v0 + bsv[g]), o1 = bfhi(uwv[g]) * (wsv[g] * v1 + bsv[g]);
        *(unsigned short*)(a->ws + WS_H8 + row * DM + 1024 + c) = (unsigned short)(pk4_fp8(o0 * a->in[18][1024 + c] * MIX_SCALE, o1 * a->in[18][1024 + c + 1] * MIX_SCALE, 0.f, 0.f) & 0xffffu);
        const float ss = wave_sum(o0 * o0 + o1 * o1);
        if (lane == 0) SS[row * 24 + 16 + g] = ss;
    }
}
__device__ __forceinline__ void mix_phase(KArgsPtr a, LAS unsigned char* lds, int tid) {
    const int NA = 1024, NG = 512, NSA = 64, NSG = 4, NTOT = NA + NG + NSA + NSG;
    const int w = __builtin_amdgcn_readfirstlane(tid >> 6), lane = tid & 63;
    int it = blockIdx.x;
    {
        AttnRegs R, Rn;
        if (it < NA) attn_load(a, it, tid, R);
        while (it < NA) {
            attn_stage(lds, tid, R);
            __syncthreads();
            const int itn = it + gridDim.x;
            if (itn < NA) attn_load(a, itn, tid, Rn);
            attn_compute(a, lds, it, tid, R.qf);
            __syncthreads();
            R = Rn; it = itn;
        }
    }
    for (; it < NTOT; it += gridDim.x) {
        if (it < NA + NG) gmlp_item(a, lds, it - NA, tid);
        else if (it < NA + NG + NSA) sattn_wave(a, (LAS float*)(lds + w * 1024), (it - NA - NG) * 8 + w, lane);
        else sgmlp_wave(a, (it - NA - NG - NSA) * 8 + w, lane);
    }
}

#define XB_TMO      128
#define XB_XCNT(j)  (256  + 64 * (j))
#define XB_XSUB(j)  (1280 + 64 * (j))
#define XB_XGEN(j)  (2304 + 64 * (j))
#define XB_TOP      3328
#define XB_TOPGEN   3392
#define XCD_BAR_WORDS 3456
#define XB_SPIN_CAP (1u << 18)

__device__ __forceinline__ unsigned xb_ld(unsigned* p)              { return __hip_atomic_load(p, __ATOMIC_RELAXED, __HIP_MEMORY_SCOPE_AGENT); }
__device__ __forceinline__ unsigned xb_add(unsigned* p, unsigned v) { return __hip_atomic_fetch_add(p, v, __ATOMIC_RELAXED, __HIP_MEMORY_SCOPE_AGENT); }
__device__ __forceinline__ unsigned xb_xcc_id() { return (unsigned)__builtin_amdgcn_s_getreg((3 << 11) | 20) & 0xFu; }
#define XB_SPIN(cond, bar) do { unsigned _sp = 0; while (cond) { __builtin_amdgcn_s_sleep(1); \
    if ((++_sp & 255u) == 0u) { if (xb_ld(&(bar)[XB_TMO])) break; if (_sp > XB_SPIN_CAP) { atomicAdd(&(bar)[XB_TMO], 1u); break; } } } } while (0)

struct XcdBarrier {
    unsigned* bar; unsigned x;
    volatile LAS unsigned* st;
};

__device__ __forceinline__ XcdBarrier xcd_barrier_post(unsigned* bar, volatile LAS unsigned* st) {
    XcdBarrier b; b.bar = bar; b.x = xb_xcc_id(); b.st = st;
    if (threadIdx.x == 0) (void)xb_add(&bar[XB_XCNT(b.x)], 1u);
    return b;
}
__device__ __forceinline__ void xcd_barrier_complete(unsigned* bar, unsigned x, unsigned& nloc, unsigned& nx) {
    const unsigned G = gridDim.x * gridDim.y * gridDim.z;
    unsigned sum, cnt, mine, sp = 0u;
    for (;;) {
        sum = 0u; cnt = 0u; mine = 0u;
#pragma unroll
        for (unsigned j = 0; j < 16; ++j) { const unsigned c = xb_ld(&bar[XB_XCNT(j)]); sum += c; cnt += (c > 0u) ? 1u : 0u; mine = (j == x) ? c : mine; }
        if (sum == G) break;
        __builtin_amdgcn_s_sleep(1);
        if ((++sp & 255u) == 0u) { if (xb_ld(&bar[XB_TMO])) break; if (sp > XB_SPIN_CAP) { atomicAdd(&bar[XB_TMO], 1u); break; } }
    }
    nloc = mine > 0u ? mine : 1u; nx = cnt > 0u ? cnt : 1u;
}

__device__ __forceinline__ void xcd_barrier(const XcdBarrier& b) {
    asm volatile("s_waitcnt vmcnt(0)" ::: "memory");
    __syncthreads();
    if (threadIdx.x == 0) {
        unsigned* bar = b.bar;
        __builtin_amdgcn_s_waitcnt(0);
        unsigned nloc = b.st[0], nx = b.st[1];
        if (nloc == 0u) { xcd_barrier_complete(bar, b.x, nloc, nx); b.st[0] = nloc; b.st[1] = nx; }
        const unsigned old = xb_add(&bar[XB_XSUB(b.x)], 1u);
        const unsigned gen = old / nloc;
        if (old + 1u == (gen + 1u) * nloc) {
            __builtin_amdgcn_fence(__ATOMIC_RELEASE, "agent");
            asm volatile("s_waitcnt vmcnt(0)" ::: "memory");
            const unsigned og = xb_add(&bar[XB_TOP], 1u);
            const unsigned tg = og / nx;
            if (og + 1u == (tg + 1u) * nx) xb_add(&bar[XB_TOPGEN], 1u);
            else XB_SPIN(xb_ld(&bar[XB_TOPGEN]) == tg, bar);
            __builtin_amdgcn_fence(__ATOMIC_ACQUIRE, "agent");
            xb_add(&bar[XB_XGEN(b.x)], 1u);
            asm volatile("s_waitcnt vmcnt(0)" ::: "memory");
        } else {
            XB_SPIN(xb_ld(&bar[XB_XGEN(b.x)]) == gen, bar);
            __builtin_amdgcn_fence(__ATOMIC_ACQUIRE, "agent");
            asm volatile("s_waitcnt vmcnt(0)" ::: "memory");
        }
    }
    __syncthreads();
}

__device__ __forceinline__ int fresh_tid() { int t = threadIdx.x; asm volatile("" : "+v"(t)); return t; }
__device__ __forceinline__ KArgsPtr load_args() { KArgsPtr p = (KArgsPtr)__builtin_amdgcn_kernarg_segment_ptr(); asm volatile("" : "+s"(p)); return p; }
#define LA load_args()
__global__ void __launch_bounds__(512, 2) fwd(Args kernarg_only) {
    extern __shared__ __attribute__((aligned(16))) unsigned char lds_raw[];
    LAS unsigned char* lds = (LAS unsigned char*)lds_raw;
    cg::grid_group grid = cg::this_grid();
    volatile LAS unsigned* MISC = (volatile LAS unsigned*)(lds + 131072 + 320);
    if (threadIdx.x < 32) MISC[threadIdx.x] = 0u;
    __syncthreads();
    XcdBarrier xbar = xcd_barrier_post((unsigned*)(LA->ws + WS_CTL) + 4096, MISC + 8);
    if (gridDim.x == 0x7fffffffu) grid.sync();
#define GRID_SYNC() xcd_barrier(xbar)
    const int G = gridDim.x, c = blockIdx.x;
#define tid fresh_tid()
#define mod ((float*)(LA->ws + WS_MOD))
#define WUP ((bf16_t*)(LA->ws + WS_WUP))
#define WDN ((bf16_t*)(LA->ws + WS_WDN))
#define WIN ((bf16_t*)(LA->ws + WS_WIN))
#define WO ((bf16_t*)(LA->ws + WS_WO))
#define H ((bf16_t*)(LA->ws + WS_H))
#define ACT ((bf16_t*)(LA->ws + WS_ACT))
#define Y ((bf16_t*)(LA->ws + WS_Y))
#define PARTP ((float*)(LA->ws + WS_PART))
#define X1 ((bf16_t*)(LA->ws + WS_X1))

#ifndef NO_P0
    for (int rep = 0; rep <= DUP_P0; ++rep) { p0_phase(LA, lds, tid, rep); if (rep < DUP_P0) GRID_SYNC(); }
#endif
    GRID_SYNC();
#ifndef NO_ROW
    h0_phase(LA, tid);
#if DUP_ROW
    GRID_SYNC();
    h0_phase(LA, tid);
#endif
#endif
    GRID_SYNC();
#define UP_PHASE(l) { pg8::Gemm g{(const bf16_t*)(LA->ws + WS_H8), (const bf16_t*)(LA->ws + WS_WUP + (size_t)(l) * WUP_ELEMS), MPAD, NUP, DM / 2}; pg8::StaticOrder S; S.init(MPAD, NUP, G, c); EpiSwiGLU E{LA->ws + WS_ACT}; \
      pg8::gemm_phase<EpiSwiGLU, pg8::StaticOrder, true, true, true>(lds, g, S, E);       \
      { const int rem = ((MPAD / 256) * (NUP / 256)) % G; if (rem != 0 && c >= rem) tr_deferred(LA, lds, tid, 2 * I_UP + (l) * I_DN, I_DN, c - rem, G - rem); else if (rem == 0) tr_deferred(LA, lds, tid, 2 * I_UP + (l) * I_DN, I_DN, c, G); } }
#define DOWN_PHASE(l, sub, xres, XB) { pg8::Gemm g{(const bf16_t*)(LA->ws + WS_ACT), (const bf16_t*)(LA->ws + WS_WDN + (size_t)(l) * WDN8_BYTES), MP, DM, DFFP / 2}; pg8::StaticOrder S; S.init(MP, DM, G, c); \
      EpiResid<XB> E{xres, Y, mod + (sub) * 6144 + 4096, 0.5f / (W_DN_SCALE * ACT_SCALE)}; \
      small_part<true>(lds, tid, LA->ws + WS_ACT + (size_t)MP * DFFP, LA->ws + WS_WDN + (size_t)(l) * WDN8_BYTES, DFFP, PARTP); \
      pg8::gemm_phase<EpiResid<XB>, pg8::StaticOrder, true, true, true>(lds, g, S, E); }
#ifndef NO_UP
    UP_PHASE(0)
#if DUP_UP
    GRID_SYNC();
    UP_PHASE(0)
#endif
#endif
    GRID_SYNC();
#ifndef NO_DN
    DOWN_PHASE(0, 0, LA->in[0], false)
#if DUP_DN
    GRID_SYNC();
    DOWN_PHASE(0, 0, LA->in[0], false)
#endif
#endif
    GRID_SYNC();
#ifndef NO_ROW
    ln_phase(LA, lds, tid, 0, false, 1);
#if DUP_ROW
    GRID_SYNC();
    ln_phase(LA, lds, tid, 0, false, 1);
#endif
#endif
    GRID_SYNC();
    { pg8::Gemm g{H, WIN, MPAD, INW, DM}; pg8::StaticOrder S; S.init(MPAD, INW, G, c);
      EpiInProj E{(bf16_t*)(LA->ws + WS_Q), (bf16_t*)(LA->ws + WS_K), (bf16_t*)(LA->ws + WS_V), (bf16_t*)(LA->ws + WS_U), (bf16_t*)(LA->ws + WS_GV), (const float*)(LA->ws + WS_ROPE), LA->out};

#ifndef NO_IN
      pg8::gemm_phase<EpiInProj, pg8::StaticOrder, true, true>(lds, g, S, E);
#endif
      { const int rem = ((MPAD / 256) * (INW / 256)) % G; const int bi_ = rem != 0 ? c - rem : c, nb_ = rem != 0 ? G - rem : G;
        if (rem == 0 || c >= rem) { tr_deferred(LA, lds, tid, 2 * I_UP + 2 * I_DN + I_IN, I_WO, bi_, nb_); tr_deferred(LA, lds, tid, 2 * I_UP - N_UP1_DEF, N_UP1_DEF, bi_, nb_); } }
    }
    GRID_SYNC();
#ifndef NO_MIX
    mix_phase(LA, lds, tid);
#if DUP_MIX
    GRID_SYNC();
    mix_phase(LA, lds, tid);
#endif
#endif
    GRID_SYNC();
#ifndef NO_WO
    { pg8::Gemm g{(const bf16_t*)(LA->ws + WS_H8), (const bf16_t*)(LA->ws + WS_WO), MP, DM, DM / 2}; pg8::StaticOrder S; S.init(MP, DM, G, c);
      LAS float* rs = (LAS float*)(lds + 131072 + 1024);
      rs_table(LA, rs, S, tid);
      EpiResidMix E{X1, Y, mod + 1 * 6144 + 4096, rs};
      small_part<true>(lds, tid, LA->ws + WS_H8 + (size_t)MP * DM, LA->ws + WS_WO, DM, PARTP);
      pg8::gemm_phase<EpiResidMix, pg8::StaticOrder, true, true, true>(lds, g, S, E); }
#endif
    GRID_SYNC();
#ifndef NO_ROW
    ln_phase(LA, lds, tid, 1, false, 2);
#endif
    GRID_SYNC();
#ifndef NO_UP
    UP_PHASE(1)
#if DUP_UP
    GRID_SYNC();
    UP_PHASE(1)
#endif
#endif
    GRID_SYNC();
#ifndef NO_DN
    DOWN_PHASE(1, 2, X1, true)
#if DUP_DN
    GRID_SYNC();
    DOWN_PHASE(1, 2, X1, true)
#endif
#endif
    GRID_SYNC();
#ifndef DUP_SYNC
#define DUP_SYNC 0
#endif
    for (int i = 0; i < DUP_SYNC; ++i) GRID_SYNC();
    ln_phase(LA, lds, tid, 2, true, 0);
#if DUP_ROW
    GRID_SYNC();
    ln_phase(LA, lds, tid, 2, true, 0);
#endif
#undef tid
#undef mod
#undef WUP
#undef WDN
#undef WIN
#undef WO
#undef H
#undef ACT
#undef Y
#undef X1
}

extern "C" void kernel_launch(void* const* d_in, const int* in_sizes, int n_in, void* d_out, int out_size, void* d_ws, size_t ws_size, hipStream_t stream) {
    static int grid = 0;
    if (grid == 0) {
        if (n_in != 20 || ws_size < WS_END) { fprintf(stderr, "kernel_launch: unexpected n_in %d / ws %zu\n", n_in, ws_size); grid = -1; return; }
        int dev = 0, cus = 0, per_cu = 0;
        if (hipGetDevice(&dev) != hipSuccess || hipDeviceGetAttribute(&cus, hipDeviceAttributeMultiprocessorCount, dev) != hipSuccess) { grid = -1; return; }
        if (hipFuncSetAttribute((const void*)fwd, hipFuncAttributeMaxDynamicSharedMemorySize, LDS_BYTES) != hipSuccess) { fprintf(stderr, "kernel_launch: hipFuncSetAttribute failed\n"); grid = -1; return; }
        if (hipOccupancyMaxActiveBlocksPerMultiprocessor(&per_cu, (const void*)fwd, 512, LDS_BYTES) != hipSuccess || per_cu < 1) { fprintf(stderr, "kernel_launch: occupancy query says %d\n", per_cu); }
        (void)hipGetLastError();
        grid = cus;
    }
    if (grid < 0) return;
    (void)hipMemsetAsync((char*)d_ws + WS_CTL, 0, 65536, stream);
    Args a{};
    for (int i = 0; i < 20; ++i) a.in[i] = (const float*)d_in[i];
    a.out = (float*)d_out; a.ws = (unsigned char*)d_ws;
    void* args[] = {&a};
    hipError_t e = hipLaunchCooperativeKernel((const void*)fwd, dim3(grid), dim3(512), args, LDS_BYTES, stream);
    if (e != hipSuccess) fprintf(stderr, "kernel_launch: cooperative launch failed: %s (grid %d)\n", hipGetErrorString(e), grid);
}
```

```cpp
#include <hip/hip_runtime.h>
#include <hip/hip_cooperative_groups.h>
#include <cstdio>
#include <cstdint>
namespace cg = cooperative_groups;
#ifndef DUP_P0
#define DUP_P0 0
#endif
#ifndef DUP_UP
#define DUP_UP 0
#endif
#ifndef DUP_DN
#define DUP_DN 0
#endif
#ifndef DUP_MIX
#define DUP_MIX 0
#endif
#ifndef DUP_IN
#define DUP_IN 0
#endif
#ifndef DUP_WO
#define DUP_WO 0
#endif
#ifndef DUP_ROW
#define DUP_ROW 0
#endif
namespace pg8 {
#define PG8_LAS __attribute__((address_space(3)))
typedef unsigned short bf16_t;
typedef short bf16x8 __attribute__((ext_vector_type(8)));
typedef float f32x4 __attribute__((ext_vector_type(4)));
typedef unsigned u32x4 __attribute__((ext_vector_type(4)));
constexpr int BM = 256, BK = 64, HALF = 128, HTB = HALF * BK * 2  , STAGE_BYTES = 8 * HTB, NXCD = 8, WGM = 8;

__host__ __device__ __forceinline__ int lds_byte(int r, int c) { const int st = (r >> 4) * 2 + (c >> 5), rr = r & 15, cc = c & 31, ob = rr * 64 + cc * 2; return st * 1024 + (ob ^ (((ob >> 9) & 1) << 5)); }
__host__ __device__ __forceinline__ void stage_rc(int b, int& R, int& C) { const int st = b / 1024, sb = b % 1024, swz = sb ^ (((sb >> 9) & 1) << 5); R = (st >> 1) * 16 + swz / 64; C = (st & 1) * 32 + (swz % 64) / 2; }
__host__ __device__ __forceinline__ int perm32(int rho) { const int n = rho >> 4, i = rho & 15; return 8 * (i >> 2) + 4 * n + (i & 3); }

struct Unit { int pm, pn; };
struct Gemm { const bf16_t* A; const bf16_t* Bt; int M, N, K; };

struct StaticOrder {
    int nM, nN, nwg, G, c;
    __host__ __device__ void init(int M, int N, int G_, int c_) { nM = M / BM; nN = N / BM; nwg = nM * nN; G = G_; c = c_; }
    __host__ __device__ bool next(int i, Unit& u) const {
        const long L = (long)i * G + c; if (L >= nwg) return false;
        int wgid = (int)L; { const int q = nwg / NXCD, r = nwg % NXCD, xcd = wgid % NXCD, off = wgid / NXCD; wgid = (xcd < r ? xcd * (q + 1) : r * (q + 1) + (xcd - r) * q) + off; }
        const int nig = WGM * nN, gid = wgid / nig, fm = gid * WGM, gsz = (nM - fm) < WGM ? (nM - fm) : WGM;
        u.pm = fm + ((wgid % nig) % gsz); u.pn = (wgid % nig) / gsz; return true;
    }
    __device__ __forceinline__ void a_ready(const Unit&) const {}
    __device__ __forceinline__ void done(const Unit&) const {}
};

__device__ __forceinline__ unsigned cvt_pk_bf16(float lo, float hi) { unsigned r; asm volatile("v_cvt_pk_bf16_f32 %0, %1, %2" : "=v"(r) : "v"(lo), "v"(hi)); return r; }
typedef int i32x4v __attribute__((ext_vector_type(4)));
typedef int i32x8v __attribute__((ext_vector_type(8)));
__device__ __forceinline__ f32x4 mma_fp8(const bf16x8 (&a)[2], const bf16x8 (&b)[2], f32x4 c) {
    const i32x8v A = __builtin_shufflevector(__builtin_bit_cast(i32x4v, a[0]), __builtin_bit_cast(i32x4v, a[1]), 0, 1, 2, 3, 4, 5, 6, 7);
    const i32x8v B = __builtin_shufflevector(__builtin_bit_cast(i32x4v, b[0]), __builtin_bit_cast(i32x4v, b[1]), 0, 1, 2, 3, 4, 5, 6, 7);
    asm volatile("v_mfma_f32_16x16x128_f8f6f4 %0, %1, %2, %0" : "+v"(c) : "v"(A), "v"(B));
    return c;
}
template <class Epi, class Sched, bool ALIGN_EPI = false, bool SP2 = false, bool FP8 = false>
__device__ __forceinline__ void gemm_phase(PG8_LAS unsigned char* lds, const Gemm g, const Sched& S, const Epi& E) {
    int tid_ = threadIdx.x; asm volatile("" : "+v"(tid_));
    const int tid = tid_, wid = __builtin_amdgcn_readfirstlane(tid >> 6), lane = tid & 63, wr = wid >> 2, wc = wid & 3, fr = lane & 15, fq = lane >> 4;
    const int K = g.K, nt = K / BK;
    unsigned voffA[2], voffB[2];
#pragma unroll
    for (int i = 0; i < 2; ++i) { int R, C; stage_rc(tid * 16 + i * 8192, R, C); const int Rb = Epi::PERM ? ((R & ~31) + perm32(R & 31)) : R;
        voffA[i] = (unsigned)(R * K + C) * 2u; voffB[i] = (unsigned)(Rb * K + C) * 2u; }
    const size_t kstep = (size_t)(BK * 2);
    const size_t hstep = (size_t)HALF * K * 2;
    const size_t tstep = 2 * hstep;
    const unsigned ldsw = (unsigned)wid * 1024u;
    const int aoff = lds_byte(wr * 64 + fr, fq * 8), boff = lds_byte(wc * 32 + fr, fq * 8);
#define PG8_SA(b, h) (((b) * 2 + (h)) * HTB)
#define PG8_SB(b, h) ((4 + (b) * 2 + (h)) * HTB)
#define PG8_STAGE(bufoff, gbase, voff) do { _Pragma("unroll") for (int _i = 0; _i < 2; ++_i) \
        __builtin_amdgcn_global_load_lds((const unsigned*)((const char*)(gbase) + (voff)[_i]), (PG8_LAS unsigned*)(lds + (bufoff) + ldsw + _i * 8192), 16, 0, 0); } while (0)
#define PG8_LDA(dst, b, h) do { _Pragma("unroll") for (int m = 0; m < 4; ++m) _Pragma("unroll") for (int k = 0; k < 2; ++k) dst[m][k] = *(const PG8_LAS bf16x8*)(lds + PG8_SA(b, h) + aoff + m * 2048 + k * 1024); } while (0)
#define PG8_LDB(dst, b, h) do { _Pragma("unroll") for (int n = 0; n < 2; ++n) _Pragma("unroll") for (int k = 0; k < 2; ++k) dst[n][k] = *(const PG8_LAS bf16x8*)(lds + PG8_SB(b, h) + boff + n * 2048 + k * 1024); } while (0)
#define PG8_MMA(ai, bj, At, Bt) do { __builtin_amdgcn_s_setprio(1); \
        if constexpr (FP8) { _Pragma("unroll") for (int m = 0; m < 4; ++m) _Pragma("unroll") for (int n = 0; n < 2; ++n) acc[ai][bj][m][n] = mma_fp8(Bt[n], At[m], acc[ai][bj][m][n]); } \
        else { _Pragma("unroll") for (int m = 0; m < 4; ++m) _Pragma("unroll") for (int n = 0; n < 2; ++n) _Pragma("unroll") for (int k = 0; k < 2; ++k) \
        acc[ai][bj][m][n] = __builtin_amdgcn_mfma_f32_16x16x32_bf16(Bt[n][k], At[m][k], acc[ai][bj][m][n], 0, 0, 0); } __builtin_amdgcn_s_setprio(0); } while (0)
#define PG8_WAIT_V(n) asm volatile("s_waitcnt vmcnt(" #n ")" ::: "memory")
#define PG8_WAIT_L(n) asm volatile("s_waitcnt lgkmcnt(" #n ")" ::: "memory")
#define PG8_BAR __builtin_amdgcn_s_barrier()
#define PG8_SCHED __builtin_amdgcn_sched_barrier(0)
    Unit cur, nxt; int ui = 0;
    if (!S.next(0, cur)) return;
    f32x4 acc[2][2][4][2];
#pragma unroll
    for (int a = 0; a < 2; ++a)
#pragma unroll
        for (int b = 0; b < 2; ++b)
#pragma unroll
            for (int m = 0; m < 4; ++m)
#pragma unroll
                for (int n = 0; n < 2; ++n) acc[a][b][m][n] = (f32x4){0.f, 0.f, 0.f, 0.f};
    bf16x8 At[4][2], B0[2][2], B1[2][2];
    const char* cA = (const char*)g.A + (size_t)cur.pm * tstep; const char* cB = (const char*)g.Bt + (size_t)cur.pn * tstep;
    S.a_ready(cur);
    if constexpr (SP2) {
        PG8_STAGE(PG8_SB(0, 0), cB, voffB); PG8_STAGE(PG8_SB(0, 1), cB + hstep, voffB); PG8_STAGE(PG8_SA(0, 0), cA, voffA); PG8_STAGE(PG8_SA(0, 1), cA + hstep, voffA);
        if (wr == 1) PG8_BAR;
        PG8_WAIT_V(2); PG8_BAR;
        PG8_STAGE(PG8_SB(1, 0), cB + kstep, voffB); PG8_STAGE(PG8_SA(1, 0), cA + kstep, voffA); PG8_STAGE(PG8_SB(1, 1), cB + hstep + kstep, voffB);
        PG8_WAIT_V(6); PG8_BAR;
    } else {
        PG8_STAGE(PG8_SB(0, 0), cB, voffB); PG8_STAGE(PG8_SA(0, 0), cA, voffA); PG8_STAGE(PG8_SB(0, 1), cB + hstep, voffB); PG8_STAGE(PG8_SA(0, 1), cA + hstep, voffA);
        if (wr == 1) PG8_BAR;
        PG8_WAIT_V(4); PG8_BAR;
        PG8_STAGE(PG8_SB(1, 0), cB + kstep, voffB); PG8_STAGE(PG8_SA(1, 0), cA + kstep, voffA); PG8_STAGE(PG8_SB(1, 1), cB + hstep + kstep, voffB);
        PG8_WAIT_V(6); PG8_BAR;
    }
    for (;;) {
        const bool has_next = S.next(ui + 1, nxt);
        const char* nA = has_next ? (const char*)g.A + (size_t)nxt.pm * tstep : cA; const char* nB = has_next ? (const char*)g.Bt + (size_t)nxt.pn * tstep : cB;
        for (int t = 0; t < nt; t += 2) {
            if constexpr (Epi::MIDK) { if (t == nt / 2) E.mid(acc, ui, wr, fr); }
            const bool last = (t == nt - 2);
            const char* a1 = cA + (size_t)(t + 1) * kstep;
            const char* a2 = last ? nA : cA + (size_t)(t + 2) * kstep; const char* b2 = last ? nB : cB + (size_t)(t + 2) * kstep;
            const char* a3 = a2 + kstep; const char* b3 = b2 + kstep;
            if (last && has_next) S.a_ready(nxt);
            if constexpr (SP2) {
            PG8_LDB(B0, 0, 0); PG8_LDB(B1, 0, 1); PG8_SCHED; PG8_LDA(At, 0, 0); PG8_STAGE(PG8_SA(1, 1), a1 + hstep, voffA);
            PG8_WAIT_V(8); PG8_WAIT_L(0); PG8_BAR; PG8_MMA(0, 0, At, B0); PG8_MMA(0, 1, At, B1); PG8_BAR; PG8_SCHED;
            PG8_LDA(At, 0, 1); PG8_STAGE(PG8_SB(0, 0), b2, voffB); PG8_STAGE(PG8_SB(0, 1), b2 + hstep, voffB); PG8_STAGE(PG8_SA(0, 0), a2, voffA);
            PG8_WAIT_V(8); PG8_WAIT_L(0); PG8_BAR; PG8_MMA(1, 0, At, B0); PG8_MMA(1, 1, At, B1); PG8_BAR; PG8_SCHED;
            PG8_LDB(B0, 1, 0); PG8_LDB(B1, 1, 1); PG8_SCHED; PG8_LDA(At, 1, 0); PG8_STAGE(PG8_SA(0, 1), a2 + hstep, voffA);
            PG8_WAIT_V(8); PG8_WAIT_L(0); PG8_BAR; PG8_MMA(0, 0, At, B0); PG8_MMA(0, 1, At, B1); PG8_BAR; PG8_SCHED;
            PG8_LDA(At, 1, 1); PG8_STAGE(PG8_SB(1, 0), b3, voffB); PG8_STAGE(PG8_SB(1, 1), b3 + hstep, voffB); PG8_STAGE(PG8_SA(1, 0), a3, voffA);
            PG8_WAIT_V(8); PG8_WAIT_L(0); PG8_BAR; PG8_MMA(1, 0, At, B0); PG8_MMA(1, 1, At, B1); PG8_BAR; PG8_SCHED;
            } else {
            PG8_LDB(B0, 0, 0); PG8_SCHED; PG8_LDA(At, 0, 0); PG8_STAGE(PG8_SA(1, 1), a1 + hstep, voffA);
            PG8_WAIT_L(8); PG8_BAR; PG8_WAIT_L(0); PG8_MMA(0, 0, At, B0); PG8_BAR; PG8_SCHED;
            PG8_LDB(B1, 0, 1); PG8_STAGE(PG8_SB(0, 0), b2, voffB);
            PG8_BAR; PG8_WAIT_L(0); PG8_MMA(0, 1, At, B1); PG8_BAR;
            PG8_LDA(At, 0, 1); PG8_STAGE(PG8_SA(0, 0), a2, voffA);
            PG8_BAR; PG8_WAIT_L(0); PG8_MMA(1, 0, At, B0); PG8_BAR; PG8_SCHED;
            PG8_STAGE(PG8_SB(0, 1), b2 + hstep, voffB);
            PG8_WAIT_V(6); PG8_BAR; PG8_MMA(1, 1, At, B1); PG8_BAR;
            PG8_LDB(B0, 1, 0); PG8_SCHED; PG8_LDA(At, 1, 0); PG8_STAGE(PG8_SA(0, 1), a2 + hstep, voffA);
            PG8_WAIT_L(8); PG8_BAR; PG8_WAIT_L(0); PG8_MMA(0, 0, At, B0); PG8_BAR; PG8_SCHED;
            PG8_LDB(B1, 1, 1); PG8_STAGE(PG8_SB(1, 0), b3, voffB);
            PG8_BAR; PG8_WAIT_L(0); PG8_MMA(0, 1, At, B1); PG8_BAR;
            PG8_LDA(At, 1, 1); PG8_STAGE(PG8_SA(1, 0), a3, voffA);
            PG8_BAR; PG8_WAIT_L(0); PG8_MMA(1, 0, At, B0); PG8_BAR; PG8_SCHED;
            PG8_STAGE(PG8_SB(1, 1), b3 + hstep, voffB);
            PG8_WAIT_V(6); PG8_BAR; PG8_MMA(1, 1, At, B1); PG8_BAR;
            }
        }
        if constexpr (FP8) asm volatile("s_nop 15\n\ts_nop 15\n\ts_nop 15\n\ts_nop 15" ::: "memory");
        if constexpr (ALIGN_EPI) { if (wr == 0) PG8_BAR; }
        if constexpr (!Epi::AFTER_DRAIN) { if constexpr (Epi::MIDK) E(acc, cur, wr, wc, fr, fq, ui); else E(acc, cur, wr, wc, fr, fq); S.done(cur); }
        if (!has_next) break;
#pragma unroll
        for (int a = 0; a < 2; ++a)
#pragma unroll
            for (int b = 0; b < 2; ++b)
#pragma unroll
                for (int m = 0; m < 4; ++m)
#pragma unroll
                    for (int n = 0; n < 2; ++n) acc[a][b][m][n] = (f32x4){0.f, 0.f, 0.f, 0.f};
        cur = nxt; cA = nA; cB = nB; ++ui;
        if constexpr (ALIGN_EPI) { if (wr == 1) PG8_BAR; }
    }
    PG8_WAIT_V(0);
    if constexpr (!ALIGN_EPI) { if (wr == 0) PG8_BAR; }
    PG8_BAR;
    if constexpr (Epi::AFTER_DRAIN) { E.fused(acc, cur, wr, wc, fr, fq, lds, wid, lane); S.done(cur); }
#undef PG8_SA
#undef PG8_SB
#undef PG8_STAGE
#undef PG8_LDA
#undef PG8_LDB
#undef PG8_MMA
#undef PG8_WAIT_V
#undef PG8_WAIT_L
#undef PG8_BAR
#undef PG8_SCHED
}
}
#define LAS __attribute__((address_space(3)))
typedef unsigned short bf16_t;
typedef short bf16x8 __attribute__((ext_vector_type(8)));
typedef float f32x4 __attribute__((ext_vector_type(4)));
typedef float f32x16 __attribute__((ext_vector_type(16)));
typedef unsigned u32x4 __attribute__((ext_vector_type(4)));
typedef unsigned u32x2 __attribute__((ext_vector_type(2)));

constexpr int DM = 2048, SEQ = 2048, MP = 8192, NS = 32, MT = MP + NS, MPAD = 8448;
constexpr int DFF = 5504, NUP = 2 * DFF, INW = 3584, NMOD = 18432, NC = 36;
constexpr int DFFP = 5632;
constexpr float W_UP_SCALE = 32.f, W_DN_SCALE = 64.f, ACT_SCALE = 4.f, W_O_SCALE = 64.f, MIX_SCALE = 4.f;
constexpr float ALPHA = 1.189207115002721f;
constexpr float LN_EPS = 1e-5f;
constexpr int LDS_BYTES = 147456;
constexpr size_t OFF_YP = 0, OFF_YS = 16777216, OFF_KWP = OFF_YS + 65536, OFF_VWP = OFF_KWP + 131072, OFF_KWS = OFF_VWP + 131072, OFF_VWS = OFF_KWS + 1048576, OFF_GVS = OFF_VWS + 1048576;
constexpr size_t MiB = 1u << 20;
constexpr size_t WS_CTL = 0, WS_MOD = 1 * MiB, WS_ROPE = 4 * MiB, WS_SS = 5 * MiB, WS_WUP = 8 * MiB, WS_WDN = 96 * MiB, WS_WIN = 140 * MiB, WS_WO = 154 * MiB,
                 WS_H = 162 * MiB, WS_ACT = 196 * MiB, WS_Y = 286 * MiB, WS_X1 = 352 * MiB, WS_Q = 418 * MiB, WS_U = 436 * MiB, WS_GV = 453 * MiB, WS_K = 470 * MiB, WS_V = 475 * MiB,
                 WS_MIX = 480 * MiB, WS_H8 = 514 * MiB, WS_END = 532 * MiB;
constexpr size_t WS_STATS = WS_SS + 917504;
constexpr size_t WS_PART = WS_Y + 40 * MiB;
constexpr size_t WUP_ELEMS = (size_t)NUP * DM, WDN_ELEMS = (size_t)DM * DFF, WDN8_BYTES = (size_t)DM * DFFP;

struct Args { const float* in[20]; float* out; unsigned char* ws; };
typedef const Args __attribute__((address_space(4)))* KArgsPtr;

__device__ __forceinline__ unsigned pk2(float lo, float hi) { return pg8::cvt_pk_bf16(lo, hi); }
__device__ __forceinline__ float bf2f(unsigned short b) { return __builtin_bit_cast(float, (unsigned)b << 16); }
__device__ __forceinline__ float bflo(unsigned w) { return __builtin_bit_cast(float, w << 16); }
__device__ __forceinline__ float bfhi(unsigned w) { return __builtin_bit_cast(float, w & 0xffff0000u); }
__device__ __forceinline__ float wave_sum(float v) {
#pragma unroll
    for (int o = 1; o < 64; o <<= 1) v += __shfl_xor(v, o);
    return v;
}
__device__ __forceinline__ float wave_max(float v) {
#pragma unroll
    for (int o = 1; o < 64; o <<= 1) v = fmaxf(v, __shfl_xor(v, o));
    return v;
}
__device__ __forceinline__ float silu_f(float g) { return g * __builtin_amdgcn_rcpf(1.f + __expf(-g)); }
__device__ __forceinline__ float gelu_f(float x) { const float t = 1.5957691216057308f * (x + 0.044715f * x * x * x); return x * __builtin_amdgcn_rcpf(1.f + __expf(-t)); }
__device__ __forceinline__ bf16x8 pack8(float a0, float a1, float a2, float a3, float a4, float a5, float a6, float a7) {
    u32x4 w; w.x = pk2(a0, a1); w.y = pk2(a2, a3); w.z = pk2(a4, a5); w.w = pk2(a6, a7); return __builtin_bit_cast(bf16x8, w);
}
__device__ __forceinline__ unsigned pk4_fp8(float a, float b, float c, float d) { return (unsigned)__builtin_amdgcn_cvt_pk_fp8_f32(c, d, __builtin_amdgcn_cvt_pk_fp8_f32(a, b, 0, false), true); }
#define MFMA16(A, B, C) __builtin_amdgcn_mfma_f32_16x16x32_bf16((A), (B), (C), 0, 0, 0)

using pg8::Unit;
struct EpiSwiGLU {
    static constexpr bool PERM = true, AFTER_DRAIN = false, MIDK = false;
    unsigned char* O;
    __device__ __forceinline__ void operator()(const f32x4 (&acc)[2][2][4][2], const Unit& u, int wr, int wc, int fr, int fq) const {
        const int row0 = u.pm * 256 + wr * 64 + fr, col0 = u.pn * 128 + wc * 32 + 8 * fq;
        constexpr float IS = 1.f / W_UP_SCALE, OS = ACT_SCALE / W_UP_SCALE;
#pragma unroll
        for (int ai = 0; ai < 2; ++ai)
#pragma unroll
            for (int m = 0; m < 4; ++m) {
                unsigned char* rowp = O + (unsigned)(row0 + ai * 128 + m * 16) * (unsigned)DFFP + (unsigned)col0;
                const f32x4 v0 = acc[ai][0][m][0] * OS, v1 = acc[ai][0][m][1] * OS, g0 = acc[ai][1][m][0] * IS, g1 = acc[ai][1][m][1] * IS;
                u32x2 w;
                w.x = pk4_fp8(silu_f(g0[0]) * v0[0], silu_f(g0[1]) * v0[1], silu_f(g0[2]) * v0[2], silu_f(g0[3]) * v0[3]);
                w.y = pk4_fp8(silu_f(g1[0]) * v1[0], silu_f(g1[1]) * v1[1], silu_f(g1[2]) * v1[2], silu_f(g1[3]) * v1[3]);
                *(u32x2*)rowp = w;
            }
    }
};
template <int XB  > struct EpiResid {
    static constexpr bool PERM = false, AFTER_DRAIN = false, MIDK = false;
    const void* xres; bf16_t* Y; const float* gate; static constexpr float coef = 0.5f / (W_DN_SCALE * ACT_SCALE);
    const float* lng; const float* lnb; const float* stats;
    __device__ __forceinline__ void operator()(const f32x4 (&acc)[2][2][4][2], const Unit& u, int wr, int wc, int fr, int fq) const {
        const int b = u.pm >> 3, col0 = u.pn * 256 + wc * 32 + 4 * fq, row0 = u.pm * 256 + wr * 64 + fr;
        f32x4 g4[2][2];
#pragma unroll
        for (int bj = 0; bj < 2; ++bj)
#pragma unroll
            for (int n = 0; n < 2; ++n) g4[bj][n] = *(const f32x4*)(gate + (size_t)b * NMOD + col0 + bj * 128 + n * 16) * coef;
        f32x4 lg[2][2], lb[2][2];
        if (XB == 2) {
#pragma unroll
            for (int bj = 0; bj < 2; ++bj)
#pragma unroll
                for (int n = 0; n < 2; ++n) { lg[bj][n] = *(const f32x4*)(lng + col0 + bj * 128 + n * 16); lb[bj][n] = *(const f32x4*)(lnb + col0 + bj * 128 + n * 16); }
        }
#pragma unroll
        for (int ai = 0; ai < 2; ++ai)
#pragma unroll
            for (int m = 0; m < 4; ++m) {
                const unsigned off = (unsigned)(row0 + ai * 128 + m * 16) * (unsigned)DM + (unsigned)col0;
                float mu = 0.f, rs_ = 1.f;
                if (XB == 2) { const unsigned r = (unsigned)(row0 + ai * 128 + m * 16); mu = stats[2 * r]; rs_ = stats[2 * r + 1]; }
#pragma unroll
                for (int bj = 0; bj < 2; ++bj)
#pragma unroll
                    for (int n = 0; n < 2; ++n) {
                        f32x4 xr;
                        if (XB == 2) { const u32x2 yw = *(const u32x2*)(Y + off + bj * 128 + n * 16); xr = ((f32x4){bflo(yw.x), bfhi(yw.x), bflo(yw.y), bfhi(yw.y)} - mu) * rs_ * lg[bj][n] + lb[bj][n]; }
                        else if (XB == 1) { const u32x2 xw = *(const u32x2*)((const bf16_t*)xres + off + bj * 128 + n * 16); xr = (f32x4){bflo(xw.x), bfhi(xw.x), bflo(xw.y), bfhi(xw.y)}; }
                        else xr = *(const f32x4*)((const float*)xres + off + bj * 128 + n * 16);
                        const f32x4 y = xr * ALPHA + g4[bj][n] * acc[ai][bj][m][n]; u32x2 wv; wv.x = pk2(y[0], y[1]); wv.y = pk2(y[2], y[3]);
                        *(u32x2*)(Y + off + bj * 128 + n * 16) = wv;
                    }
            }
    }
};
struct EpiResidMix {
    static constexpr bool PERM = false, AFTER_DRAIN = false, MIDK = true;
    bf16_t* Y; const float* gate; const LAS float* rs; const float* lng; const float* lnb; const float* stats;
    __device__ __forceinline__ void mid(f32x4 (&acc)[2][2][4][2], int ui, int wr, int fr) const {
#pragma unroll
        for (int ai = 0; ai < 2; ++ai)
#pragma unroll
            for (int m = 0; m < 4; ++m) {
                const float f = rs[((ui & 3) * 256 + ai * 128 + wr * 64 + m * 16 + fr) * 2];
#pragma unroll
                for (int bj = 0; bj < 2; ++bj)
#pragma unroll
                    for (int n = 0; n < 2; ++n) acc[ai][bj][m][n] = acc[ai][bj][m][n] * f;
            }
    }
    __device__ __forceinline__ void operator()(const f32x4 (&acc)[2][2][4][2], const Unit& u, int wr, int wc, int fr, int fq, int ui) const {
        const int b = u.pm >> 3, col0 = u.pn * 256 + wc * 32 + 4 * fq, row0 = u.pm * 256 + wr * 64 + fr;
        f32x4 g4[2][2];
#pragma unroll
        for (int bj = 0; bj < 2; ++bj)
#pragma unroll
            for (int n = 0; n < 2; ++n) g4[bj][n] = *(const f32x4*)(gate + (size_t)b * NMOD + col0 + bj * 128 + n * 16) * (1.0f / (W_O_SCALE * MIX_SCALE));
        f32x4 lg[2][2], lb[2][2];
#pragma unroll
        for (int bj = 0; bj < 2; ++bj)
#pragma unroll
            for (int n = 0; n < 2; ++n) { lg[bj][n] = *(const f32x4*)(lng + col0 + bj * 128 + n * 16); lb[bj][n] = *(const f32x4*)(lnb + col0 + bj * 128 + n * 16); }
#pragma unroll
        for (int ai = 0; ai < 2; ++ai)
#pragma unroll
            for (int m = 0; m < 4; ++m) {
                const unsigned off = (unsigned)(row0 + ai * 128 + m * 16) * (unsigned)DM + (unsigned)col0;
                const float rg = rs[((ui & 3) * 256 + ai * 128 + wr * 64 + m * 16 + fr) * 2 + 1];
                const unsigned rr = (unsigned)(row0 + ai * 128 + m * 16); const float mu = stats[2 * rr], rs_ = stats[2 * rr + 1];
#pragma unroll
                for (int bj = 0; bj < 2; ++bj)
#pragma unroll
                    for (int n = 0; n < 2; ++n) {
                        const u32x2 yw = *(const u32x2*)(Y + off + bj * 128 + n * 16);
                        const f32x4 xr = ((f32x4){bflo(yw.x), bfhi(yw.x), bflo(yw.y), bfhi(yw.y)} - mu) * rs_ * lg[bj][n] + lb[bj][n];
                        const f32x4 y = xr * ALPHA + g4[bj][n] * (acc[ai][bj][m][n] * rg); u32x2 wv; wv.x = pk2(y[0], y[1]); wv.y = pk2(y[2], y[3]);
                        *(u32x2*)(Y + off + bj * 128 + n * 16) = wv;
                    }
            }
    }
};
__device__ __forceinline__ void rs_table(KArgsPtr a, LAS float* rs, const pg8::StaticOrder& S, int tid) {
    const float* SS = (const float*)(a->ws + WS_SS);
    const int rl = tid >> 1, hf = tid & 1;
    Unit u;
    for (int i = 0; i < 4 && S.next(i, u); ++i) {
        const f32x4* sp = (const f32x4*)(SS + (size_t)(u.pm * 256 + rl) * 24);
        float sum;
        if (hf == 0) { const f32x4 a0 = sp[0], a1 = sp[1], a2 = sp[2], a3 = sp[3]; sum = ((a0[0] + a0[1]) + (a0[2] + a0[3])) + ((a1[0] + a1[1]) + (a1[2] + a1[3])) + ((a2[0] + a2[1]) + (a2[2] + a2[3])) + ((a3[0] + a3[1]) + (a3[2] + a3[3])); }
        else { const f32x4 b0 = sp[4], b1 = sp[5]; sum = ((b0[0] + b0[1]) + (b0[2] + b0[3])) + ((b1[0] + b1[1]) + (b1[2] + b1[3])); }
        const float r = 1.f / sqrtf(sum * (1.f / 1024.f) + LN_EPS);
        const float other = __shfl_xor(r, 1);
        if (hf == 0) { rs[(i * 256 + rl) * 2] = r / other; rs[(i * 256 + rl) * 2 + 1] = other; }
    }
    __syncthreads();
}
struct EpiInProj {
    static constexpr bool PERM = false, AFTER_DRAIN = false, MIDK = false;
    bf16_t *Q, *Kb, *Vb, *U, *GV; const float* rope; float* out;
    __device__ __forceinline__ void operator()(const f32x4 (&acc)[2][2][4][2], const Unit& u, int wr, int wc, int fr, int fq) const {
        const int pn = u.pn, pm = u.pm; const bool samp = (pm == 32);
        const unsigned cl = wc * 32 + 4 * fq;
        if (pn < 6) {
            bf16_t* dst = pn < 4 ? Q + pn * 256 : (pn == 4 ? Kb : Vb);
            const unsigned ld = pn < 4 ? 1024u : 256u;
            const float qs = pn < 4 ? 0.125f : 1.f;
            const bool rot = (pn != 5) && ((wc & 1) == 0);
            float* wout = out + (samp ? (pn == 4 ? OFF_KWS : OFF_VWS) : (pn == 4 ? OFF_KWP : OFF_VWP));
#pragma unroll
            for (int ai = 0; ai < 2; ++ai)
#pragma unroll
                for (int m = 0; m < 4; ++m) {
                    const unsigned rowl = ai * 128 + wr * 64 + m * 16 + fr, row = pm * 256 + rowl;
                    f32x4 cs = {1.f, 1.f, 1.f, 1.f}, sn = {0.f, 0.f, 0.f, 0.f};
                    if (rot) { const unsigned pi = samp ? 2048u : (row & 2047u); cs = *(const f32x4*)(rope + pi * 16u + 4u * (fq & 1)); sn = *(const f32x4*)(rope + pi * 16u + 8u + 4u * (fq & 1)); }
                    const bool wwin = (pn >= 4) && (samp ? (rowl < (unsigned)NS) : ((pm & 7) == 7 && ai == 1));
                    const unsigned wrow = samp ? (rowl * 128u + 127u) : ((unsigned)(pm >> 3) * 128u + rowl - 128u);
#pragma unroll
                    for (int bj = 0; bj < 2; ++bj)
#pragma unroll
                        for (int n = 0; n < 2; ++n) {
                            f32x4 v = acc[ai][bj][m][n];
                            if (n == 0 && rot) {
                                f32x4 p; p[0] = __shfl_xor(v[0], 32); p[1] = __shfl_xor(v[1], 32); p[2] = __shfl_xor(v[2], 32); p[3] = __shfl_xor(v[3], 32);
                                v = (fq < 2) ? (v * cs - p * sn) : (v * cs + p * sn);
                            }
                            const unsigned c = bj * 128 + n * 16 + cl;
                            if (wwin) *(f32x4*)(wout + wrow * 256u + c) = v;
                            v = v * qs; u32x2 w; w.x = pk2(v[0], v[1]); w.y = pk2(v[2], v[3]);
                            *(u32x2*)(dst + row * ld + c) = w;
                        }
                    asm volatile("" ::: "memory");
                }
        } else {
            bf16_t* base = (pn < 10) ? (U + (pn - 6) * 256) : (GV + (pn - 10) * 256);
#pragma unroll
            for (int ai = 0; ai < 2; ++ai)
#pragma unroll
                for (int m = 0; m < 4; ++m) {
                    const unsigned row = pm * 256 + ai * 128 + wr * 64 + m * 16 + fr;
#pragma unroll
                    for (int bj = 0; bj < 2; ++bj)
#pragma unroll
                        for (int n = 0; n < 2; ++n) {
                            const f32x4 v = acc[ai][bj][m][n];
                            u32x2 w; w.x = pk2(gelu_f(v[0]), gelu_f(v[1])); w.y = pk2(gelu_f(v[2]), gelu_f(v[3]));
                            *(u32x2*)(base + row * 1024u + bj * 128 + n * 16 + cl) = w;
                        }
                    asm volatile("" ::: "memory");
                }
        }
    }
};

__device__ __forceinline__ void ada_item(KArgsPtr a, LAS unsigned char* lds, int it, int tid) {
    const int w = __builtin_amdgcn_readfirstlane(tid >> 6), lane = tid & 63, fr = lane & 15, fq = lane >> 4;
    const int g = w & 1, kq = w >> 1;
    const float* W = a->in[6]; const int c0 = it * 128;
    f32x4 acc[4][3];
#pragma unroll
    for (int nt = 0; nt < 4; ++nt)
#pragma unroll
        for (int mt = 0; mt < 3; ++mt) acc[nt][mt] = (f32x4){0.f, 0.f, 0.f, 0.f};
    for (int i4 = 0; i4 < 4; ++i4) {
        const int kb = 512 * kq + 128 * i4 + 8 * fq;
        f32x4 wv[4][8];
#pragma unroll
        for (int sx = 0; sx < 4; ++sx)
#pragma unroll
            for (int e = 0; e < 8; ++e) wv[sx][e] = __builtin_nontemporal_load((const f32x4*)(W + (size_t)(kb + 32 * sx + e) * NMOD + c0 + 64 * g + 4 * fr));
#pragma unroll
        for (int sx = 0; sx < 4; ++sx) {
            const int k0 = kb + 32 * sx;
            bf16x8 sc[3];
#pragma unroll
            for (int mt = 0; mt < 3; ++mt) {
                const int r = 16 * mt + fr;
                if (r < NC) {
                    const float* cp = (r < 4 ? a->in[4] + (size_t)r * DM : a->in[5] + (size_t)(r - 4) * DM) + k0;
                    const f32x4 x0 = *(const f32x4*)cp, x1 = *(const f32x4*)(cp + 4);
                    sc[mt] = pack8(silu_f(x0[0]), silu_f(x0[1]), silu_f(x0[2]), silu_f(x0[3]), silu_f(x1[0]), silu_f(x1[1]), silu_f(x1[2]), silu_f(x1[3]));
                } else sc[mt] = (bf16x8){0, 0, 0, 0, 0, 0, 0, 0};
            }
#pragma unroll
            for (int nt = 0; nt < 4; ++nt) {
                const bf16x8 wf = pack8(wv[sx][0][nt], wv[sx][1][nt], wv[sx][2][nt], wv[sx][3][nt], wv[sx][4][nt], wv[sx][5][nt], wv[sx][6][nt], wv[sx][7][nt]);
#pragma unroll
                for (int mt = 0; mt < 3; ++mt) acc[nt][mt] = MFMA16(wf, sc[mt], acc[nt][mt]);
            }
        }
    }
    LAS float* red = (LAS float*)(lds + 69632);
    for (int ww = 0; ww < 8; ++ww) {
        if (w == ww) {
#pragma unroll
            for (int nt = 0; nt < 4; ++nt)
#pragma unroll
                for (int mt = 0; mt < 3; ++mt)
#pragma unroll
                    for (int rg = 0; rg < 4; ++rg) {
                        const int idx = (16 * mt + fr) * 132 + 64 * g + 16 * fq + 4 * rg + nt;
                        if (kq == 0) red[idx] = acc[nt][mt][rg]; else red[idx] += acc[nt][mt][rg];
                    }
        }
        __syncthreads();
    }
    float* mod = (float*)(a->ws + WS_MOD);
    for (int e = tid; e < NC * 128; e += 512) { const int r = e >> 7, c = e & 127; mod[(size_t)r * NMOD + c0 + c] = red[r * 132 + c] + a->in[7][c0 + c]; }
    __syncthreads();
}
constexpr int I_UP = (DM / 64) * (NUP / 32), I_DN = (DFF / 64) * (DM / 32), I_IN = (DM / 64) * (INW / 32), I_WO = (DM / 64) * (DM / 32);
constexpr int N_TR = 2 * I_UP + 2 * I_DN + I_IN + I_WO;
constexpr int N_UP1_DEF = 4096;
constexpr int N_TR_P0 = 2 * I_UP - N_UP1_DEF + I_IN;
constexpr int N_TR_TAIL = 2048;
struct TrItem { const float* src; unsigned char* dst; int N, rowb; float scale; };
__device__ __forceinline__ void tr_decode(KArgsPtr a, int it, int lane, TrItem& d) {
    const float* W; unsigned char* WT; int N, kind = 0, r = it, rowb, esz; float scale = 0.f;
    if (r < 2 * I_UP) { const int l = r >= I_UP ? 1 : 0; r -= l * I_UP; W = a->in[10] + (size_t)l * WUP_ELEMS; WT = a->ws + WS_WUP + (size_t)l * WUP_ELEMS; rowb = DM; esz = 1; N = NUP; kind = 1; scale = W_UP_SCALE; }
    else if ((r -= 2 * I_UP) < 2 * I_DN) { const int l = r >= I_DN ? 1 : 0; r -= l * I_DN; W = a->in[11] + (size_t)l * WDN_ELEMS; WT = a->ws + WS_WDN + (size_t)l * WDN8_BYTES; rowb = DFFP; esz = 1; N = DM; scale = W_DN_SCALE; }
    else if ((r -= 2 * I_DN) < I_IN) { W = a->in[12]; WT = a->ws + WS_WIN; rowb = 2 * DM; esz = 2; N = INW; }
    else { r -= I_IN; W = a->in[19]; WT = a->ws + WS_WO; rowb = DM; esz = 1; N = DM; scale = W_O_SCALE; }
    const int nblk = N / 32, kb = r / nblk, nb = r - kb * nblk, k0 = 64 * kb, n0 = 32 * nb;
    int d0 = n0;
    if (kind) { const int bj = n0 >= DFF ? 1 : 0, q = n0 - bj * DFF; d0 = 256 * (q >> 7) + 128 * bj + (q & 127); }
    d.src = W + (size_t)(k0 + (lane >> 5)) * N + n0 + (lane & 31);
    d.dst = WT + (size_t)(d0 + (lane >> 3)) * rowb + (size_t)(k0 + 8 * (lane & 7)) * esz;
    d.N = N; d.rowb = rowb; d.scale = scale;
}
__device__ __forceinline__ void tr_load(const TrItem& d, float (&v)[32]) {
#pragma unroll
    for (int i = 0; i < 32; ++i) v[i] = __builtin_nontemporal_load(d.src + (size_t)(2 * i) * d.N);
}
__device__ __forceinline__ void tr_store(const TrItem& d, const float (&v)[32], LAS float* scr, int lane) {
#pragma unroll
    for (int i = 0; i < 32; ++i) scr[(2 * i + (lane >> 5)) * 33 + (lane & 31)] = v[i];
    asm volatile("s_waitcnt lgkmcnt(0)" ::: "memory");
    const int c = lane & 7;
    if (d.scale == 0.f) {
#pragma unroll
        for (int j = 0; j < 4; ++j) { const LAS float* sp = scr + (8 * c) * 33 + (lane >> 3) + 8 * j;
            u32x4 o; o.x = pk2(sp[0 * 33], sp[1 * 33]); o.y = pk2(sp[2 * 33], sp[3 * 33]); o.z = pk2(sp[4 * 33], sp[5 * 33]); o.w = pk2(sp[6 * 33], sp[7 * 33]);
            *(u32x4*)(d.dst + (size_t)(8 * j) * d.rowb) = o; }
    } else {
        const float sc = d.scale;
#pragma unroll
        for (int j = 0; j < 4; ++j) { const LAS float* sp = scr + (8 * c) * 33 + (lane >> 3) + 8 * j;
            u32x2 o; o.x = pk4_fp8(sp[0 * 33] * sc, sp[1 * 33] * sc, sp[2 * 33] * sc, sp[3 * 33] * sc); o.y = pk4_fp8(sp[4 * 33] * sc, sp[5 * 33] * sc, sp[6 * 33] * sc, sp[7 * 33] * sc);
            *(u32x2*)(d.dst + (size_t)(8 * j) * d.rowb) = o; }
    }
    asm volatile("s_waitcnt lgkmcnt(0)" ::: "memory");
}
__device__ __forceinline__ void p0_phase(KArgsPtr a, LAS unsigned char* lds, int tid, int rep) {
    const int w = __builtin_amdgcn_readfirstlane(tid >> 6), lane = tid & 63, G = gridDim.x;
    const int NADA = NMOD / 128;
#ifndef DUP_ADA
#define DUP_ADA 0
#endif
    if ((int)blockIdx.x < NADA) { for (int rr = 0; rr <= DUP_ADA; ++rr) for (int it = blockIdx.x; it < NADA; it += G) ada_item(a, lds, it, tid); }
    if ((int)blockIdx.x >= NADA || G <= NADA) {
        const int nb = (G > NADA) ? (G - NADA) : G, bi = (G > NADA) ? ((int)blockIdx.x - NADA) : (int)blockIdx.x;
        float* rope = (float*)(a->ws + WS_ROPE);
        for (int e = bi * 512 + tid; e < 2049 * 8; e += nb * 512) {
            const int pi = e >> 3, i = e & 7;
            const float pos = (pi == 2048) ? 16384.f : (float)pi;
            const float inv = (float)exp2(-(double)i * 0.125 * 18.931568569324174);
            const float angf = pos * inv;
            double ang = (double)angf;
            const double k = rint(ang * 0.15915494309189535);
            double r = fma(-k, 6.283185307179586, ang); r = fma(-k, 2.4492935982947064e-16, r);
            const double r2 = r * r;
            double s = -1.0 / 51090942171709440000.0;
            s = s * r2 + 1.0 / 121645100408832000.0; s = s * r2 - 1.0 / 355687428096000.0; s = s * r2 + 1.0 / 1307674368000.0; s = s * r2 - 1.0 / 6227020800.0;
            s = s * r2 + 1.0 / 39916800.0; s = s * r2 - 1.0 / 362880.0; s = s * r2 + 1.0 / 5040.0; s = s * r2 - 1.0 / 120.0; s = s * r2 + 1.0 / 6.0; s = -s * r2 + 1.0; s = s * r;
            double c = 1.0 / 2432902008176640000.0;
            c = c * r2 - 1.0 / 6402373705728000.0; c = c * r2 + 1.0 / 20922789888000.0; c = c * r2 - 1.0 / 87178291200.0; c = c * r2 + 1.0 / 479001600.0;
            c = c * r2 - 1.0 / 3628800.0; c = c * r2 + 1.0 / 40320.0; c = c * r2 - 1.0 / 720.0; c = c * r2 + 1.0 / 24.0; c = c * r2 - 0.5; c = c * r2 + 1.0;
            rope[pi * 16 + i] = (float)c; rope[pi * 16 + 8 + i] = (float)s;
        }
        for (int e = bi * 512 + tid; e < (2 * DM + MPAD) * 8; e += nb * 512) {
            const int rw = e >> 3, q = e & 7;
            unsigned char* base = rw < 2 * DM ? a->ws + WS_WDN + (size_t)rw * DFFP : a->ws + WS_ACT + (size_t)(rw - 2 * DM) * DFFP;
            *(u32x4*)(base + DFF + 16 * q) = (u32x4){0u, 0u, 0u, 0u};
        }
        for (int e = bi * 512 + tid; e < 2 * NS * 127 * 64; e += nb * 512) {
            const int t = e / (NS * 127 * 64), r = e % (NS * 127 * 64), b = r / (127 * 64), q = r % (127 * 64);
            const f32x4 v = *((const f32x4*)(a->in[2 + t] + (size_t)b * 128 * 256 + 256) + q);
            *((f32x4*)(a->out + (t ? OFF_VWS : OFF_KWS) + (size_t)b * 128 * 256) + q) = v;
        }
    }
    {
        const int gw = blockIdx.x * 8 + w, NGW = G * 8;
        LAS float* scr = (LAS float*)(lds + w * 8448);
        const bool has_tail = (G > NADA) && ((int)blockIdx.x >= NADA);
        const int n_main = (G > NADA) ? (N_TR_P0 - N_TR_TAIL) : N_TR_P0;
        const int nm_w = (gw < n_main) ? (n_main - gw + NGW - 1) / NGW : 0;
        const int tw = ((int)blockIdx.x - NADA) * 8 + w, TNW = (G - NADA) * 8;
        const int nt_w = (has_tail && tw < N_TR_TAIL) ? (N_TR_TAIL - tw + TNW - 1) / TNW : 0;
        const int n_w = nm_w + nt_w;
        for (int k = 0; k < n_w; k += 4) {
            TrItem d[4]; float v[4][32];
#pragma unroll
            for (int q = 0; q < 4; ++q) if (k + q < n_w) { const int kk = k + q; int it = kk < nm_w ? gw + kk * NGW : n_main + tw + (kk - nm_w) * TNW; if (it >= 2 * I_UP - N_UP1_DEF) it += 2 * I_DN + N_UP1_DEF;     tr_decode(a, it, lane, d[q]); tr_load(d[q], v[q]); }
#pragma unroll
            for (int q = 0; q < 4; ++q) if (k + q < n_w) tr_store(d[q], v[q], scr, lane);
        }
    }
}
__device__ __forceinline__ void tr_deferred(KArgsPtr a, LAS unsigned char* lds, int tid, int first, int count, int bi, int nblk) {
    const int w = __builtin_amdgcn_readfirstlane(tid >> 6), lane = tid & 63;
    LAS float* scr = (LAS float*)(lds + w * 8448);
    const int tw = bi * 8 + w, TNW = nblk * 8;
    const int n_w = (tw < count) ? (count - tw + TNW - 1) / TNW : 0;
    for (int k = 0; k < n_w; k += 4) {
        TrItem d[4]; float v[4][32];
#pragma unroll
        for (int q = 0; q < 4; ++q) if (k + q < n_w) { tr_decode(a, first + tw + (k + q) * TNW, lane, d[q]); tr_load(d[q], v[q]); }
#pragma unroll
        for (int q = 0; q < 4; ++q) if (k + q < n_w) tr_store(d[q], v[q], scr, lane);
    }
}
__device__ __forceinline__ const float* mod_row(KArgsPtr a, int row, int sub) {
    const int b = row < MP ? (row >> 11) : (4 + row - MP);
    return (const float*)(a->ws + WS_MOD) + (size_t)b * NMOD + sub * 6144;
}
__device__ __forceinline__ void h0_phase(KArgsPtr a, int tid) {
    const unsigned lane = tid & 63; const int gw = blockIdx.x * 8 + __builtin_amdgcn_readfirstlane(tid >> 6), NGW = gridDim.x * 8;
    unsigned char* H8 = a->ws + WS_H8;
    for (int r0 = gw; r0 < MP; r0 += 4 * NGW) {
        f32x4 xv[4][8];
#pragma unroll
        for (int q = 0; q < 4; ++q) { const int row = r0 + q * NGW; if (row < MP) {
            const f32x4* xr = (const f32x4*)(row < MP ? a->in[0] + (size_t)row * DM : a->in[1] + (size_t)(row - MP) * DM);
#pragma unroll
            for (int j = 0; j < 8; ++j) xv[q][j] = __builtin_nontemporal_load(xr + (64u * j + lane)); } }
#pragma unroll
        for (int q = 0; q < 4; ++q) { const int row = r0 + q * NGW; if (row < MP) {
            const f32x4* sh = (const f32x4*)mod_row(a, row, 0); const f32x4* scl = sh + 512;
            unsigned* o = (unsigned*)(H8 + (size_t)row * DM);
#pragma unroll
            for (int j = 0; j < 8; ++j) { const unsigned c = 64u * j + lane; const f32x4 h = xv[q][j] * (scl[c] + 1.f) + sh[c]; o[c] = pk4_fp8(h[0], h[1], h[2], h[3]); } } }
    }
    const int w = __builtin_amdgcn_readfirstlane(tid >> 6);
    for (int t = blockIdx.x; t < NS; t += gridDim.x) {
        const int row = MP + t; const unsigned c = 64u * w + lane;
        const f32x4 x = ((const f32x4*)(a->in[1] + (size_t)t * DM))[c];
        const f32x4* sh = (const f32x4*)mod_row(a, row, 0); const f32x4* scl = sh + 512;
        const f32x4 h = x * (scl[c] + 1.f) + sh[c];
        ((unsigned*)(H8 + (size_t)row * DM))[c] = pk4_fp8(h[0], h[1], h[2], h[3]);
    }
}
__device__ __forceinline__ void ln_finish(KArgsPtr a, f32x4 (&v)[8], int row, unsigned lane, int li, bool final_out, int next_sub) {
    const f32x4* g4 = (const f32x4*)(a->in[8] + li * DM); const f32x4* b4 = (const f32x4*)(a->in[9] + li * DM);
    bf16_t* X1 = (bf16_t*)(a->ws + WS_X1); bf16_t* H = (bf16_t*)(a->ws + WS_H);
    float s = 0.f;
#pragma unroll
    for (int j = 0; j < 8; ++j) s += (v[j][0] + v[j][1]) + (v[j][2] + v[j][3]);
    const float mean = wave_sum(s) * (1.f / DM); float q = 0.f;
#pragma unroll
    for (int j = 0; j < 8; ++j) { v[j] = v[j] - mean; q += (v[j][0] * v[j][0] + v[j][1] * v[j][1]) + (v[j][2] * v[j][2] + v[j][3] * v[j][3]); }
    const float rstd = 1.f / sqrtf(wave_sum(q) * (1.f / DM) + LN_EPS);
    f32x4* xo = (f32x4*)(row < MP ? a->out + OFF_YP + (size_t)row * DM : a->out + OFF_YS + (size_t)(row - MP) * DM);
    if (!final_out && lane == 0) { float* st = (float*)(a->ws + WS_STATS) + 2 * (size_t)row; st[0] = mean; st[1] = rstd; }
    const f32x4* sh = (const f32x4*)mod_row(a, row, final_out ? 0 : next_sub); const f32x4* scl = sh + 512;
    u32x2* ho = (u32x2*)(H + (size_t)row * DM); unsigned* ho8 = (unsigned*)(a->ws + WS_H8 + (size_t)row * DM);
#pragma unroll
    for (int j = 0; j < 8; ++j) {
        const unsigned c = 64u * j + lane; const f32x4 x = v[j] * rstd * g4[c] + b4[c]; if (final_out) xo[c] = x;
        if (!final_out) { const f32x4 h = x * (scl[c] + 1.f) + sh[c];
            if (next_sub == 2) ho8[c] = pk4_fp8(h[0], h[1], h[2], h[3]);
            else { u32x2 wv; wv.x = pk2(h[0], h[1]); wv.y = pk2(h[2], h[3]); ho[c] = wv; } }
        if (j & 1) asm volatile("" ::: "memory");
    }
}
__device__ __forceinline__ void ln_phase(KArgsPtr a, LAS unsigned char* lds, int tid, int li, bool final_out, int next_sub) {
    const unsigned lane = tid & 63; const int gw = blockIdx.x * 8 + __builtin_amdgcn_readfirstlane(tid >> 6), NGW = gridDim.x * 8;
    const bf16_t* Y = (const bf16_t*)(a->ws + WS_Y); const bf16_t* X1 = (const bf16_t*)(a->ws + WS_X1);
    for (int r0 = gw; r0 < MP; r0 += 4 * NGW) {
        f32x4 v[4][8];
#pragma unroll
        for (int q = 0; q < 4; ++q) { const int row = r0 + q * NGW; if (row < MP) { const u32x2* yr = (const u32x2*)(Y + (size_t)row * DM);
#pragma unroll
            for (int j = 0; j < 8; ++j) { const u32x2 yw = yr[64u * j + lane]; v[q][j] = (f32x4){bflo(yw.x), bfhi(yw.x), bflo(yw.y), bfhi(yw.y)}; } } }
#pragma unroll
        for (int q = 0; q < 4; ++q) { const int row = r0 + q * NGW; if (row < MP) ln_finish(a, v[q], row, lane, li, final_out, next_sub); }
    }
    const int w = __builtin_amdgcn_readfirstlane(tid >> 6);
    LAS float* red = (LAS float*)lds;
    for (int t = blockIdx.x; t < NS; t += gridDim.x) {
        const int row = MP + t; const float coef = (li == 1) ? 1.0f / (W_O_SCALE * MIX_SCALE) : 0.5f / (W_DN_SCALE * ACT_SCALE);
        const unsigned c = 64u * w + lane;
        float ra = 1.f, rg = 1.f;
        if (li == 1) {
            const float sv = (lane < 24) ? ((const float*)(a->ws + WS_SS))[(size_t)row * 24 + lane] : 0.f;
            const float sa = wave_sum(lane < 16 ? sv : 0.f), sg = wave_sum(lane >= 16 ? sv : 0.f);
            ra = 1.f / sqrtf(sa * (1.f / 1024.f) + LN_EPS); rg = 1.f / sqrtf(sg * (1.f / 1024.f) + LN_EPS);
        }
        const f32x4* xs = (const f32x4*)(a->in[1] + (size_t)t * DM); const u32x2* xsb = (const u32x2*)(X1 + (size_t)row * DM);
        const f32x4* gt = (const f32x4*)(mod_row(a, row, li) + 4096);
        const f32x4* pp = (const f32x4*)((const float*)(a->ws + WS_PART) + (size_t)t * DM);
        const f32x4 sm = (pp[c] + pp[c + 32 * 512]) * ra + (pp[c + 64 * 512] + pp[c + 96 * 512]) * rg;
        f32x4 xv; if (li == 0) xv = xs[c]; else { const u32x2 xw = xsb[c]; xv = (f32x4){bflo(xw.x), bfhi(xw.x), bflo(xw.y), bfhi(xw.y)}; }
        f32x4 v = xv * ALPHA + gt[c] * coef * sm;
        const float s = wave_sum((v[0] + v[1]) + (v[2] + v[3]));
        if (lane == 0) red[w] = s;
        __syncthreads();
        const float mean = (((red[0] + red[1]) + (red[2] + red[3])) + ((red[4] + red[5]) + (red[6] + red[7]))) * (1.f / DM);
        v = v - mean;
        const float q = wave_sum((v[0] * v[0] + v[1] * v[1]) + (v[2] * v[2] + v[3] * v[3]));
        if (lane == 0) red[8 + w] = q;
        __syncthreads();
        const float rstd = 1.f / sqrtf((((red[8] + red[9]) + (red[10] + red[11])) + ((red[12] + red[13]) + (red[14] + red[15]))) * (1.f / DM) + LN_EPS);
        const f32x4* g4 = (const f32x4*)(a->in[8] + li * DM); const f32x4* b4 = (const f32x4*)(a->in[9] + li * DM);
        const f32x4 x = v * rstd * g4[c] + b4[c];
        if (final_out) ((f32x4*)(a->out + OFF_YS + (size_t)t * DM))[c] = x;
        else {
            u32x2 xw; xw.x = pk2(x[0], x[1]); xw.y = pk2(x[2], x[3]); ((u32x2*)(a->ws + WS_X1 + (size_t)row * DM * 2))[c] = xw;
            const f32x4* sh = (const f32x4*)mod_row(a, row, next_sub); const f32x4* scl = sh + 512;
            const f32x4 h = x * (scl[c] + 1.f) + sh[c];
            if (next_sub == 2) ((unsigned*)(a->ws + WS_H8 + (size_t)row * DM))[c] = pk4_fp8(h[0], h[1], h[2], h[3]);
            else { u32x2 hw; hw.x = pk2(h[0], h[1]); hw.y = pk2(h[2], h[3]); ((u32x2*)(a->ws + WS_H + (size_t)row * DM * 2))[c] = hw; }
        }
        __syncthreads();
    }
}
__device__ __forceinline__ void merge_phase(KArgsPtr a, int tid) {
    const unsigned lane = tid & 63; const int gw = blockIdx.x * 8 + __builtin_amdgcn_readfirstlane(tid >> 6), NGW = gridDim.x * 8;
    const bf16_t* MIX = (const bf16_t*)(a->ws + WS_MIX); const float* SS = (const float*)(a->ws + WS_SS); unsigned char* H8 = a->ws + WS_H8;
    const float* og = a->in[18];
    for (int r0 = gw; r0 < MP; r0 += 4 * NGW) {
        u32x4 mv[4][4]; float sv[4];
#pragma unroll
        for (int q = 0; q < 4; ++q) { const int row = r0 + q * NGW; if (row < MP) {
            sv[q] = (lane < 24) ? SS[(size_t)row * 24 + lane] : 0.f;
            const u32x4* mr = (const u32x4*)(MIX + (size_t)row * DM);
#pragma unroll
            for (int j = 0; j < 4; ++j) mv[q][j] = mr[64u * j + lane]; } }
#pragma unroll
        for (int q = 0; q < 4; ++q) { const int row = r0 + q * NGW; if (row < MP) {
            float sa = (lane < 16) ? sv[q] : 0.f, sg = (lane >= 16) ? sv[q] : 0.f;
            sa = wave_sum(sa); sg = wave_sum(sg);
            const float ra = 1.f / sqrtf(sa * (1.f / 1024.f) + LN_EPS), rg = 1.f / sqrtf(sg * (1.f / 1024.f) + LN_EPS);
            u32x2* ho = (u32x2*)(H8 + (size_t)row * DM);
#pragma unroll
            for (int j = 0; j < 4; ++j) {
                const unsigned c = 64u * j + lane; const u32x4 m = mv[q][j]; const float r = (j < 2) ? ra : rg;
                const f32x4 g0 = *(const f32x4*)(og + 8 * c), g1 = *(const f32x4*)(og + 8 * c + 4);
                u32x2 o;
                o.x = pk4_fp8(bflo(m.x) * r * g0[0], bfhi(m.x) * r * g0[1], bflo(m.y) * r * g0[2], bfhi(m.y) * r * g0[3]);
                o.y = pk4_fp8(bflo(m.z) * r * g1[0], bfhi(m.z) * r * g1[1], bflo(m.w) * r * g1[2], bfhi(m.w) * r * g1[3]);
                ho[c] = o;
            } } }
    }
    const int w = __builtin_amdgcn_readfirstlane(tid >> 6);
    for (int t = blockIdx.x; t < NS; t += gridDim.x) {
        const int row = MP + t;
        const float sv = (lane < 24) ? SS[(size_t)row * 24 + lane] : 0.f;
        const float sa = wave_sum(lane < 16 ? sv : 0.f), sg = wave_sum(lane >= 16 ? sv : 0.f);
        const float ra = 1.f / sqrtf(sa * (1.f / 1024.f) + LN_EPS), rg = 1.f / sqrtf(sg * (1.f / 1024.f) + LN_EPS);
        if (lane < 32) {
            const unsigned c = 32u * w + lane;
            const u32x4 m = ((const u32x4*)(MIX + (size_t)row * DM))[c]; const float r = (c < 128u) ? ra : rg;
            const f32x4 g0 = *(const f32x4*)(og + 8 * c), g1 = *(const f32x4*)(og + 8 * c + 4);
            u32x2 o;
            o.x = pk4_fp8(bflo(m.x) * r * g0[0], bfhi(m.x) * r * g0[1], bflo(m.y) * r * g0[2], bfhi(m.y) * r * g0[3]);
            o.y = pk4_fp8(bflo(m.z) * r * g1[0], bfhi(m.z) * r * g1[1], bflo(m.w) * r * g1[2], bfhi(m.w) * r * g1[3]);
            ((u32x2*)(H8 + (size_t)row * DM))[c] = o;
        }
    }
}
template <bool FP8  >
__device__ __forceinline__ void small_part(LAS unsigned char* lds, int tid, const void* Av, const void* Btv, int K, float* PART) {
    const int w = __builtin_amdgcn_readfirstlane(tid >> 6), lane = tid & 63, S = K / 16;
    LAS float* part = (LAS float*)lds;
    for (int it = blockIdx.x; it < 256; it += gridDim.x) {
        const int n0 = 32 * (it & 63), kq = it >> 6, sl = kq * 8 + w;
        const int s0 = (sl * S) >> 5, s1 = ((sl + 1) * S) >> 5;
        f32x16 acc;
#pragma unroll
        for (int i = 0; i < 16; ++i) acc[i] = 0.f;
        if constexpr (FP8) {
            const unsigned char* ap = (const unsigned char*)Av + (size_t)(lane & 31) * K + 8 * (lane >> 5);
            const unsigned char* bp = (const unsigned char*)Btv + (size_t)(n0 + (lane & 31)) * K + 8 * (lane >> 5);
            long af[11], bfr[11];
#pragma unroll
            for (int i = 0; i < 11; ++i) { const int st = (s0 + i < s1) ? s0 + i : s0; af[i] = *(const long*)(ap + 16 * st); bfr[i] = *(const long*)(bp + 16 * st); }
#pragma unroll
            for (int i = 0; i < 11; ++i) if (s0 + i < s1) acc = __builtin_amdgcn_mfma_f32_32x32x16_fp8_fp8(af[i], bfr[i], acc, 0, 0, 0);
        } else {
            const bf16_t* ap = (const bf16_t*)Av + (size_t)(lane & 31) * K + 8 * (lane >> 5);
            const bf16_t* bp = (const bf16_t*)Btv + (size_t)(n0 + (lane & 31)) * K + 8 * (lane >> 5);
            bf16x8 af[11], bfr[11];
#pragma unroll
            for (int i = 0; i < 11; ++i) { const int st = (s0 + i < s1) ? s0 + i : s0; af[i] = *(const bf16x8*)(ap + 16 * st); bfr[i] = *(const bf16x8*)(bp + 16 * st); }
#pragma unroll
            for (int i = 0; i < 11; ++i) if (s0 + i < s1) acc = __builtin_amdgcn_mfma_f32_32x32x16_bf16(af[i], bfr[i], acc, 0, 0, 0);
        }
#pragma unroll
        for (int rg = 0; rg < 16; ++rg) { const int i = 8 * (rg >> 2) + 4 * (lane >> 5) + (rg & 3); part[w * 1024 + i * 32 + (lane & 31)] = acc[rg]; }
        __syncthreads();
        for (int e = tid; e < 1024; e += 512) {
            const int t = e >> 5, n = e & 31; float sm = 0.f;
#pragma unroll
            for (int ww = 0; ww < 8; ++ww) sm += part[ww * 1024 + e];
            PART[(size_t)(kq * 32 + t) * DM + n0 + n] = sm;
        }
        __syncthreads();
    }
}
struct AttnRegs { u32x4 kv[4], vv[4]; bf16x8 qf[2]; };
__device__ __forceinline__ void attn_load(KArgsPtr a, int item, int tid, AttnRegs& R) {
    const int h = item & 15, nb = (item >> 4) & 15, b = item >> 8, kvh = h >> 2;
    const bf16_t* Q = (const bf16_t*)(a->ws + WS_Q); const bf16_t* Kb = (const bf16_t*)(a->ws + WS_K); const bf16_t* Vb = (const bf16_t*)(a->ws + WS_V);
    const int w = __builtin_amdgcn_readfirstlane(tid >> 6), lane = tid & 63, fr = lane & 15, fq = lane >> 4;
    const unsigned qrow = b * SEQ + nb * 128 + 16 * w + fr;
#pragma unroll
    for (int ks = 0; ks < 2; ++ks) R.qf[ks] = *(const bf16x8*)(Q + qrow * 1024u + h * 64 + ks * 32 + 8 * fq);
    const int rowk0 = b * SEQ + (nb - 1) * 128;
#pragma unroll
    for (int i = 0; i < 4; ++i) {
        const int ch = tid + 512 * i, c = ch >> 3, part = ch & 7;
        R.kv[i] = (u32x4){0u, 0u, 0u, 0u}; R.vv[i] = (u32x4){0u, 0u, 0u, 0u};
        if (nb > 0 || c >= 128) { const unsigned off = (unsigned)(rowk0 + c) * 256u + kvh * 64 + part * 8; R.kv[i] = *(const u32x4*)(Kb + off); R.vv[i] = *(const u32x4*)(Vb + off); }
    }
}
__device__ __forceinline__ void attn_stage(LAS unsigned char* lds, int tid, const AttnRegs& R) {
    LAS bf16_t* Kl = (LAS bf16_t*)lds; LAS bf16_t* Vl = Kl + 256 * 72;
#pragma unroll
    for (int i = 0; i < 4; ++i) { const int ch = tid + 512 * i, c = ch >> 3, part = ch & 7; *(LAS u32x4*)(Kl + c * 72 + part * 8) = R.kv[i]; *(LAS u32x4*)(Vl + c * 72 + part * 8) = R.vv[i]; }
}
__device__ __forceinline__ void attn_compute(KArgsPtr a, LAS unsigned char* lds, int item, int tid, const bf16x8 (&qf)[2]) {
    const int h = item & 15, nb = (item >> 4) & 15, b = item >> 8;
    bf16_t* MIX = (bf16_t*)(a->ws + WS_MIX); float* SS = (float*)(a->ws + WS_SS);
    LAS bf16_t* Kl = (LAS bf16_t*)lds; LAS bf16_t* Vl = Kl + 256 * 72;
    const int w = __builtin_amdgcn_readfirstlane(tid >> 6), lane = tid & 63, fr = lane & 15, fq = lane >> 4;
    const size_t qrow = (size_t)b * SEQ + nb * 128 + 16 * w + fr;
    f32x4 s[9];
#pragma unroll
    for (int t = 0; t < 9; ++t) {
        s[t] = (f32x4){0.f, 0.f, 0.f, 0.f};
#pragma unroll
        for (int ks = 0; ks < 2; ++ks) { const bf16x8 kf = *(const LAS bf16x8*)(Kl + (16 * (w + t) + fr) * 72 + ks * 32 + 8 * fq); s[t] = MFMA16(kf, qf[ks], s[t]); }
    }
    const float sink = a->in[13][h];
    float mx = sink;
#pragma unroll
    for (int t = 0; t < 9; ++t)
#pragma unroll
        for (int rg = 0; rg < 4; ++rg) {
            bool valid = (nb > 0) || (w + t >= 8);
            if (t == 0) valid = valid && (4 * fq + rg > fr);
            if (t == 8) valid = valid && (4 * fq + rg <= fr);
            const float v = valid ? s[t][rg] : -INFINITY; s[t][rg] = v; mx = fmaxf(mx, v);
        }
    mx = fmaxf(mx, __shfl_xor(mx, 16)); mx = fmaxf(mx, __shfl_xor(mx, 32));
    float sum = 0.f;
#pragma unroll
    for (int t = 0; t < 9; ++t)
#pragma unroll
        for (int rg = 0; rg < 4; ++rg) { const float p = __expf(s[t][rg] - mx); s[t][rg] = p; sum += p; }
    sum += __shfl_xor(sum, 16); sum += __shfl_xor(sum, 32);
    const float inv = 1.f / (sum + __expf(sink - mx));
    f32x4 o[4];
#pragma unroll
    for (int dt = 0; dt < 4; ++dt) o[dt] = (f32x4){0.f, 0.f, 0.f, 0.f};
#pragma unroll
    for (int st = 0; st < 5; ++st) {
        u32x4 pw; pw.x = pk2(s[2 * st][0], s[2 * st][1]); pw.y = pk2(s[2 * st][2], s[2 * st][3]);
        if (st < 4) { pw.z = pk2(s[2 * st + 1][0], s[2 * st + 1][1]); pw.w = pk2(s[2 * st + 1][2], s[2 * st + 1][3]); } else { pw.z = 0u; pw.w = 0u; }
        const bf16x8 pf = __builtin_bit_cast(bf16x8, pw);
        const int ca = 16 * (w + 2 * st) + 4 * fq, cb = ca + 16;
#pragma unroll
        for (int dt = 0; dt < 4; ++dt) {
            const LAS bf16_t* vp = Vl + 16 * dt + fr;
            u32x4 vw;
            vw.x = (unsigned)vp[(ca + 0) * 72] | ((unsigned)vp[(ca + 1) * 72] << 16); vw.y = (unsigned)vp[(ca + 2) * 72] | ((unsigned)vp[(ca + 3) * 72] << 16);
            if (st < 4) { vw.z = (unsigned)vp[(cb + 0) * 72] | ((unsigned)vp[(cb + 1) * 72] << 16); vw.w = (unsigned)vp[(cb + 2) * 72] | ((unsigned)vp[(cb + 3) * 72] << 16); } else { vw.z = 0u; vw.w = 0u; }
            o[dt] = MFMA16(__builtin_bit_cast(bf16x8, vw), pf, o[dt]);
        }
    }
    float ssq = 0.f;
#pragma unroll
    for (int dt = 0; dt < 4; ++dt) {
        const f32x4 v = o[dt] * inv; ssq += (v[0] * v[0] + v[1] * v[1]) + (v[2] * v[2] + v[3] * v[3]);
        const f32x4 vg = v * *(const f32x4*)(a->in[18] + h * 64 + 16 * dt + 4 * fq) * MIX_SCALE;
        *(unsigned*)(a->ws + WS_H8 + qrow * DM + h * 64 + 16 * dt + 4 * fq) = pk4_fp8(vg[0], vg[1], vg[2], vg[3]);
    }
    ssq += __shfl_xor(ssq, 16); ssq += __shfl_xor(ssq, 32);
    if (fq == 0) SS[qrow * 24 + h] = ssq;
}
__device__ __forceinline__ void gmlp_item(KArgsPtr a, LAS unsigned char* lds, int item, int tid) {
    const int g = item & 7, ch = (item >> 3) & 15, b = item >> 7; const size_t r0 = (size_t)b * SEQ + ch * 128;
    const bf16_t* GV = (const bf16_t*)(a->ws + WS_GV); const bf16_t* U = (const bf16_t*)(a->ws + WS_U);
    bf16_t* MIX = (bf16_t*)(a->ws + WS_MIX); float* SS = (float*)(a->ws + WS_SS);
    LAS bf16_t* vT = (LAS bf16_t*)lds;
    const int w = __builtin_amdgcn_readfirstlane(tid >> 6), lane = tid & 63, fr = lane & 15, fq = lane >> 4;
    const int irow = 16 * w + fr;
    const int nks = (16 * w + 15) / 32 + 1;
    const float* Wrow = a->in[16] + ((size_t)g * 128 + irow) * 128;
    f32x4 wq[4][2];
#pragma unroll
    for (int ks = 0; ks < 4; ++ks) if (ks < nks) { wq[ks][0] = *(const f32x4*)(Wrow + ks * 32 + 8 * fq); wq[ks][1] = *(const f32x4*)(Wrow + ks * 32 + 8 * fq + 4); }
    const size_t row = r0 + irow;
    u32x2 uw[8];
#pragma unroll
    for (int ct = 0; ct < 8; ++ct) uw[ct] = *(const u32x2*)(U + row * 1024 + g * 128 + 16 * ct + 4 * fq);
    const float bsp = a->in[17][g * 128 + irow];
    {
        const int p = tid >> 2, qd = tid & 3;
        const u32x4* src = (const u32x4*)(GV + (r0 + p) * 1024 + g * 128 + 32 * qd);
        float x[32];
#pragma unroll
        for (int i = 0; i < 4; ++i) { const u32x4 rw = src[i];
            x[8 * i + 0] = bflo(rw.x); x[8 * i + 1] = bfhi(rw.x); x[8 * i + 2] = bflo(rw.y); x[8 * i + 3] = bfhi(rw.y);
            x[8 * i + 4] = bflo(rw.z); x[8 * i + 5] = bfhi(rw.z); x[8 * i + 6] = bflo(rw.w); x[8 * i + 7] = bfhi(rw.w); }
        float s = 0.f;
#pragma unroll
        for (int i = 0; i < 32; ++i) s += x[i];
        s += __shfl_xor(s, 1); s += __shfl_xor(s, 2);
        const float mean = s * (1.f / 128.f); float q = 0.f;
#pragma unroll
        for (int i = 0; i < 32; ++i) { x[i] -= mean; q += x[i] * x[i]; }
        q += __shfl_xor(q, 1); q += __shfl_xor(q, 2);
        const float rstd = 1.f / sqrtf(q * (1.f / 128.f) + LN_EPS);
        const float* gg = a->in[14] + g * 128 + 32 * qd; const float* gb = a->in[15] + g * 128 + 32 * qd;
#pragma unroll
        for (int i = 0; i < 32; i += 2) {
            const unsigned pr = pk2(x[i] * rstd * gg[i] + gb[i], x[i + 1] * rstd * gg[i + 1] + gb[i + 1]);
            vT[(32 * qd + i) * 136 + p] = (bf16_t)(pr & 0xffffu); vT[(32 * qd + i + 1) * 136 + p] = (bf16_t)(pr >> 16);
        }
    }
    __syncthreads();
    f32x4 acc[8];
#pragma unroll
    for (int ct = 0; ct < 8; ++ct) acc[ct] = (f32x4){0.f, 0.f, 0.f, 0.f};
#pragma unroll
    for (int ks = 0; ks < 4; ++ks) if (ks < nks) {
        const int j0 = ks * 32 + 8 * fq;
        const f32x4 w0 = wq[ks][0], w1 = wq[ks][1];
        const bf16x8 wf = pack8(j0 + 0 <= irow ? w0[0] : 0.f, j0 + 1 <= irow ? w0[1] : 0.f, j0 + 2 <= irow ? w0[2] : 0.f, j0 + 3 <= irow ? w0[3] : 0.f,
                                j0 + 4 <= irow ? w1[0] : 0.f, j0 + 5 <= irow ? w1[1] : 0.f, j0 + 6 <= irow ? w1[2] : 0.f, j0 + 7 <= irow ? w1[3] : 0.f);
#pragma unroll
        for (int ct = 0; ct < 8; ++ct) { const bf16x8 vf = *(const LAS bf16x8*)(vT + (16 * ct + fr) * 136 + ks * 32 + 8 * fq); acc[ct] = MFMA16(vf, wf, acc[ct]); }
    }
    float ssq = 0.f;
#pragma unroll
    for (int ct = 0; ct < 8; ++ct) {
        const float o0 = bflo(uw[ct].x) * (acc[ct][0] + bsp), o1 = bfhi(uw[ct].x) * (acc[ct][1] + bsp), o2 = bflo(uw[ct].y) * (acc[ct][2] + bsp), o3 = bfhi(uw[ct].y) * (acc[ct][3] + bsp);
        ssq += (o0 * o0 + o1 * o1) + (o2 * o2 + o3 * o3);
        const f32x4 og = *(const f32x4*)(a->in[18] + 1024 + g * 128 + 16 * ct + 4 * fq) * MIX_SCALE;
        *(unsigned*)(a->ws + WS_H8 + row * DM + 1024 + g * 128 + 16 * ct + 4 * fq) = pk4_fp8(o0 * og[0], o1 * og[1], o2 * og[2], o3 * og[3]);
    }
    ssq += __shfl_xor(ssq, 16); ssq += __shfl_xor(ssq, 32);
    if (fq == 0) SS[row * 24 + 16 + g] = ssq;
    __syncthreads();
}
__device__ __forceinline__ void sattn_wave(KArgsPtr a, LAS float* wl, int si, int lane) {
    const int bs = si >> 4, h = si & 15, kvh = h >> 2; const size_t row = MP + bs;
    const bf16_t* Q = (const bf16_t*)(a->ws + WS_Q); const bf16_t* Kb = (const bf16_t*)(a->ws + WS_K); const bf16_t* Vb = (const bf16_t*)(a->ws + WS_V);
    bf16_t* MIX = (bf16_t*)(a->ws + WS_MIX); float* SS = (float*)(a->ws + WS_SS);
    LAS float* ql = wl; LAS float* pl = wl + 64;
    const float qv = bf2f(Q[row * 1024 + h * 64 + lane]);
    ql[lane] = qv;
    const float dotnew = wave_sum(qv * bf2f(Kb[row * 256 + kvh * 64 + lane]));
    const float* ck = a->in[2] + (size_t)bs * 128 * 256 + kvh * 64; const float* cv = a->in[3] + (size_t)bs * 128 * 256 + kvh * 64;
    const int j0 = lane + 1, j1 = (lane + 65 < 128) ? (lane + 65) : 127;
    float s0 = 0.f, s1 = 0.f;
#pragma unroll
    for (int hf = 0; hf < 2; ++hf) {
        f32x4 k0[8], k1[8];
#pragma unroll
        for (int d4 = 0; d4 < 8; ++d4) { k0[d4] = *(const f32x4*)(ck + (size_t)j0 * 256 + 32 * hf + 4 * d4); k1[d4] = *(const f32x4*)(ck + (size_t)j1 * 256 + 32 * hf + 4 * d4); }
#pragma unroll
        for (int d4 = 0; d4 < 8; ++d4) {
            const f32x4 qq = *(const LAS f32x4*)(ql + 32 * hf + 4 * d4);
            s0 += (qq[0] * k0[d4][0] + qq[1] * k0[d4][1]) + (qq[2] * k0[d4][2] + qq[3] * k0[d4][3]);
            s1 += (qq[0] * k1[d4][0] + qq[1] * k1[d4][1]) + (qq[2] * k1[d4][2] + qq[3] * k1[d4][3]);
        }
    }
    if (lane == 63) s1 = dotnew;
    const float sink = a->in[13][h];
    const float mx = fmaxf(wave_max(fmaxf(s0, s1)), sink);
    const float p0 = __expf(s0 - mx), p1 = __expf(s1 - mx);
    const float denom = wave_sum(p0 + p1) + __expf(sink - mx);
    pl[lane] = p0; pl[lane + 64] = p1;
    float o = 0.f;
    const float vnew = bf2f(Vb[row * 256 + kvh * 64 + lane]);
    for (int jb = 0; jb < 128; jb += 32) {
        float vv[32];
#pragma unroll
        for (int u = 0; u < 32; ++u) { const int j = jb + u; vv[u] = cv[(size_t)(j < 127 ? j + 1 : 127) * 256 + lane]; }
#pragma unroll
        for (int u = 0; u < 32; ++u) { const int j = jb + u; o += pl[j] * (j < 127 ? vv[u] : vnew); }
    }
    o = o / denom;
    *(unsigned char*)(a->ws + WS_H8 + row * DM + h * 64 + lane) = (unsigned char)(pk4_fp8(o * a->in[18][h * 64 + lane] * MIX_SCALE, 0.f, 0.f, 0.f) & 0xffu);
    const float ss = wave_sum(o * o);
    if (lane == 0) SS[row * 24 + h] = ss;
}
__device__ __forceinline__ void sgmlp_wave(KArgsPtr a, int bs, int lane) {
    const size_t row = MP + bs;
    const bf16_t* GV = (const bf16_t*)(a->ws + WS_GV); const bf16_t* U = (const bf16_t*)(a->ws + WS_U);
    bf16_t* MIX = (bf16_t*)(a->ws + WS_MIX); float* SS = (float*)(a->ws + WS_SS);
    unsigned gwv[8], uwv[8]; float gn0[8], gn1[8], gb0[8], gb1[8], wsv[8], bsv[8], og0[8], og1[8];
#pragma unroll
    for (int g = 0; g < 8; ++g) {
        const int c = g * 128 + 2 * lane;
        gwv[g] = *(const unsigned*)(GV + row * 1024 + c); uwv[g] = *(const unsigned*)(U + row * 1024 + c);
        gn0[g] = a->in[14][c]; gn1[g] = a->in[14][c + 1]; gb0[g] = a->in[15][c]; gb1[g] = a->in[15][c + 1];
        wsv[g] = a->in[16][(size_t)g * 128 * 128]; bsv[g] = a->in[17][g * 128];
    }
#pragma unroll
    for (int g = 0; g < 8; ++g) {
        const int c = g * 128 + 2 * lane;
        float x0 = bflo(gwv[g]), x1 = bfhi(gwv[g]);
        const float mean = wave_sum(x0 + x1) * (1.f / 128.f); x0 -= mean; x1 -= mean;
        const float rstd = 1.f / sqrtf(wave_sum(x0 * x0 + x1 * x1) * (1.f / 128.f) + LN_EPS);
        const float v0 = x0 * rstd * gn0[g] + gb0[g], v1 = x1 * rstd * gn1[g] + gb1[g];
        a->out[OFF_GVS + (size_t)bs * 1024 + c] = v0; a->out[OFF_GVS + (size_t)bs * 1024 + c + 1] = v1;
        const float o0 = bflo(uwv[g]) * (wsv[g] * v0 + bsv[g]), o1 = bfhi(uwv[g]) * (wsv[g] * v1 + bsv[g]);
        *(unsigned short*)(a->ws + WS_H8 + row * DM + 1024 + c) = (unsigned short)(pk4_fp8(o0 * a->in[18][1024 + c] * MIX_SCALE, o1 * a->in[18][1024 + c + 1] * MIX_SCALE, 0.f, 0.f) & 0xffffu);
        const float ss = wave_sum(o0 * o0 + o1 * o1);
        if (lane == 0) SS[row * 24 + 16 + g] = ss;
    }
}
__device__ __forceinline__ void mix_phase(KArgsPtr a, LAS unsigned char* lds, int tid) {
    const int NA = 1024, NG = 512, NSA = 64, NSG = 4, NTOT = NA + NG + NSA + NSG;
    const int w = __builtin_amdgcn_readfirstlane(tid >> 6), lane = tid & 63;
    int it = blockIdx.x;
    {
        AttnRegs R, Rn;
        if (it < NA) attn_load(a, it, tid, R);
        while (it < NA) {
            attn_stage(lds, tid, R);
            __syncthreads();
            const int itn = it + gridDim.x;
            if (itn < NA) attn_load(a, itn, tid, Rn);
            attn_compute(a, lds, it, tid, R.qf);
            __syncthreads();
            R = Rn; it = itn;
        }
    }
    for (; it < NTOT; it += gridDim.x) {
        if (it < NA + NG) gmlp_item(a, lds, it - NA, tid);
        else if (it < NA + NG + NSA) sattn_wave(a, (LAS float*)(lds + w * 1024), (it - NA - NG) * 8 + w, lane);
        else sgmlp_wave(a, (it - NA - NG - NSA) * 8 + w, lane);
    }
}

#define XB_TMO      128
#define XB_XCNT(j)  (256  + 64 * (j))
#define XB_XSUB(j)  (1280 + 64 * (j))
#define XB_XGEN(j)  (2304 + 64 * (j))
#define XB_TOP      3328
#define XB_TOPGEN   3392
#define XCD_BAR_WORDS 3456
#define XB_SPIN_CAP (1u << 18)

__device__ __forceinline__ unsigned xb_ld(unsigned* p)              { return __hip_atomic_load(p, __ATOMIC_RELAXED, __HIP_MEMORY_SCOPE_AGENT); }
__device__ __forceinline__ unsigned xb_add(unsigned* p, unsigned v) { return __hip_atomic_fetch_add(p, v, __ATOMIC_RELAXED, __HIP_MEMORY_SCOPE_AGENT); }
__device__ __forceinline__ unsigned xb_xcc_id() { return (unsigned)__builtin_amdgcn_s_getreg((3 << 11) | 20) & 0xFu; }
#define XB_SPIN(cond, bar) do { unsigned _sp = 0; while (cond) { __builtin_amdgcn_s_sleep(1); \
    if ((++_sp & 255u) == 0u) { if (xb_ld(&(bar)[XB_TMO])) break; if (_sp > XB_SPIN_CAP) { atomicAdd(&(bar)[XB_TMO], 1u); break; } } } } while (0)

struct XcdBarrier {
    unsigned* bar; unsigned x;
    volatile LAS unsigned* st;
};

__device__ __forceinline__ XcdBarrier xcd_barrier_post(unsigned* bar, volatile LAS unsigned* st) {
    XcdBarrier b; b.bar = bar; b.x = xb_xcc_id(); b.st = st;
    if (threadIdx.x == 0) (void)xb_add(&bar[XB_XCNT(b.x)], 1u);
    return b;
}
__device__ __forceinline__ void xcd_barrier_complete(unsigned* bar, unsigned x, unsigned& nloc, unsigned& nx) {
    const unsigned G = gridDim.x * gridDim.y * gridDim.z;
    unsigned sum, cnt, mine, sp = 0u;
    for (;;) {
        sum = 0u; cnt = 0u; mine = 0u;
#pragma unroll
        for (unsigned j = 0; j < 16; ++j) { const unsigned c = xb_ld(&bar[XB_XCNT(j)]); sum += c; cnt += (c > 0u) ? 1u : 0u; mine = (j == x) ? c : mine; }
        if (sum == G) break;
        __builtin_amdgcn_s_sleep(1);
        if ((++sp & 255u) == 0u) { if (xb_ld(&bar[XB_TMO])) break; if (sp > XB_SPIN_CAP) { atomicAdd(&bar[XB_TMO], 1u); break; } }
    }
    nloc = mine > 0u ? mine : 1u; nx = cnt > 0u ? cnt : 1u;
}

__device__ __forceinline__ void xcd_barrier(const XcdBarrier& b) {
    asm volatile("s_waitcnt vmcnt(0)" ::: "memory");
    __syncthreads();
    if (threadIdx.x == 0) {
        unsigned* bar = b.bar;
        __builtin_amdgcn_s_waitcnt(0);
        unsigned nloc = b.st[0], nx = b.st[1];
        if (nloc == 0u) { xcd_barrier_complete(bar, b.x, nloc, nx); b.st[0] = nloc; b.st[1] = nx; }
        const unsigned old = xb_add(&bar[XB_XSUB(b.x)], 1u);
        const unsigned gen = old / nloc;
        if (old + 1u == (gen + 1u) * nloc) {
            __builtin_amdgcn_fence(__ATOMIC_RELEASE, "agent");
            asm volatile("s_waitcnt vmcnt(0)" ::: "memory");
            const unsigned og = xb_add(&bar[XB_TOP], 1u);
            const unsigned tg = og / nx;
            if (og + 1u == (tg + 1u) * nx) xb_add(&bar[XB_TOPGEN], 1u);
            else XB_SPIN(xb_ld(&bar[XB_TOPGEN]) == tg, bar);
            __builtin_amdgcn_fence(__ATOMIC_ACQUIRE, "agent");
            xb_add(&bar[XB_XGEN(b.x)], 1u);
            asm volatile("s_waitcnt vmcnt(0)" ::: "memory");
        } else {
            XB_SPIN(xb_ld(&bar[XB_XGEN(b.x)]) == gen, bar);
            __builtin_amdgcn_fence(__ATOMIC_ACQUIRE, "agent");
            asm volatile("s_waitcnt vmcnt(0)" ::: "memory");
        }
    }
    __syncthreads();
}

__device__ __forceinline__ int fresh_tid() { int t = threadIdx.x; asm volatile("" : "+v"(t)); return t; }
__device__ __forceinline__ KArgsPtr load_args() { KArgsPtr p = (KArgsPtr)__builtin_amdgcn_kernarg_segment_ptr(); asm volatile("" : "+s"(p)); return p; }
#define LA load_args()
__global__ void __launch_bounds__(512, 2) fwd(Args kernarg_only) {
    extern __shared__ __attribute__((aligned(16))) unsigned char lds_raw[];
    LAS unsigned char* lds = (LAS unsigned char*)lds_raw;
    cg::grid_group grid = cg::this_grid();
    volatile LAS unsigned* MISC = (volatile LAS unsigned*)(lds + 131072 + 320);
    if (threadIdx.x < 32) MISC[threadIdx.x] = 0u;
    __syncthreads();
    XcdBarrier xbar = xcd_barrier_post((unsigned*)(LA->ws + WS_CTL) + 4096, MISC + 8);
    if (gridDim.x == 0x7fffffffu) grid.sync();
#define GRID_SYNC() xcd_barrier(xbar)
    const int G = gridDim.x, c = blockIdx.x;
#define tid fresh_tid()
#define mod ((float*)(LA->ws + WS_MOD))
#define WUP ((bf16_t*)(LA->ws + WS_WUP))
#define WDN ((bf16_t*)(LA->ws + WS_WDN))
#define WIN ((bf16_t*)(LA->ws + WS_WIN))
#define WO ((bf16_t*)(LA->ws + WS_WO))
#define H ((bf16_t*)(LA->ws + WS_H))
#define ACT ((bf16_t*)(LA->ws + WS_ACT))
#define Y ((bf16_t*)(LA->ws + WS_Y))
#define PARTP ((float*)(LA->ws + WS_PART))
#define X1 ((bf16_t*)(LA->ws + WS_X1))

#ifndef NO_P0
    for (int rep = 0; rep <= DUP_P0; ++rep) { p0_phase(LA, lds, tid, rep); if (rep < DUP_P0) GRID_SYNC(); }
#endif
    GRID_SYNC();
#ifndef NO_ROW
    h0_phase(LA, tid);
#if DUP_ROW
    GRID_SYNC();
    h0_phase(LA, tid);
#endif
#endif
    GRID_SYNC();
#define UP_PHASE(l) { pg8::Gemm g{(const bf16_t*)(LA->ws + WS_H8), (const bf16_t*)(LA->ws + WS_WUP + (size_t)(l) * WUP_ELEMS), MPAD, NUP, DM / 2}; pg8::StaticOrder S; S.init(MPAD, NUP, G, c); EpiSwiGLU E{LA->ws + WS_ACT}; \
      pg8::gemm_phase<EpiSwiGLU, pg8::StaticOrder, true, true, true>(lds, g, S, E);       \
      { const int rem = ((MPAD / 256) * (NUP / 256)) % G; if (rem != 0 && c >= rem) tr_deferred(LA, lds, tid, 2 * I_UP + (l) * I_DN, I_DN, c - rem, G - rem); else if (rem == 0) tr_deferred(LA, lds, tid, 2 * I_UP + (l) * I_DN, I_DN, c, G); } }
#define DOWN_PHASE(l, sub, xres, XB, LNI) { pg8::Gemm g{(const bf16_t*)(LA->ws + WS_ACT), (const bf16_t*)(LA->ws + WS_WDN + (size_t)(l) * WDN8_BYTES), MP, DM, DFFP / 2}; pg8::StaticOrder S; S.init(MP, DM, G, c); \
      EpiResid<XB> E{xres, Y, mod + (sub) * 6144 + 4096, LA->in[8] + (LNI) * DM, LA->in[9] + (LNI) * DM, (const float*)(LA->ws + WS_STATS)}; \
      small_part<true>(lds, tid, LA->ws + WS_ACT + (size_t)MP * DFFP, LA->ws + WS_WDN + (size_t)(l) * WDN8_BYTES, DFFP, PARTP); \
      pg8::gemm_phase<EpiResid<XB>, pg8::StaticOrder, true, true, true>(lds, g, S, E); }
#ifndef NO_UP
    UP_PHASE(0)
#if DUP_UP
    GRID_SYNC();
    UP_PHASE(0)
#endif
#endif
    GRID_SYNC();
#ifndef NO_DN
    DOWN_PHASE(0, 0, LA->in[0], 0, 0)
#if DUP_DN
    GRID_SYNC();
    DOWN_PHASE(0, 0, LA->in[0], 0, 0)
#endif
#endif
    GRID_SYNC();
#ifndef NO_ROW
    ln_phase(LA, lds, tid, 0, false, 1);
#if DUP_ROW
    GRID_SYNC();
    ln_phase(LA, lds, tid, 0, false, 1);
#endif
#endif
    GRID_SYNC();
    { pg8::Gemm g{H, WIN, MPAD, INW, DM}; pg8::StaticOrder S; S.init(MPAD, INW, G, c);
      EpiInProj E{(bf16_t*)(LA->ws + WS_Q), (bf16_t*)(LA->ws + WS_K), (bf16_t*)(LA->ws + WS_V), (bf16_t*)(LA->ws + WS_U), (bf16_t*)(LA->ws + WS_GV), (const float*)(LA->ws + WS_ROPE), LA->out};

#ifndef NO_IN
      pg8::gemm_phase<EpiInProj, pg8::StaticOrder, true, true>(lds, g, S, E);
#endif
      { const int rem = ((MPAD / 256) * (INW / 256)) % G; const int bi_ = rem != 0 ? c - rem : c, nb_ = rem != 0 ? G - rem : G;
        if (rem == 0 || c >= rem) { tr_deferred(LA, lds, tid, 2 * I_UP + 2 * I_DN + I_IN, I_WO, bi_, nb_); tr_deferred(LA, lds, tid, 2 * I_UP - N_UP1_DEF, N_UP1_DEF, bi_, nb_); } }
    }
    GRID_SYNC();
#ifndef NO_MIX
    mix_phase(LA, lds, tid);
#if DUP_MIX
    GRID_SYNC();
    mix_phase(LA, lds, tid);
#endif
#endif
    GRID_SYNC();
#ifndef NO_WO
    { pg8::Gemm g{(const bf16_t*)(LA->ws + WS_H8), (const bf16_t*)(LA->ws + WS_WO), MP, DM, DM / 2}; pg8::StaticOrder S; S.init(MP, DM, G, c);
      LAS float* rs = (LAS float*)(lds + 131072 + 1024);
      rs_table(LA, rs, S, tid);
      EpiResidMix E{Y, mod + 1 * 6144 + 4096, rs, LA->in[8], LA->in[9], (const float*)(LA->ws + WS_STATS)};
      small_part<true>(lds, tid, LA->ws + WS_H8 + (size_t)MP * DM, LA->ws + WS_WO, DM, PARTP);
      pg8::gemm_phase<EpiResidMix, pg8::StaticOrder, true, true, true>(lds, g, S, E); }
#endif
    GRID_SYNC();
#ifndef NO_ROW
    ln_phase(LA, lds, tid, 1, false, 2);
#endif
    GRID_SYNC();
#ifndef NO_UP
    UP_PHASE(1)
#if DUP_UP
    GRID_SYNC();
    UP_PHASE(1)
#endif
#endif
    GRID_SYNC();
#ifndef NO_DN
    DOWN_PHASE(1, 2, nullptr, 2, 1)
#if DUP_DN
    GRID_SYNC();
    DOWN_PHASE(1, 2, nullptr, 2, 1)
#endif
#endif
    GRID_SYNC();
#ifndef DUP_SYNC
#define DUP_SYNC 0
#endif
    for (int i = 0; i < DUP_SYNC; ++i) GRID_SYNC();
    ln_phase(LA, lds, tid, 2, true, 0);
#if DUP_ROW
    GRID_SYNC();
    ln_phase(LA, lds, tid, 2, true, 0);
#endif
#undef tid
#undef mod
#undef WUP
#undef WDN
#undef WIN
#undef WO
#undef H
#undef ACT
#undef Y
#undef X1
}

extern "C" void kernel_launch(void* const* d_in, const int* in_sizes, int n_in, void* d_out, int out_size, void* d_ws, size_t ws_size, hipStream_t stream) {
    static int grid = 0;
    if (grid == 0) {
        if (n_in != 20 || ws_size < WS_END) { fprintf(stderr, "kernel_launch: unexpected n_in %d / ws %zu\n", n_in, ws_size); grid = -1; return; }
        int dev = 0, cus = 0, per_cu = 0;
        if (hipGetDevice(&dev) != hipSuccess || hipDeviceGetAttribute(&cus, hipDeviceAttributeMultiprocessorCount, dev) != hipSuccess) { grid = -1; return; }
        if (hipFuncSetAttribute((const void*)fwd, hipFuncAttributeMaxDynamicSharedMemorySize, LDS_BYTES) != hipSuccess) { fprintf(stderr, "kernel_launch: hipFuncSetAttribute failed\n"); grid = -1; return; }
        if (hipOccupancyMaxActiveBlocksPerMultiprocessor(&per_cu, (const void*)fwd, 512, LDS_BYTES) != hipSuccess || per_cu < 1) { fprintf(stderr, "kernel_launch: occupancy query says %d\n", per_cu); }
        (void)hipGetLastError();
        grid = cus;
    }
    if (grid < 0) return;
    (void)hipMemsetAsync((char*)d_ws + WS_CTL, 0, 65536, stream);
    Args a{};
    for (int i = 0; i < 20; ++i) a.in[i] = (const float*)d_in[i];
    a.out = (float*)d_out; a.ws = (unsigned char*)d_ws;
    void* args[] = {&a};
    hipError_t e = hipLaunchCooperativeKernel((const void*)fwd, dim3(grid), dim3(512), args, LDS_BYTES, stream);
    if (e != hipSuccess) fprintf(stderr, "kernel_launch: cooperative launch failed: %s (grid %d)\n", hipGetErrorString(e), grid);
}
```

```cpp
#include <hip/hip_runtime.h>
#include <hip/hip_cooperative_groups.h>
#include <cstdio>
#include <cstdint>
namespace cg = cooperative_groups;
#ifndef DUP_P0
#define DUP_P0 0
#endif
#ifndef DUP_UP
#define DUP_UP 0
#endif
#ifndef DUP_DN
#define DUP_DN 0
#endif
#ifndef DUP_MIX
#define DUP_MIX 0
#endif
#ifndef DUP_IN
#define DUP_IN 0
#endif
#ifndef DUP_WO
#define DUP_WO 0
#endif
#ifndef DUP_ROW
#define DUP_ROW 0
#endif
namespace pg8 {
#define PG8_LAS __attribute__((address_space(3)))
typedef unsigned short bf16_t;
typedef short bf16x8 __attribute__((ext_vector_type(8)));
typedef float f32x4 __attribute__((ext_vector_type(4)));
typedef unsigned u32x4 __attribute__((ext_vector_type(4)));
constexpr int BM = 256, BK = 64, HALF = 128, HTB = HALF * BK * 2  , STAGE_BYTES = 8 * HTB, NXCD = 8, WGM = 8;

__host__ __device__ __forceinline__ int lds_byte(int r, int c) { const int st = (r >> 4) * 2 + (c >> 5), rr = r & 15, cc = c & 31, ob = rr * 64 + cc * 2; return st * 1024 + (ob ^ (((ob >> 9) & 1) << 5)); }
__host__ __device__ __forceinline__ void stage_rc(int b, int& R, int& C) { const int st = b / 1024, sb = b % 1024, swz = sb ^ (((sb >> 9) & 1) << 5); R = (st >> 1) * 16 + swz / 64; C = (st & 1) * 32 + (swz % 64) / 2; }
__host__ __device__ __forceinline__ int perm32(int rho) { const int n = rho >> 4, i = rho & 15; return 8 * (i >> 2) + 4 * n + (i & 3); }

struct Unit { int pm, pn; };
struct Gemm { const bf16_t* A; const bf16_t* Bt; int M, N, K; };

struct StaticOrder {
    int nM, nN, nwg, G, c;
    __host__ __device__ void init(int M, int N, int G_, int c_) { nM = M / BM; nN = N / BM; nwg = nM * nN; G = G_; c = c_; }
    __host__ __device__ bool next(int i, Unit& u) const {
        const long L = (long)i * G + c; if (L >= nwg) return false;
        int wgid = (int)L; { const int q = nwg / NXCD, r = nwg % NXCD, xcd = wgid % NXCD, off = wgid / NXCD; wgid = (xcd < r ? xcd * (q + 1) : r * (q + 1) + (xcd - r) * q) + off; }
        const int nig = WGM * nN, gid = wgid / nig, fm = gid * WGM, gsz = (nM - fm) < WGM ? (nM - fm) : WGM;
        u.pm = fm + ((wgid % nig) % gsz); u.pn = (wgid % nig) / gsz; return true;
    }
    __device__ __forceinline__ void a_ready(const Unit&) const {}
    __device__ __forceinline__ void done(const Unit&) const {}
};

__device__ __forceinline__ unsigned cvt_pk_bf16(float lo, float hi) { unsigned r; asm volatile("v_cvt_pk_bf16_f32 %0, %1, %2" : "=v"(r) : "v"(lo), "v"(hi)); return r; }
typedef int i32x4v __attribute__((ext_vector_type(4)));
typedef int i32x8v __attribute__((ext_vector_type(8)));
__device__ __forceinline__ f32x4 mma_fp8(const bf16x8 (&a)[2], const bf16x8 (&b)[2], f32x4 c) {
    const i32x8v A = __builtin_shufflevector(__builtin_bit_cast(i32x4v, a[0]), __builtin_bit_cast(i32x4v, a[1]), 0, 1, 2, 3, 4, 5, 6, 7);
    const i32x8v B = __builtin_shufflevector(__builtin_bit_cast(i32x4v, b[0]), __builtin_bit_cast(i32x4v, b[1]), 0, 1, 2, 3, 4, 5, 6, 7);
    asm volatile("v_mfma_f32_16x16x128_f8f6f4 %0, %1, %2, %0" : "+v"(c) : "v"(A), "v"(B));
    return c;
}
template <class Epi, class Sched, bool ALIGN_EPI = false, bool SP2 = false, bool FP8 = false>
__device__ __forceinline__ void gemm_phase(PG8_LAS unsigned char* lds, const Gemm g, const Sched& S, const Epi& E) {
    int tid_ = threadIdx.x; asm volatile("" : "+v"(tid_));
    const int tid = tid_, wid = __builtin_amdgcn_readfirstlane(tid >> 6), lane = tid & 63, wr = wid >> 2, wc = wid & 3, fr = lane & 15, fq = lane >> 4;
    const int K = g.K, nt = K / BK;
    unsigned voffA[2], voffB[2];
#pragma unroll
    for (int i = 0; i < 2; ++i) { int R, C; stage_rc(tid * 16 + i * 8192, R, C); const int Rb = Epi::PERM ? ((R & ~31) + perm32(R & 31)) : R;
        voffA[i] = (unsigned)(R * K + C) * 2u; voffB[i] = (unsigned)(Rb * K + C) * 2u; }
    const size_t kstep = (size_t)(BK * 2);
    const size_t hstep = (size_t)HALF * K * 2;
    const size_t tstep = 2 * hstep;
    const unsigned ldsw = (unsigned)wid * 1024u;
    const int aoff = lds_byte(wr * 64 + fr, fq * 8), boff = lds_byte(wc * 32 + fr, fq * 8);
#define PG8_SA(b, h) (((b) * 2 + (h)) * HTB)
#define PG8_SB(b, h) ((4 + (b) * 2 + (h)) * HTB)
#define PG8_STAGE(bufoff, gbase, voff) do { _Pragma("unroll") for (int _i = 0; _i < 2; ++_i) \
        __builtin_amdgcn_global_load_lds((const unsigned*)((const char*)(gbase) + (voff)[_i]), (PG8_LAS unsigned*)(lds + (bufoff) + ldsw + _i * 8192), 16, 0, 0); } while (0)
#define PG8_LDA(dst, b, h) do { _Pragma("unroll") for (int m = 0; m < 4; ++m) _Pragma("unroll") for (int k = 0; k < 2; ++k) dst[m][k] = *(const PG8_LAS bf16x8*)(lds + PG8_SA(b, h) + aoff + m * 2048 + k * 1024); } while (0)
#define PG8_LDB(dst, b, h) do { _Pragma("unroll") for (int n = 0; n < 2; ++n) _Pragma("unroll") for (int k = 0; k < 2; ++k) dst[n][k] = *(const PG8_LAS bf16x8*)(lds + PG8_SB(b, h) + boff + n * 2048 + k * 1024); } while (0)
#define PG8_MMA(ai, bj, At, Bt) do { __builtin_amdgcn_s_setprio(1); \
        if constexpr (FP8) { _Pragma("unroll") for (int m = 0; m < 4; ++m) _Pragma("unroll") for (int n = 0; n < 2; ++n) acc[ai][bj][m][n] = mma_fp8(Bt[n], At[m], acc[ai][bj][m][n]); } \
        else { _Pragma("unroll") for (int m = 0; m < 4; ++m) _Pragma("unroll") for (int n = 0; n < 2; ++n) _Pragma("unroll") for (int k = 0; k < 2; ++k) \
        acc[ai][bj][m][n] = __builtin_amdgcn_mfma_f32_16x16x32_bf16(Bt[n][k], At[m][k], acc[ai][bj][m][n], 0, 0, 0); } __builtin_amdgcn_s_setprio(0); } while (0)
#define PG8_WAIT_V(n) asm volatile("s_waitcnt vmcnt(" #n ")" ::: "memory")
#define PG8_WAIT_L(n) asm volatile("s_waitcnt lgkmcnt(" #n ")" ::: "memory")
#define PG8_BAR __builtin_amdgcn_s_barrier()
#define PG8_SCHED __builtin_amdgcn_sched_barrier(0)
    Unit cur, nxt; int ui = 0;
    if (!S.next(0, cur)) return;
    f32x4 acc[2][2][4][2];
#pragma unroll
    for (int a = 0; a < 2; ++a)
#pragma unroll
        for (int b = 0; b < 2; ++b)
#pragma unroll
            for (int m = 0; m < 4; ++m)
#pragma unroll
                for (int n = 0; n < 2; ++n) acc[a][b][m][n] = (f32x4){0.f, 0.f, 0.f, 0.f};
    bf16x8 At[4][2], B0[2][2], B1[2][2];
    const char* cA = (const char*)g.A + (size_t)cur.pm * tstep; const char* cB = (const char*)g.Bt + (size_t)cur.pn * tstep;
    S.a_ready(cur);
    if constexpr (SP2) {
        PG8_STAGE(PG8_SB(0, 0), cB, voffB); PG8_STAGE(PG8_SB(0, 1), cB + hstep, voffB); PG8_STAGE(PG8_SA(0, 0), cA, voffA); PG8_STAGE(PG8_SA(0, 1), cA + hstep, voffA);
        if (wr == 1) PG8_BAR;
        PG8_WAIT_V(2); PG8_BAR;
        PG8_STAGE(PG8_SB(1, 0), cB + kstep, voffB); PG8_STAGE(PG8_SA(1, 0), cA + kstep, voffA); PG8_STAGE(PG8_SB(1, 1), cB + hstep + kstep, voffB);
        PG8_WAIT_V(6); PG8_BAR;
    } else {
        PG8_STAGE(PG8_SB(0, 0), cB, voffB); PG8_STAGE(PG8_SA(0, 0), cA, voffA); PG8_STAGE(PG8_SB(0, 1), cB + hstep, voffB); PG8_STAGE(PG8_SA(0, 1), cA + hstep, voffA);
        if (wr == 1) PG8_BAR;
        PG8_WAIT_V(4); PG8_BAR;
        PG8_STAGE(PG8_SB(1, 0), cB + kstep, voffB); PG8_STAGE(PG8_SA(1, 0), cA + kstep, voffA); PG8_STAGE(PG8_SB(1, 1), cB + hstep + kstep, voffB);
        PG8_WAIT_V(6); PG8_BAR;
    }
    for (;;) {
        const bool has_next = S.next(ui + 1, nxt);
        const char* nA = has_next ? (const char*)g.A + (size_t)nxt.pm * tstep : cA; const char* nB = has_next ? (const char*)g.Bt + (size_t)nxt.pn * tstep : cB;
        for (int t = 0; t < nt; t += 2) {
            if constexpr (Epi::MIDK) { if (t == nt / 2) E.mid(acc, ui, wr, fr); }
            const bool last = (t == nt - 2);
            const char* a1 = cA + (size_t)(t + 1) * kstep;
            const char* a2 = last ? nA : cA + (size_t)(t + 2) * kstep; const char* b2 = last ? nB : cB + (size_t)(t + 2) * kstep;
            const char* a3 = a2 + kstep; const char* b3 = b2 + kstep;
            if (last && has_next) S.a_ready(nxt);
            if constexpr (SP2) {
            PG8_LDB(B0, 0, 0); PG8_LDB(B1, 0, 1); PG8_SCHED; PG8_LDA(At, 0, 0); PG8_STAGE(PG8_SA(1, 1), a1 + hstep, voffA);
            PG8_WAIT_V(8); PG8_WAIT_L(0); PG8_BAR; PG8_MMA(0, 0, At, B0); PG8_MMA(0, 1, At, B1); PG8_BAR; PG8_SCHED;
            PG8_LDA(At, 0, 1); PG8_STAGE(PG8_SB(0, 0), b2, voffB); PG8_STAGE(PG8_SB(0, 1), b2 + hstep, voffB); PG8_STAGE(PG8_SA(0, 0), a2, voffA);
            PG8_WAIT_V(8); PG8_WAIT_L(0); PG8_BAR; PG8_MMA(1, 0, At, B0); PG8_MMA(1, 1, At, B1); PG8_BAR; PG8_SCHED;
            PG8_LDB(B0, 1, 0); PG8_LDB(B1, 1, 1); PG8_SCHED; PG8_LDA(At, 1, 0); PG8_STAGE(PG8_SA(0, 1), a2 + hstep, voffA);
            PG8_WAIT_V(8); PG8_WAIT_L(0); PG8_BAR; PG8_MMA(0, 0, At, B0); PG8_MMA(0, 1, At, B1); PG8_BAR; PG8_SCHED;
            PG8_LDA(At, 1, 1); PG8_STAGE(PG8_SB(1, 0), b3, voffB); PG8_STAGE(PG8_SB(1, 1), b3 + hstep, voffB); PG8_STAGE(PG8_SA(1, 0), a3, voffA);
            PG8_WAIT_V(8); PG8_WAIT_L(0); PG8_BAR; PG8_MMA(1, 0, At, B0); PG8_MMA(1, 1, At, B1); PG8_BAR; PG8_SCHED;
            } else {
            PG8_LDB(B0, 0, 0); PG8_SCHED; PG8_LDA(At, 0, 0); PG8_STAGE(PG8_SA(1, 1), a1 + hstep, voffA);
            PG8_WAIT_L(8); PG8_BAR; PG8_WAIT_L(0); PG8_MMA(0, 0, At, B0); PG8_BAR; PG8_SCHED;
            PG8_LDB(B1, 0, 1); PG8_STAGE(PG8_SB(0, 0), b2, voffB);
            PG8_BAR; PG8_WAIT_L(0); PG8_MMA(0, 1, At, B1); PG8_BAR;
            PG8_LDA(At, 0, 1); PG8_STAGE(PG8_SA(0, 0), a2, voffA);
            PG8_BAR; PG8_WAIT_L(0); PG8_MMA(1, 0, At, B0); PG8_BAR; PG8_SCHED;
            PG8_STAGE(PG8_SB(0, 1), b2 + hstep, voffB);
            PG8_WAIT_V(6); PG8_BAR; PG8_MMA(1, 1, At, B1); PG8_BAR;
            PG8_LDB(B0, 1, 0); PG8_SCHED; PG8_LDA(At, 1, 0); PG8_STAGE(PG8_SA(0, 1), a2 + hstep, voffA);
            PG8_WAIT_L(8); PG8_BAR; PG8_WAIT_L(0); PG8_MMA(0, 0, At, B0); PG8_BAR; PG8_SCHED;
            PG8_LDB(B1, 1, 1); PG8_STAGE(PG8_SB(1, 0), b3, voffB);
            PG8_BAR; PG8_WAIT_L(0); PG8_MMA(0, 1, At, B1); PG8_BAR;
            PG8_LDA(At, 1, 1); PG8_STAGE(PG8_SA(1, 0), a3, voffA);
            PG8_BAR; PG8_WAIT_L(0); PG8_MMA(1, 0, At, B0); PG8_BAR; PG8_SCHED;
            PG8_STAGE(PG8_SB(1, 1), b3 + hstep, voffB);
            PG8_WAIT_V(6); PG8_BAR; PG8_MMA(1, 1, At, B1); PG8_BAR;
            }
        }
        if constexpr (FP8) asm volatile("s_nop 15\n\ts_nop 15\n\ts_nop 15\n\ts_nop 15" ::: "memory");
        if constexpr (ALIGN_EPI) { if (wr == 0) PG8_BAR; }
        if constexpr (!Epi::AFTER_DRAIN) { if constexpr (Epi::MIDK) E(acc, cur, wr, wc, fr, fq, ui); else E(acc, cur, wr, wc, fr, fq); S.done(cur); }
        if (!has_next) break;
#pragma unroll
        for (int a = 0; a < 2; ++a)
#pragma unroll
            for (int b = 0; b < 2; ++b)
#pragma unroll
                for (int m = 0; m < 4; ++m)
#pragma unroll
                    for (int n = 0; n < 2; ++n) acc[a][b][m][n] = (f32x4){0.f, 0.f, 0.f, 0.f};
        cur = nxt; cA = nA; cB = nB; ++ui;
        if constexpr (ALIGN_EPI) { if (wr == 1) PG8_BAR; }
    }
    PG8_WAIT_V(0);
    if constexpr (!ALIGN_EPI) { if (wr == 0) PG8_BAR; }
    PG8_BAR;
    if constexpr (Epi::AFTER_DRAIN) { E.fused(acc, cur, wr, wc, fr, fq, lds, wid, lane); S.done(cur); }
#undef PG8_SA
#undef PG8_SB
#undef PG8_STAGE
#undef PG8_LDA
#undef PG8_LDB
#undef PG8_MMA
#undef PG8_WAIT_V
#undef PG8_WAIT_L
#undef PG8_BAR
#undef PG8_SCHED
}
}
#define LAS __attribute__((address_space(3)))
typedef unsigned short bf16_t;
typedef short bf16x8 __attribute__((ext_vector_type(8)));
typedef float f32x4 __attribute__((ext_vector_type(4)));
typedef float f32x16 __attribute__((ext_vector_type(16)));
typedef unsigned u32x4 __attribute__((ext_vector_type(4)));
typedef unsigned u32x2 __attribute__((ext_vector_type(2)));

constexpr int DM = 2048, SEQ = 2048, MP = 8192, NS = 32, MT = MP + NS, MPAD = 8448;
constexpr int DFF = 5504, NUP = 2 * DFF, INW = 3584, NMOD = 18432, NC = 36;
constexpr int DFFP = 5632;
constexpr float W_UP_SCALE = 32.f, W_DN_SCALE = 64.f, ACT_SCALE = 4.f, W_O_SCALE = 64.f, MIX_SCALE = 4.f;
constexpr float ALPHA = 1.189207115002721f;
constexpr float LN_EPS = 1e-5f;
constexpr int LDS_BYTES = 147456;
constexpr size_t OFF_YP = 0, OFF_YS = 16777216, OFF_KWP = OFF_YS + 65536, OFF_VWP = OFF_KWP + 131072, OFF_KWS = OFF_VWP + 131072, OFF_VWS = OFF_KWS + 1048576, OFF_GVS = OFF_VWS + 1048576;
constexpr size_t MiB = 1u << 20;
constexpr size_t WS_CTL = 0, WS_MOD = 1 * MiB, WS_ROPE = 4 * MiB, WS_SS = 5 * MiB, WS_WUP = 8 * MiB, WS_WDN = 96 * MiB, WS_WIN = 140 * MiB, WS_WO = 154 * MiB,
                 WS_H = 162 * MiB, WS_ACT = 196 * MiB, WS_Y = 286 * MiB, WS_X1 = 352 * MiB, WS_Q = 418 * MiB, WS_U = 436 * MiB, WS_GV = 453 * MiB, WS_K = 470 * MiB, WS_V = 475 * MiB,
                 WS_MIX = 480 * MiB, WS_H8 = 514 * MiB, WS_END = 532 * MiB;
constexpr size_t WS_STATS = WS_SS + 917504;
constexpr size_t WS_PART = WS_Y + 40 * MiB;
constexpr size_t WUP_ELEMS = (size_t)NUP * DM, WDN_ELEMS = (size_t)DM * DFF, WDN8_BYTES = (size_t)DM * DFFP;

struct Args { const float* in[20]; float* out; unsigned char* ws; };
typedef const Args __attribute__((address_space(4)))* KArgsPtr;

__device__ __forceinline__ unsigned pk2(float lo, float hi) { return pg8::cvt_pk_bf16(lo, hi); }
__device__ __forceinline__ float bf2f(unsigned short b) { return __builtin_bit_cast(float, (unsigned)b << 16); }
__device__ __forceinline__ float bflo(unsigned w) { return __builtin_bit_cast(float, w << 16); }
__device__ __forceinline__ float bfhi(unsigned w) { return __builtin_bit_cast(float, w & 0xffff0000u); }
__device__ __forceinline__ float wave_sum(float v) {
#pragma unroll
    for (int o = 1; o < 64; o <<= 1) v += __shfl_xor(v, o);
    return v;
}
__device__ __forceinline__ float wave_max(float v) {
#pragma unroll
    for (int o = 1; o < 64; o <<= 1) v = fmaxf(v, __shfl_xor(v, o));
    return v;
}
__device__ __forceinline__ float silu_f(float g) { return g * __builtin_amdgcn_rcpf(1.f + __expf(-g)); }
__device__ __forceinline__ float gelu_f(float x) { const float t = 1.5957691216057308f * (x + 0.044715f * x * x * x); return x * __builtin_amdgcn_rcpf(1.f + __expf(-t)); }
__device__ __forceinline__ bf16x8 pack8(float a0, float a1, float a2, float a3, float a4, float a5, float a6, float a7) {
    u32x4 w; w.x = pk2(a0, a1); w.y = pk2(a2, a3); w.z = pk2(a4, a5); w.w = pk2(a6, a7); return __builtin_bit_cast(bf16x8, w);
}
__device__ __forceinline__ unsigned pk4_fp8(float a, float b, float c, float d) { return (unsigned)__builtin_amdgcn_cvt_pk_fp8_f32(c, d, __builtin_amdgcn_cvt_pk_fp8_f32(a, b, 0, false), true); }
#define MFMA16(A, B, C) __builtin_amdgcn_mfma_f32_16x16x32_bf16((A), (B), (C), 0, 0, 0)

using pg8::Unit;
struct EpiSwiGLU {
    static constexpr bool PERM = true, AFTER_DRAIN = false, MIDK = false;
    unsigned char* O;
    __device__ __forceinline__ void operator()(const f32x4 (&acc)[2][2][4][2], const Unit& u, int wr, int wc, int fr, int fq) const {
        const int row0 = u.pm * 256 + wr * 64 + fr, col0 = u.pn * 128 + wc * 32 + 8 * fq;
        constexpr float IS = 1.f / W_UP_SCALE, OS = ACT_SCALE / W_UP_SCALE;
#pragma unroll
        for (int ai = 0; ai < 2; ++ai)
#pragma unroll
            for (int m = 0; m < 4; ++m) {
                unsigned char* rowp = O + (unsigned)(row0 + ai * 128 + m * 16) * (unsigned)DFFP + (unsigned)col0;
                const f32x4 v0 = acc[ai][0][m][0] * OS, v1 = acc[ai][0][m][1] * OS, g0 = acc[ai][1][m][0] * IS, g1 = acc[ai][1][m][1] * IS;
                u32x2 w;
                w.x = pk4_fp8(silu_f(g0[0]) * v0[0], silu_f(g0[1]) * v0[1], silu_f(g0[2]) * v0[2], silu_f(g0[3]) * v0[3]);
                w.y = pk4_fp8(silu_f(g1[0]) * v1[0], silu_f(g1[1]) * v1[1], silu_f(g1[2]) * v1[2], silu_f(g1[3]) * v1[3]);
                *(u32x2*)rowp = w;
            }
    }
};
template <int XB  > struct EpiResid {
    static constexpr bool PERM = false, AFTER_DRAIN = false, MIDK = false;
    const void* xres; bf16_t* Y; const float* gate; static constexpr float coef = 0.5f / (W_DN_SCALE * ACT_SCALE);
    const float* lng; const float* lnb; const float* stats;
    __device__ __forceinline__ void operator()(const f32x4 (&acc)[2][2][4][2], const Unit& u, int wr, int wc, int fr, int fq) const {
        const int b = u.pm >> 3, col0 = u.pn * 256 + wc * 32 + 4 * fq, row0 = u.pm * 256 + wr * 64 + fr;
        f32x4 g4[2][2];
#pragma unroll
        for (int bj = 0; bj < 2; ++bj)
#pragma unroll
            for (int n = 0; n < 2; ++n) g4[bj][n] = *(const f32x4*)(gate + (size_t)b * NMOD + col0 + bj * 128 + n * 16) * coef;
        f32x4 lg[2][2], lb[2][2];
        if (XB == 2) {
#pragma unroll
            for (int bj = 0; bj < 2; ++bj)
#pragma unroll
                for (int n = 0; n < 2; ++n) { lg[bj][n] = *(const f32x4*)(lng + col0 + bj * 128 + n * 16); lb[bj][n] = *(const f32x4*)(lnb + col0 + bj * 128 + n * 16); }
        }
#pragma unroll
        for (int ai = 0; ai < 2; ++ai)
#pragma unroll
            for (int m = 0; m < 4; ++m) {
                const unsigned off = (unsigned)(row0 + ai * 128 + m * 16) * (unsigned)DM + (unsigned)col0;
                float mu = 0.f, rs_ = 1.f;
                if (XB == 2) { const unsigned r = (unsigned)(row0 + ai * 128 + m * 16); mu = stats[2 * r]; rs_ = stats[2 * r + 1]; }
#pragma unroll
                for (int bj = 0; bj < 2; ++bj)
#pragma unroll
                    for (int n = 0; n < 2; ++n) {
                        f32x4 xr;
                        if (XB == 2) { const u32x2 yw = *(const u32x2*)(Y + off + bj * 128 + n * 16); xr = ((f32x4){bflo(yw.x), bfhi(yw.x), bflo(yw.y), bfhi(yw.y)} - mu) * rs_ * lg[bj][n] + lb[bj][n]; }
                        else if (XB == 1) { const u32x2 xw = *(const u32x2*)((const bf16_t*)xres + off + bj * 128 + n * 16); xr = (f32x4){bflo(xw.x), bfhi(xw.x), bflo(xw.y), bfhi(xw.y)}; }
                        else xr = *(const f32x4*)((const float*)xres + off + bj * 128 + n * 16);
                        const f32x4 y = xr * ALPHA + g4[bj][n] * acc[ai][bj][m][n]; u32x2 wv; wv.x = pk2(y[0], y[1]); wv.y = pk2(y[2], y[3]);
                        *(u32x2*)(Y + off + bj * 128 + n * 16) = wv;
                    }
            }
    }
};
struct EpiResidMix {
    static constexpr bool PERM = false, AFTER_DRAIN = false, MIDK = true;
    bf16_t* Y; const float* gate; const LAS float* rs; const float* lng; const float* lnb; const float* stats;
    __device__ __forceinline__ void mid(f32x4 (&acc)[2][2][4][2], int ui, int wr, int fr) const {
#pragma unroll
        for (int ai = 0; ai < 2; ++ai)
#pragma unroll
            for (int m = 0; m < 4; ++m) {
                const float f = rs[((ui & 3) * 256 + ai * 128 + wr * 64 + m * 16 + fr) * 2];
#pragma unroll
                for (int bj = 0; bj < 2; ++bj)
#pragma unroll
                    for (int n = 0; n < 2; ++n) acc[ai][bj][m][n] = acc[ai][bj][m][n] * f;
            }
    }
    __device__ __forceinline__ void operator()(const f32x4 (&acc)[2][2][4][2], const Unit& u, int wr, int wc, int fr, int fq, int ui) const {
        const int b = u.pm >> 3, col0 = u.pn * 256 + wc * 32 + 4 * fq, row0 = u.pm * 256 + wr * 64 + fr;
        f32x4 g4[2][2];
#pragma unroll
        for (int bj = 0; bj < 2; ++bj)
#pragma unroll
            for (int n = 0; n < 2; ++n) g4[bj][n] = *(const f32x4*)(gate + (size_t)b * NMOD + col0 + bj * 128 + n * 16) * (1.0f / (W_O_SCALE * MIX_SCALE));
        f32x4 lg[2][2], lb[2][2];
#pragma unroll
        for (int bj = 0; bj < 2; ++bj)
#pragma unroll
            for (int n = 0; n < 2; ++n) { lg[bj][n] = *(const f32x4*)(lng + col0 + bj * 128 + n * 16); lb[bj][n] = *(const f32x4*)(lnb + col0 + bj * 128 + n * 16); }
#pragma unroll
        for (int ai = 0; ai < 2; ++ai)
#pragma unroll
            for (int m = 0; m < 4; ++m) {
                const unsigned off = (unsigned)(row0 + ai * 128 + m * 16) * (unsigned)DM + (unsigned)col0;
                const float rg = rs[((ui & 3) * 256 + ai * 128 + wr * 64 + m * 16 + fr) * 2 + 1];
                const unsigned rr = (unsigned)(row0 + ai * 128 + m * 16); const float mu = stats[2 * rr], rs_ = stats[2 * rr + 1];
#pragma unroll
                for (int bj = 0; bj < 2; ++bj)
#pragma unroll
                    for (int n = 0; n < 2; ++n) {
                        const u32x2 yw = *(const u32x2*)(Y + off + bj * 128 + n * 16);
                        const f32x4 xr = ((f32x4){bflo(yw.x), bfhi(yw.x), bflo(yw.y), bfhi(yw.y)} - mu) * rs_ * lg[bj][n] + lb[bj][n];
                        const f32x4 y = xr * ALPHA + g4[bj][n] * (acc[ai][bj][m][n] * rg); u32x2 wv; wv.x = pk2(y[0], y[1]); wv.y = pk2(y[2], y[3]);
                        *(u32x2*)(Y + off + bj * 128 + n * 16) = wv;
                    }
            }
    }
};
__device__ __forceinline__ void rs_table(KArgsPtr a, LAS float* rs, const pg8::StaticOrder& S, int tid) {
    const float* SS = (const float*)(a->ws + WS_SS);
    const int rl = tid >> 1, hf = tid & 1;
    Unit u;
    for (int i = 0; i < 4 && S.next(i, u); ++i) {
        const f32x4* sp = (const f32x4*)(SS + (size_t)(u.pm * 256 + rl) * 24);
        float sum;
        if (hf == 0) { const f32x4 a0 = sp[0], a1 = sp[1], a2 = sp[2], a3 = sp[3]; sum = ((a0[0] + a0[1]) + (a0[2] + a0[3])) + ((a1[0] + a1[1]) + (a1[2] + a1[3])) + ((a2[0] + a2[1]) + (a2[2] + a2[3])) + ((a3[0] + a3[1]) + (a3[2] + a3[3])); }
        else { const f32x4 b0 = sp[4], b1 = sp[5]; sum = ((b0[0] + b0[1]) + (b0[2] + b0[3])) + ((b1[0] + b1[1]) + (b1[2] + b1[3])); }
        const float r = 1.f / sqrtf(sum * (1.f / 1024.f) + LN_EPS);
        const float other = __shfl_xor(r, 1);
        if (hf == 0) { rs[(i * 256 + rl) * 2] = r / other; rs[(i * 256 + rl) * 2 + 1] = other; }
    }
    __syncthreads();
}
struct EpiInProj {
    static constexpr bool PERM = false, AFTER_DRAIN = false, MIDK = false;
    bf16_t *Q, *Kb, *Vb, *U, *GV; const float* rope; float* out;
    __device__ __forceinline__ void operator()(const f32x4 (&acc)[2][2][4][2], const Unit& u, int wr, int wc, int fr, int fq) const {
        const int pn = u.pn, pm = u.pm; const bool samp = (pm == 32);
        const unsigned cl = wc * 32 + 4 * fq;
        if (pn < 6) {
            bf16_t* dst = pn < 4 ? Q + pn * 256 : (pn == 4 ? Kb : Vb);
            const unsigned ld = pn < 4 ? 1024u : 256u;
            const float qs = pn < 4 ? 0.125f : 1.f;
            const bool rot = (pn != 5) && ((wc & 1) == 0);
            float* wout = out + (samp ? (pn == 4 ? OFF_KWS : OFF_VWS) : (pn == 4 ? OFF_KWP : OFF_VWP));
#pragma unroll
            for (int ai = 0; ai < 2; ++ai)
#pragma unroll
                for (int m = 0; m < 4; ++m) {
                    const unsigned rowl = ai * 128 + wr * 64 + m * 16 + fr, row = pm * 256 + rowl;
                    f32x4 cs = {1.f, 1.f, 1.f, 1.f}, sn = {0.f, 0.f, 0.f, 0.f};
                    if (rot) { const unsigned pi = samp ? 2048u : (row & 2047u); cs = *(const f32x4*)(rope + pi * 16u + 4u * (fq & 1)); sn = *(const f32x4*)(rope + pi * 16u + 8u + 4u * (fq & 1)); }
                    const bool wwin = (pn >= 4) && (samp ? (rowl < (unsigned)NS) : ((pm & 7) == 7 && ai == 1));
                    const unsigned wrow = samp ? (rowl * 128u + 127u) : ((unsigned)(pm >> 3) * 128u + rowl - 128u);
#pragma unroll
                    for (int bj = 0; bj < 2; ++bj)
#pragma unroll
                        for (int n = 0; n < 2; ++n) {
                            f32x4 v = acc[ai][bj][m][n];
                            if (n == 0 && rot) {
                                f32x4 p; p[0] = __shfl_xor(v[0], 32); p[1] = __shfl_xor(v[1], 32); p[2] = __shfl_xor(v[2], 32); p[3] = __shfl_xor(v[3], 32);
                                v = (fq < 2) ? (v * cs - p * sn) : (v * cs + p * sn);
                            }
                            const unsigned c = bj * 128 + n * 16 + cl;
                            if (wwin) *(f32x4*)(wout + wrow * 256u + c) = v;
                            v = v * qs; u32x2 w; w.x = pk2(v[0], v[1]); w.y = pk2(v[2], v[3]);
                            *(u32x2*)(dst + row * ld + c) = w;
                        }
                    asm volatile("" ::: "memory");
                }
        } else {
            bf16_t* base = (pn < 10) ? (U + (pn - 6) * 256) : (GV + (pn - 10) * 256);
#pragma unroll
            for (int ai = 0; ai < 2; ++ai)
#pragma unroll
                for (int m = 0; m < 4; ++m) {
                    const unsigned row = pm * 256 + ai * 128 + wr * 64 + m * 16 + fr;
#pragma unroll
                    for (int bj = 0; bj < 2; ++bj)
#pragma unroll
                        for (int n = 0; n < 2; ++n) {
                            const f32x4 v = acc[ai][bj][m][n];
                            u32x2 w; w.x = pk2(gelu_f(v[0]), gelu_f(v[1])); w.y = pk2(gelu_f(v[2]), gelu_f(v[3]));
                            *(u32x2*)(base + row * 1024u + bj * 128 + n * 16 + cl) = w;
                        }
                    asm volatile("" ::: "memory");
                }
        }
    }
};

__device__ __forceinline__ void ada_item(KArgsPtr a, LAS unsigned char* lds, int it, int tid) {
    const int w = __builtin_amdgcn_readfirstlane(tid >> 6), lane = tid & 63, fr = lane & 15, fq = lane >> 4;
    const int g = w & 1, kq = w >> 1;
    const float* W = a->in[6]; const int c0 = it * 128;
    f32x4 acc[4][3];
#pragma unroll
    for (int nt = 0; nt < 4; ++nt)
#pragma unroll
        for (int mt = 0; mt < 3; ++mt) acc[nt][mt] = (f32x4){0.f, 0.f, 0.f, 0.f};
    for (int i4 = 0; i4 < 4; ++i4) {
        const int kb = 512 * kq + 128 * i4 + 8 * fq;
        f32x4 wv[4][8];
#pragma unroll
        for (int sx = 0; sx < 4; ++sx)
#pragma unroll
            for (int e = 0; e < 8; ++e) wv[sx][e] = __builtin_nontemporal_load((const f32x4*)(W + (size_t)(kb + 32 * sx + e) * NMOD + c0 + 64 * g + 4 * fr));
#pragma unroll
        for (int sx = 0; sx < 4; ++sx) {
            const int k0 = kb + 32 * sx;
            bf16x8 sc[3];
#pragma unroll
            for (int mt = 0; mt < 3; ++mt) {
                const int r = 16 * mt + fr;
                if (r < NC) {
                    const float* cp = (r < 4 ? a->in[4] + (size_t)r * DM : a->in[5] + (size_t)(r - 4) * DM) + k0;
                    const f32x4 x0 = *(const f32x4*)cp, x1 = *(const f32x4*)(cp + 4);
                    sc[mt] = pack8(silu_f(x0[0]), silu_f(x0[1]), silu_f(x0[2]), silu_f(x0[3]), silu_f(x1[0]), silu_f(x1[1]), silu_f(x1[2]), silu_f(x1[3]));
                } else sc[mt] = (bf16x8){0, 0, 0, 0, 0, 0, 0, 0};
            }
#pragma unroll
            for (int nt = 0; nt < 4; ++nt) {
                const bf16x8 wf = pack8(wv[sx][0][nt], wv[sx][1][nt], wv[sx][2][nt], wv[sx][3][nt], wv[sx][4][nt], wv[sx][5][nt], wv[sx][6][nt], wv[sx][7][nt]);
#pragma unroll
                for (int mt = 0; mt < 3; ++mt) acc[nt][mt] = MFMA16(wf, sc[mt], acc[nt][mt]);
            }
        }
    }
    LAS float* red = (LAS float*)(lds + 69632);
    for (int ww = 0; ww < 8; ++ww) {
        if (w == ww) {
#pragma unroll
            for (int nt = 0; nt < 4; ++nt)
#pragma unroll
                for (int mt = 0; mt < 3; ++mt)
#pragma unroll
                    for (int rg = 0; rg < 4; ++rg) {
                        const int idx = (16 * mt + fr) * 132 + 64 * g + 16 * fq + 4 * rg + nt;
                        if (kq == 0) red[idx] = acc[nt][mt][rg]; else red[idx] += acc[nt][mt][rg];
                    }
        }
        __syncthreads();
    }
    float* mod = (float*)(a->ws + WS_MOD);
    for (int e = tid; e < NC * 128; e += 512) { const int r = e >> 7, c = e & 127; mod[(size_t)r * NMOD + c0 + c] = red[r * 132 + c] + a->in[7][c0 + c]; }
    __syncthreads();
}
constexpr int I_UP = (DM / 64) * (NUP / 32), I_DN = (DFF / 64) * (DM / 32), I_IN = (DM / 64) * (INW / 32), I_WO = (DM / 64) * (DM / 32);
constexpr int N_TR = 2 * I_UP + 2 * I_DN + I_IN + I_WO;
constexpr int N_UP1_DEF = 4096;
constexpr int N_TR_P0 = 2 * I_UP - N_UP1_DEF + I_IN;
constexpr int N_TR_TAIL = 2048;
struct TrItem { const float* src; unsigned char* dst; int N, rowb; float scale; };
__device__ __forceinline__ void tr_decode(KArgsPtr a, int it, int lane, TrItem& d) {
    const float* W; unsigned char* WT; int N, kind = 0, r = it, rowb, esz; float scale = 0.f;
    if (r < 2 * I_UP) { const int l = r >= I_UP ? 1 : 0; r -= l * I_UP; W = a->in[10] + (size_t)l * WUP_ELEMS; WT = a->ws + WS_WUP + (size_t)l * WUP_ELEMS; rowb = DM; esz = 1; N = NUP; kind = 1; scale = W_UP_SCALE; }
    else if ((r -= 2 * I_UP) < 2 * I_DN) { const int l = r >= I_DN ? 1 : 0; r -= l * I_DN; W = a->in[11] + (size_t)l * WDN_ELEMS; WT = a->ws + WS_WDN + (size_t)l * WDN8_BYTES; rowb = DFFP; esz = 1; N = DM; scale = W_DN_SCALE; }
    else if ((r -= 2 * I_DN) < I_IN) { W = a->in[12]; WT = a->ws + WS_WIN; rowb = 2 * DM; esz = 2; N = INW; }
    else { r -= I_IN; W = a->in[19]; WT = a->ws + WS_WO; rowb = DM; esz = 1; N = DM; scale = W_O_SCALE; }
    const int nblk = N / 32, kb = r / nblk, nb = r - kb * nblk, k0 = 64 * kb, n0 = 32 * nb;
    int d0 = n0;
    if (kind) { const int bj = n0 >= DFF ? 1 : 0, q = n0 - bj * DFF; d0 = 256 * (q >> 7) + 128 * bj + (q & 127); }
    d.src = W + (size_t)(k0 + (lane >> 5)) * N + n0 + (lane & 31);
    d.dst = WT + (size_t)(d0 + (lane >> 3)) * rowb + (size_t)(k0 + 8 * (lane & 7)) * esz;
    d.N = N; d.rowb = rowb; d.scale = scale;
}
__device__ __forceinline__ void tr_load(const TrItem& d, float (&v)[32]) {
#pragma unroll
    for (int i = 0; i < 32; ++i) v[i] = __builtin_nontemporal_load(d.src + (size_t)(2 * i) * d.N);
}
__device__ __forceinline__ void tr_store(const TrItem& d, const float (&v)[32], LAS float* scr, int lane) {
#pragma unroll
    for (int i = 0; i < 32; ++i) scr[(2 * i + (lane >> 5)) * 33 + (lane & 31)] = v[i];
    asm volatile("s_waitcnt lgkmcnt(0)" ::: "memory");
    const int c = lane & 7;
    if (d.scale == 0.f) {
#pragma unroll
        for (int j = 0; j < 4; ++j) { const LAS float* sp = scr + (8 * c) * 33 + (lane >> 3) + 8 * j;
            u32x4 o; o.x = pk2(sp[0 * 33], sp[1 * 33]); o.y = pk2(sp[2 * 33], sp[3 * 33]); o.z = pk2(sp[4 * 33], sp[5 * 33]); o.w = pk2(sp[6 * 33], sp[7 * 33]);
            *(u32x4*)(d.dst + (size_t)(8 * j) * d.rowb) = o; }
    } else {
        const float sc = d.scale;
#pragma unroll
        for (int j = 0; j < 4; ++j) { const LAS float* sp = scr + (8 * c) * 33 + (lane >> 3) + 8 * j;
            u32x2 o; o.x = pk4_fp8(sp[0 * 33] * sc, sp[1 * 33] * sc, sp[2 * 33] * sc, sp[3 * 33] * sc); o.y = pk4_fp8(sp[4 * 33] * sc, sp[5 * 33] * sc, sp[6 * 33] * sc, sp[7 * 33] * sc);
            *(u32x2*)(d.dst + (size_t)(8 * j) * d.rowb) = o; }
    }
    asm volatile("s_waitcnt lgkmcnt(0)" ::: "memory");
}
__device__ __forceinline__ void p0_phase(KArgsPtr a, LAS unsigned char* lds, int tid, int rep) {
    const int w = __builtin_amdgcn_readfirstlane(tid >> 6), lane = tid & 63, G = gridDim.x;
    const int NADA = NMOD / 128;
#ifndef DUP_ADA
#define DUP_ADA 0
#endif
    if ((int)blockIdx.x < NADA) { for (int rr = 0; rr <= DUP_ADA; ++rr) for (int it = blockIdx.x; it < NADA; it += G) ada_item(a, lds, it, tid); }
    if ((int)blockIdx.x >= NADA || G <= NADA) {
        const int nb = (G > NADA) ? (G - NADA) : G, bi = (G > NADA) ? ((int)blockIdx.x - NADA) : (int)blockIdx.x;
        float* rope = (float*)(a->ws + WS_ROPE);
        for (int e = bi * 512 + tid; e < 2049 * 8; e += nb * 512) {
            const int pi = e >> 3, i = e & 7;
            const float pos = (pi == 2048) ? 16384.f : (float)pi;
            const float inv = (float)exp2(-(double)i * 0.125 * 18.931568569324174);
            const float angf = pos * inv;
            double ang = (double)angf;
            const double k = rint(ang * 0.15915494309189535);
            double r = fma(-k, 6.283185307179586, ang); r = fma(-k, 2.4492935982947064e-16, r);
            const double r2 = r * r;
            double s = -1.0 / 51090942171709440000.0;
            s = s * r2 + 1.0 / 121645100408832000.0; s = s * r2 - 1.0 / 355687428096000.0; s = s * r2 + 1.0 / 1307674368000.0; s = s * r2 - 1.0 / 6227020800.0;
            s = s * r2 + 1.0 / 39916800.0; s = s * r2 - 1.0 / 362880.0; s = s * r2 + 1.0 / 5040.0; s = s * r2 - 1.0 / 120.0; s = s * r2 + 1.0 / 6.0; s = -s * r2 + 1.0; s = s * r;
            double c = 1.0 / 2432902008176640000.0;
            c = c * r2 - 1.0 / 6402373705728000.0; c = c * r2 + 1.0 / 20922789888000.0; c = c * r2 - 1.0 / 87178291200.0; c = c * r2 + 1.0 / 479001600.0;
            c = c * r2 - 1.0 / 3628800.0; c = c * r2 + 1.0 / 40320.0; c = c * r2 - 1.0 / 720.0; c = c * r2 + 1.0 / 24.0; c = c * r2 - 0.5; c = c * r2 + 1.0;
            rope[pi * 16 + i] = (float)c; rope[pi * 16 + 8 + i] = (float)s;
        }
        for (int e = bi * 512 + tid; e < (2 * DM + MPAD) * 8; e += nb * 512) {
            const int rw = e >> 3, q = e & 7;
            unsigned char* base = rw < 2 * DM ? a->ws + WS_WDN + (size_t)rw * DFFP : a->ws + WS_ACT + (size_t)(rw - 2 * DM) * DFFP;
            *(u32x4*)(base + DFF + 16 * q) = (u32x4){0u, 0u, 0u, 0u};
        }
        for (int e = bi * 512 + tid; e < 2 * NS * 127 * 64; e += nb * 512) {
            const int t = e / (NS * 127 * 64), r = e % (NS * 127 * 64), b = r / (127 * 64), q = r % (127 * 64);
            const f32x4 v = *((const f32x4*)(a->in[2 + t] + (size_t)b * 128 * 256 + 256) + q);
            *((f32x4*)(a->out + (t ? OFF_VWS : OFF_KWS) + (size_t)b * 128 * 256) + q) = v;
        }
    }
    {
        const int gw = blockIdx.x * 8 + w, NGW = G * 8;
        LAS float* scr = (LAS float*)(lds + w * 8448);
        const bool has_tail = (G > NADA) && ((int)blockIdx.x >= NADA);
        const int n_main = (G > NADA) ? (N_TR_P0 - N_TR_TAIL) : N_TR_P0;
        const int nm_w = (gw < n_main) ? (n_main - gw + NGW - 1) / NGW : 0;
        const int tw = ((int)blockIdx.x - NADA) * 8 + w, TNW = (G - NADA) * 8;
        const int nt_w = (has_tail && tw < N_TR_TAIL) ? (N_TR_TAIL - tw + TNW - 1) / TNW : 0;
        const int n_w = nm_w + nt_w;
        for (int k = 0; k < n_w; k += 4) {
            TrItem d[4]; float v[4][32];
#pragma unroll
            for (int q = 0; q < 4; ++q) if (k + q < n_w) { const int kk = k + q; int it = kk < nm_w ? gw + kk * NGW : n_main + tw + (kk - nm_w) * TNW; if (it >= 2 * I_UP - N_UP1_DEF) it += 2 * I_DN + N_UP1_DEF;     tr_decode(a, it, lane, d[q]); tr_load(d[q], v[q]); }
#pragma unroll
            for (int q = 0; q < 4; ++q) if (k + q < n_w) tr_store(d[q], v[q], scr, lane);
        }
    }
}
__device__ __forceinline__ void tr_deferred(KArgsPtr a, LAS unsigned char* lds, int tid, int first, int count, int bi, int nblk) {
    const int w = __builtin_amdgcn_readfirstlane(tid >> 6), lane = tid & 63;
    LAS float* scr = (LAS float*)(lds + w * 8448);
    const int tw = bi * 8 + w, TNW = nblk * 8;
    const int n_w = (tw < count) ? (count - tw + TNW - 1) / TNW : 0;
    for (int k = 0; k < n_w; k += 4) {
        TrItem d[4]; float v[4][32];
#pragma unroll
        for (int q = 0; q < 4; ++q) if (k + q < n_w) { tr_decode(a, first + tw + (k + q) * TNW, lane, d[q]); tr_load(d[q], v[q]); }
#pragma unroll
        for (int q = 0; q < 4; ++q) if (k + q < n_w) tr_store(d[q], v[q], scr, lane);
    }
}
__device__ __forceinline__ const float* mod_row(KArgsPtr a, int row, int sub) {
    const int b = row < MP ? (row >> 11) : (4 + row - MP);
    return (const float*)(a->ws + WS_MOD) + (size_t)b * NMOD + sub * 6144;
}
__device__ __forceinline__ void h0_phase(KArgsPtr a, int tid) {
    const unsigned lane = tid & 63; const int gw = blockIdx.x * 8 + __builtin_amdgcn_readfirstlane(tid >> 6), NGW = gridDim.x * 8;
    unsigned char* H8 = a->ws + WS_H8;
    for (int r0 = 4 * gw; r0 < MP; r0 += 4 * NGW) {
        const f32x4* sh = (const f32x4*)mod_row(a, r0, 0); const f32x4* scl = sh + 512;
        f32x4 ps[8], ph[8];
#pragma unroll
        for (int j = 0; j < 8; ++j) { const unsigned c = 64u * j + lane; ps[j] = scl[c] + 1.f; ph[j] = sh[c]; }
#pragma unroll
        for (int q0 = 0; q0 < 4; q0 += 2) {
            f32x4 xv[2][8];
#pragma unroll
            for (int q = 0; q < 2; ++q) { const f32x4* xr = (const f32x4*)(a->in[0] + (size_t)(r0 + q0 + q) * DM);
#pragma unroll
                for (int j = 0; j < 8; ++j) xv[q][j] = __builtin_nontemporal_load(xr + (64u * j + lane)); }
#pragma unroll
            for (int q = 0; q < 2; ++q) { unsigned* o = (unsigned*)(H8 + (size_t)(r0 + q0 + q) * DM);
#pragma unroll
                for (int j = 0; j < 8; ++j) { const f32x4 h = xv[q][j] * ps[j] + ph[j]; o[64u * j + lane] = pk4_fp8(h[0], h[1], h[2], h[3]); } }
        }
    }
    const int w = __builtin_amdgcn_readfirstlane(tid >> 6);
    for (int t = blockIdx.x; t < NS; t += gridDim.x) {
        const int row = MP + t; const unsigned c = 64u * w + lane;
        const f32x4 x = ((const f32x4*)(a->in[1] + (size_t)t * DM))[c];
        const f32x4* sh = (const f32x4*)mod_row(a, row, 0); const f32x4* scl = sh + 512;
        const f32x4 h = x * (scl[c] + 1.f) + sh[c];
        ((unsigned*)(H8 + (size_t)row * DM))[c] = pk4_fp8(h[0], h[1], h[2], h[3]);
    }
}
__device__ __forceinline__ void ln_finish(KArgsPtr a, f32x4 (&v)[8], int row, unsigned lane, int li, bool final_out, int next_sub) {
    const f32x4* g4 = (const f32x4*)(a->in[8] + li * DM); const f32x4* b4 = (const f32x4*)(a->in[9] + li * DM);
    bf16_t* X1 = (bf16_t*)(a->ws + WS_X1); bf16_t* H = (bf16_t*)(a->ws + WS_H);
    float s = 0.f;
#pragma unroll
    for (int j = 0; j < 8; ++j) s += (v[j][0] + v[j][1]) + (v[j][2] + v[j][3]);
    const float mean = wave_sum(s) * (1.f / DM); float q = 0.f;
#pragma unroll
    for (int j = 0; j < 8; ++j) { v[j] = v[j] - mean; q += (v[j][0] * v[j][0] + v[j][1] * v[j][1]) + (v[j][2] * v[j][2] + v[j][3] * v[j][3]); }
    const float rstd = 1.f / sqrtf(wave_sum(q) * (1.f / DM) + LN_EPS);
    f32x4* xo = (f32x4*)(row < MP ? a->out + OFF_YP + (size_t)row * DM : a->out + OFF_YS + (size_t)(row - MP) * DM);
    if (!final_out && lane == 0) { float* st = (float*)(a->ws + WS_STATS) + 2 * (size_t)row; st[0] = mean; st[1] = rstd; }
    const f32x4* sh = (const f32x4*)mod_row(a, row, final_out ? 0 : next_sub); const f32x4* scl = sh + 512;
    u32x2* ho = (u32x2*)(H + (size_t)row * DM); unsigned* ho8 = (unsigned*)(a->ws + WS_H8 + (size_t)row * DM);
#pragma unroll
    for (int j = 0; j < 8; ++j) {
        const unsigned c = 64u * j + lane; const f32x4 x = v[j] * rstd * g4[c] + b4[c]; if (final_out) xo[c] = x;
        if (!final_out) { const f32x4 h = x * (scl[c] + 1.f) + sh[c];
            if (next_sub == 2) ho8[c] = pk4_fp8(h[0], h[1], h[2], h[3]);
            else { u32x2 wv; wv.x = pk2(h[0], h[1]); wv.y = pk2(h[2], h[3]); ho[c] = wv; } }
        if (j & 1) asm volatile("" ::: "memory");
    }
}
__device__ __forceinline__ void ln_phase(KArgsPtr a, LAS unsigned char* lds, int tid, int li, bool final_out, int next_sub) {
    const unsigned lane = tid & 63; const int gw = blockIdx.x * 8 + __builtin_amdgcn_readfirstlane(tid >> 6), NGW = gridDim.x * 8;
    const bf16_t* Y = (const bf16_t*)(a->ws + WS_Y); const bf16_t* X1 = (const bf16_t*)(a->ws + WS_X1);
    for (int r0 = 4 * gw; r0 < MP; r0 += 4 * NGW) {
        const f32x4* g4 = (const f32x4*)(a->in[8] + li * DM); const f32x4* b4 = (const f32x4*)(a->in[9] + li * DM);
        const f32x4* sh = (const f32x4*)mod_row(a, r0, final_out ? 0 : next_sub); const f32x4* scl = sh + 512;
        f32x4 pg[8], pb[8], ps[8], ph[8];
#pragma unroll
        for (int j = 0; j < 8; ++j) { const unsigned c = 64u * j + lane; pg[j] = g4[c]; pb[j] = b4[c];
            if (!final_out) { ps[j] = scl[c] + 1.f; ph[j] = sh[c]; pg[j] = pg[j] * ps[j]; pb[j] = pb[j] * ps[j] + ph[j]; } }
        u32x2 yw[2][8];
#pragma unroll
        for (int j = 0; j < 8; ++j) yw[0][j] = ((const u32x2*)(Y + (size_t)r0 * DM))[64u * j + lane];
#pragma unroll
        for (int q = 0; q < 4; ++q) {
            const int row = r0 + q;
            if (q < 3) {
#pragma unroll
                for (int j = 0; j < 8; ++j) yw[(q + 1) & 1][j] = ((const u32x2*)(Y + (size_t)(row + 1) * DM))[64u * j + lane];
            }
            f32x4 v[8]; float sm = 0.f;
#pragma unroll
            for (int j = 0; j < 8; ++j) { const u32x2 y2 = yw[q & 1][j]; v[j] = (f32x4){bflo(y2.x), bfhi(y2.x), bflo(y2.y), bfhi(y2.y)}; sm += (v[j][0] + v[j][1]) + (v[j][2] + v[j][3]); }
            const float mean = wave_sum(sm) * (1.f / DM); float qq = 0.f;
#pragma unroll
            for (int j = 0; j < 8; ++j) { v[j] = v[j] - mean; qq += (v[j][0] * v[j][0] + v[j][1] * v[j][1]) + (v[j][2] * v[j][2] + v[j][3] * v[j][3]); }
            const float rstd = 1.f / sqrtf(wave_sum(qq) * (1.f / DM) + LN_EPS);
            if (!final_out && lane == 0) { float* st = (float*)(a->ws + WS_STATS) + 2 * (size_t)row; st[0] = mean; st[1] = rstd; }
            f32x4* xo = (f32x4*)(a->out + OFF_YP + (size_t)row * DM);
            u32x2* ho = (u32x2*)(a->ws + WS_H + (size_t)row * DM * 2); unsigned* ho8 = (unsigned*)(a->ws + WS_H8 + (size_t)row * DM);
#pragma unroll
            for (int j = 0; j < 8; ++j) {
                const unsigned c = 64u * j + lane; const f32x4 x = v[j] * rstd * pg[j] + pb[j];
                if (final_out) xo[c] = x;
                else { const f32x4 h = x;
                    if (next_sub == 2) ho8[c] = pk4_fp8(h[0], h[1], h[2], h[3]);
                    else { u32x2 wv; wv.x = pk2(h[0], h[1]); wv.y = pk2(h[2], h[3]); ho[c] = wv; } }
            }
        }
    }
    const int w = __builtin_amdgcn_readfirstlane(tid >> 6);
    LAS float* red = (LAS float*)lds;
    for (int t = blockIdx.x; t < NS; t += gridDim.x) {
        const int row = MP + t; const float coef = (li == 1) ? 1.0f / (W_O_SCALE * MIX_SCALE) : 0.5f / (W_DN_SCALE * ACT_SCALE);
        const unsigned c = 64u * w + lane;
        float ra = 1.f, rg = 1.f;
        if (li == 1) {
            const float sv = (lane < 24) ? ((const float*)(a->ws + WS_SS))[(size_t)row * 24 + lane] : 0.f;
            const float sa = wave_sum(lane < 16 ? sv : 0.f), sg = wave_sum(lane >= 16 ? sv : 0.f);
            ra = 1.f / sqrtf(sa * (1.f / 1024.f) + LN_EPS); rg = 1.f / sqrtf(sg * (1.f / 1024.f) + LN_EPS);
        }
        const f32x4* xs = (const f32x4*)(a->in[1] + (size_t)t * DM); const u32x2* xsb = (const u32x2*)(X1 + (size_t)row * DM);
        const f32x4* gt = (const f32x4*)(mod_row(a, row, li) + 4096);
        const f32x4* pp = (const f32x4*)((const float*)(a->ws + WS_PART) + (size_t)t * DM);
        const f32x4 sm = (pp[c] + pp[c + 32 * 512]) * ra + (pp[c + 64 * 512] + pp[c + 96 * 512]) * rg;
        f32x4 xv; if (li == 0) xv = xs[c]; else { const u32x2 xw = xsb[c]; xv = (f32x4){bflo(xw.x), bfhi(xw.x), bflo(xw.y), bfhi(xw.y)}; }
        f32x4 v = xv * ALPHA + gt[c] * coef * sm;
        const float s = wave_sum((v[0] + v[1]) + (v[2] + v[3]));
        if (lane == 0) red[w] = s;
        __syncthreads();
        const float mean = (((red[0] + red[1]) + (red[2] + red[3])) + ((red[4] + red[5]) + (red[6] + red[7]))) * (1.f / DM);
        v = v - mean;
        const float q = wave_sum((v[0] * v[0] + v[1] * v[1]) + (v[2] * v[2] + v[3] * v[3]));
        if (lane == 0) red[8 + w] = q;
        __syncthreads();
        const float rstd = 1.f / sqrtf((((red[8] + red[9]) + (red[10] + red[11])) + ((red[12] + red[13]) + (red[14] + red[15]))) * (1.f / DM) + LN_EPS);
        const f32x4* g4 = (const f32x4*)(a->in[8] + li * DM); const f32x4* b4 = (const f32x4*)(a->in[9] + li * DM);
        const f32x4 x = v * rstd * g4[c] + b4[c];
        if (final_out) ((f32x4*)(a->out + OFF_YS + (size_t)t * DM))[c] = x;
        else {
            u32x2 xw; xw.x = pk2(x[0], x[1]); xw.y = pk2(x[2], x[3]); ((u32x2*)(a->ws + WS_X1 + (size_t)row * DM * 2))[c] = xw;
            const f32x4* sh = (const f32x4*)mod_row(a, row, next_sub); const f32x4* scl = sh + 512;
            const f32x4 h = x * (scl[c] + 1.f) + sh[c];
            if (next_sub == 2) ((unsigned*)(a->ws + WS_H8 + (size_t)row * DM))[c] = pk4_fp8(h[0], h[1], h[2], h[3]);
            else { u32x2 hw; hw.x = pk2(h[0], h[1]); hw.y = pk2(h[2], h[3]); ((u32x2*)(a->ws + WS_H + (size_t)row * DM * 2))[c] = hw; }
        }
        __syncthreads();
    }
}
__device__ __forceinline__ void merge_phase(KArgsPtr a, int tid) {
    const unsigned lane = tid & 63; const int gw = blockIdx.x * 8 + __builtin_amdgcn_readfirstlane(tid >> 6), NGW = gridDim.x * 8;
    const bf16_t* MIX = (const bf16_t*)(a->ws + WS_MIX); const float* SS = (const float*)(a->ws + WS_SS); unsigned char* H8 = a->ws + WS_H8;
    const float* og = a->in[18];
    for (int r0 = gw; r0 < MP; r0 += 4 * NGW) {
        u32x4 mv[4][4]; float sv[4];
#pragma unroll
        for (int q = 0; q < 4; ++q) { const int row = r0 + q * NGW; if (row < MP) {
            sv[q] = (lane < 24) ? SS[(size_t)row * 24 + lane] : 0.f;
            const u32x4* mr = (const u32x4*)(MIX + (size_t)row * DM);
#pragma unroll
            for (int j = 0; j < 4; ++j) mv[q][j] = mr[64u * j + lane]; } }
#pragma unroll
        for (int q = 0; q < 4; ++q) { const int row = r0 + q * NGW; if (row < MP) {
            float sa = (lane < 16) ? sv[q] : 0.f, sg = (lane >= 16) ? sv[q] : 0.f;
            sa = wave_sum(sa); sg = wave_sum(sg);
            const float ra = 1.f / sqrtf(sa * (1.f / 1024.f) + LN_EPS), rg = 1.f / sqrtf(sg * (1.f / 1024.f) + LN_EPS);
            u32x2* ho = (u32x2*)(H8 + (size_t)row * DM);
#pragma unroll
            for (int j = 0; j < 4; ++j) {
                const unsigned c = 64u * j + lane; const u32x4 m = mv[q][j]; const float r = (j < 2) ? ra : rg;
                const f32x4 g0 = *(const f32x4*)(og + 8 * c), g1 = *(const f32x4*)(og + 8 * c + 4);
                u32x2 o;
                o.x = pk4_fp8(bflo(m.x) * r * g0[0], bfhi(m.x) * r * g0[1], bflo(m.y) * r * g0[2], bfhi(m.y) * r * g0[3]);
                o.y = pk4_fp8(bflo(m.z) * r * g1[0], bfhi(m.z) * r * g1[1], bflo(m.w) * r * g1[2], bfhi(m.w) * r * g1[3]);
                ho[c] = o;
            } } }
    }
    const int w = __builtin_amdgcn_readfirstlane(tid >> 6);
    for (int t = blockIdx.x; t < NS; t += gridDim.x) {
        const int row = MP + t;
        const float sv = (lane < 24) ? SS[(size_t)row * 24 + lane] : 0.f;
        const float sa = wave_sum(lane < 16 ? sv : 0.f), sg = wave_sum(lane >= 16 ? sv : 0.f);
        const float ra = 1.f / sqrtf(sa * (1.f / 1024.f) + LN_EPS), rg = 1.f / sqrtf(sg * (1.f / 1024.f) + LN_EPS);
        if (lane < 32) {
            const unsigned c = 32u * w + lane;
            const u32x4 m = ((const u32x4*)(MIX + (size_t)row * DM))[c]; const float r = (c < 128u) ? ra : rg;
            const f32x4 g0 = *(const f32x4*)(og + 8 * c), g1 = *(const f32x4*)(og + 8 * c + 4);
            u32x2 o;
            o.x = pk4_fp8(bflo(m.x) * r * g0[0], bfhi(m.x) * r * g0[1], bflo(m.y) * r * g0[2], bfhi(m.y) * r * g0[3]);
            o.y = pk4_fp8(bflo(m.z) * r * g1[0], bfhi(m.z) * r * g1[1], bflo(m.w) * r * g1[2], bfhi(m.w) * r * g1[3]);
            ((u32x2*)(H8 + (size_t)row * DM))[c] = o;
        }
    }
}
template <bool FP8  >
__device__ __forceinline__ void small_part(LAS unsigned char* lds, int tid, const void* Av, const void* Btv, int K, float* PART) {
    const int w = __builtin_amdgcn_readfirstlane(tid >> 6), lane = tid & 63, S = K / 16;
    LAS float* part = (LAS float*)lds;
    for (int it = blockIdx.x; it < 256; it += gridDim.x) {
        const int n0 = 32 * (it & 63), kq = it >> 6, sl = kq * 8 + w;
        const int s0 = (sl * S) >> 5, s1 = ((sl + 1) * S) >> 5;
        f32x16 acc;
#pragma unroll
        for (int i = 0; i < 16; ++i) acc[i] = 0.f;
        if constexpr (FP8) {
            const unsigned char* ap = (const unsigned char*)Av + (size_t)(lane & 31) * K + 8 * (lane >> 5);
            const unsigned char* bp = (const unsigned char*)Btv + (size_t)(n0 + (lane & 31)) * K + 8 * (lane >> 5);
            long af[11], bfr[11];
#pragma unroll
            for (int i = 0; i < 11; ++i) { const int st = (s0 + i < s1) ? s0 + i : s0; af[i] = *(const long*)(ap + 16 * st); bfr[i] = *(const long*)(bp + 16 * st); }
#pragma unroll
            for (int i = 0; i < 11; ++i) if (s0 + i < s1) acc = __builtin_amdgcn_mfma_f32_32x32x16_fp8_fp8(af[i], bfr[i], acc, 0, 0, 0);
        } else {
            const bf16_t* ap = (const bf16_t*)Av + (size_t)(lane & 31) * K + 8 * (lane >> 5);
            const bf16_t* bp = (const bf16_t*)Btv + (size_t)(n0 + (lane & 31)) * K + 8 * (lane >> 5);
            bf16x8 af[11], bfr[11];
#pragma unroll
            for (int i = 0; i < 11; ++i) { const int st = (s0 + i < s1) ? s0 + i : s0; af[i] = *(const bf16x8*)(ap + 16 * st); bfr[i] = *(const bf16x8*)(bp + 16 * st); }
#pragma unroll
            for (int i = 0; i < 11; ++i) if (s0 + i < s1) acc = __builtin_amdgcn_mfma_f32_32x32x16_bf16(af[i], bfr[i], acc, 0, 0, 0);
        }
#pragma unroll
        for (int rg = 0; rg < 16; ++rg) { const int i = 8 * (rg >> 2) + 4 * (lane >> 5) + (rg & 3); part[w * 1024 + i * 32 + (lane & 31)] = acc[rg]; }
        __syncthreads();
        for (int e = tid; e < 1024; e += 512) {
            const int t = e >> 5, n = e & 31; float sm = 0.f;
#pragma unroll
            for (int ww = 0; ww < 8; ++ww) sm += part[ww * 1024 + e];
            PART[(size_t)(kq * 32 + t) * DM + n0 + n] = sm;
        }
        __syncthreads();
    }
}
struct AttnRegs { u32x4 kv[4], vv[4]; bf16x8 qf[2]; };
__device__ __forceinline__ void attn_load(KArgsPtr a, int item, int tid, AttnRegs& R) {
    const int h = item & 15, nb = (item >> 4) & 15, b = item >> 8, kvh = h >> 2;
    const bf16_t* Q = (const bf16_t*)(a->ws + WS_Q); const bf16_t* Kb = (const bf16_t*)(a->ws + WS_K); const bf16_t* Vb = (const bf16_t*)(a->ws + WS_V);
    const int w = __builtin_amdgcn_readfirstlane(tid >> 6), lane = tid & 63, fr = lane & 15, fq = lane >> 4;
    const unsigned qrow = b * SEQ + nb * 128 + 16 * w + fr;
#pragma unroll
    for (int ks = 0; ks < 2; ++ks) R.qf[ks] = *(const bf16x8*)(Q + qrow * 1024u + h * 64 + ks * 32 + 8 * fq);
    const int rowk0 = b * SEQ + (nb - 1) * 128;
#pragma unroll
    for (int i = 0; i < 4; ++i) {
        const int ch = tid + 512 * i, c = ch >> 3, part = ch & 7;
        R.kv[i] = (u32x4){0u, 0u, 0u, 0u}; R.vv[i] = (u32x4){0u, 0u, 0u, 0u};
        if (nb > 0 || c >= 128) { const unsigned off = (unsigned)(rowk0 + c) * 256u + kvh * 64 + part * 8; R.kv[i] = *(const u32x4*)(Kb + off); R.vv[i] = *(const u32x4*)(Vb + off); }
    }
}
__device__ __forceinline__ void attn_stage(LAS unsigned char* lds, int tid, const AttnRegs& R) {
    LAS bf16_t* Kl = (LAS bf16_t*)lds; LAS bf16_t* Vl = Kl + 256 * 72;
#pragma unroll
    for (int i = 0; i < 4; ++i) { const int ch = tid + 512 * i, c = ch >> 3, part = ch & 7; *(LAS u32x4*)(Kl + c * 72 + part * 8) = R.kv[i]; *(LAS u32x4*)(Vl + c * 72 + part * 8) = R.vv[i]; }
}
__device__ __forceinline__ void attn_compute(KArgsPtr a, LAS unsigned char* lds, int item, int tid, const bf16x8 (&qf)[2]) {
    const int h = item & 15, nb = (item >> 4) & 15, b = item >> 8;
    bf16_t* MIX = (bf16_t*)(a->ws + WS_MIX); float* SS = (float*)(a->ws + WS_SS);
    LAS bf16_t* Kl = (LAS bf16_t*)lds; LAS bf16_t* Vl = Kl + 256 * 72;
    const int w = __builtin_amdgcn_readfirstlane(tid >> 6), lane = tid & 63, fr = lane & 15, fq = lane >> 4;
    const size_t qrow = (size_t)b * SEQ + nb * 128 + 16 * w + fr;
    f32x4 s[9];
#pragma unroll
    for (int t = 0; t < 9; ++t) {
        s[t] = (f32x4){0.f, 0.f, 0.f, 0.f};
#pragma unroll
        for (int ks = 0; ks < 2; ++ks) { const bf16x8 kf = *(const LAS bf16x8*)(Kl + (16 * (w + t) + fr) * 72 + ks * 32 + 8 * fq); s[t] = MFMA16(kf, qf[ks], s[t]); }
    }
    const float sink = a->in[13][h];
    float mx = sink;
#pragma unroll
    for (int t = 0; t < 9; ++t)
#pragma unroll
        for (int rg = 0; rg < 4; ++rg) {
            bool valid = (nb > 0) || (w + t >= 8);
            if (t == 0) valid = valid && (4 * fq + rg > fr);
            if (t == 8) valid = valid && (4 * fq + rg <= fr);
            const float v = valid ? s[t][rg] : -INFINITY; s[t][rg] = v; mx = fmaxf(mx, v);
        }
    mx = fmaxf(mx, __shfl_xor(mx, 16)); mx = fmaxf(mx, __shfl_xor(mx, 32));
    float sum = 0.f;
#pragma unroll
    for (int t = 0; t < 9; ++t)
#pragma unroll
        for (int rg = 0; rg < 4; ++rg) { const float p = __expf(s[t][rg] - mx); s[t][rg] = p; sum += p; }
    sum += __shfl_xor(sum, 16); sum += __shfl_xor(sum, 32);
    const float inv = 1.f / (sum + __expf(sink - mx));
    f32x4 o[4];
#pragma unroll
    for (int dt = 0; dt < 4; ++dt) o[dt] = (f32x4){0.f, 0.f, 0.f, 0.f};
#pragma unroll
    for (int st = 0; st < 5; ++st) {
        u32x4 pw; pw.x = pk2(s[2 * st][0], s[2 * st][1]); pw.y = pk2(s[2 * st][2], s[2 * st][3]);
        if (st < 4) { pw.z = pk2(s[2 * st + 1][0], s[2 * st + 1][1]); pw.w = pk2(s[2 * st + 1][2], s[2 * st + 1][3]); } else { pw.z = 0u; pw.w = 0u; }
        const bf16x8 pf = __builtin_bit_cast(bf16x8, pw);
        const int ca = 16 * (w + 2 * st) + 4 * fq, cb = ca + 16;
#pragma unroll
        for (int dt = 0; dt < 4; ++dt) {
            const LAS bf16_t* vp = Vl + 16 * dt + fr;
            u32x4 vw;
            vw.x = (unsigned)vp[(ca + 0) * 72] | ((unsigned)vp[(ca + 1) * 72] << 16); vw.y = (unsigned)vp[(ca + 2) * 72] | ((unsigned)vp[(ca + 3) * 72] << 16);
            if (st < 4) { vw.z = (unsigned)vp[(cb + 0) * 72] | ((unsigned)vp[(cb + 1) * 72] << 16); vw.w = (unsigned)vp[(cb + 2) * 72] | ((unsigned)vp[(cb + 3) * 72] << 16); } else { vw.z = 0u; vw.w = 0u; }
            o[dt] = MFMA16(__builtin_bit_cast(bf16x8, vw), pf, o[dt]);
        }
    }
    float ssq = 0.f;
#pragma unroll
    for (int dt = 0; dt < 4; ++dt) {
        const f32x4 v = o[dt] * inv; ssq += (v[0] * v[0] + v[1] * v[1]) + (v[2] * v[2] + v[3] * v[3]);
        const f32x4 vg = v * *(const f32x4*)(a->in[18] + h * 64 + 16 * dt + 4 * fq) * MIX_SCALE;
        *(unsigned*)(a->ws + WS_H8 + qrow * DM + h * 64 + 16 * dt + 4 * fq) = pk4_fp8(vg[0], vg[1], vg[2], vg[3]);
    }
    ssq += __shfl_xor(ssq, 16); ssq += __shfl_xor(ssq, 32);
    if (fq == 0) SS[qrow * 24 + h] = ssq;
}
__device__ __forceinline__ void gmlp_item(KArgsPtr a, LAS unsigned char* lds, int item, int tid) {
    const int g = item & 7, ch = (item >> 3) & 15, b = item >> 7; const size_t r0 = (size_t)b * SEQ + ch * 128;
    const bf16_t* GV = (const bf16_t*)(a->ws + WS_GV); const bf16_t* U = (const bf16_t*)(a->ws + WS_U);
    bf16_t* MIX = (bf16_t*)(a->ws + WS_MIX); float* SS = (float*)(a->ws + WS_SS);
    LAS bf16_t* vT = (LAS bf16_t*)lds;
    const int w = __builtin_amdgcn_readfirstlane(tid >> 6), lane = tid & 63, fr = lane & 15, fq = lane >> 4;
    const int irow = 16 * w + fr;
    const int nks = (16 * w + 15) / 32 + 1;
    const float* Wrow = a->in[16] + ((size_t)g * 128 + irow) * 128;
    f32x4 wq[4][2];
#pragma unroll
    for (int ks = 0; ks < 4; ++ks) if (ks < nks) { wq[ks][0] = *(const f32x4*)(Wrow + ks * 32 + 8 * fq); wq[ks][1] = *(const f32x4*)(Wrow + ks * 32 + 8 * fq + 4); }
    const size_t row = r0 + irow;
    u32x2 uw[8];
#pragma unroll
    for (int ct = 0; ct < 8; ++ct) uw[ct] = *(const u32x2*)(U + row * 1024 + g * 128 + 16 * ct + 4 * fq);
    const float bsp = a->in[17][g * 128 + irow];
    {
        const int p = tid >> 2, qd = tid & 3;
        const u32x4* src = (const u32x4*)(GV + (r0 + p) * 1024 + g * 128 + 32 * qd);
        float x[32];
#pragma unroll
        for (int i = 0; i < 4; ++i) { const u32x4 rw = src[i];
            x[8 * i + 0] = bflo(rw.x); x[8 * i + 1] = bfhi(rw.x); x[8 * i + 2] = bflo(rw.y); x[8 * i + 3] = bfhi(rw.y);
            x[8 * i + 4] = bflo(rw.z); x[8 * i + 5] = bfhi(rw.z); x[8 * i + 6] = bflo(rw.w); x[8 * i + 7] = bfhi(rw.w); }
        float s = 0.f;
#pragma unroll
        for (int i = 0; i < 32; ++i) s += x[i];
        s += __shfl_xor(s, 1); s += __shfl_xor(s, 2);
        const float mean = s * (1.f / 128.f); float q = 0.f;
#pragma unroll
        for (int i = 0; i < 32; ++i) { x[i] -= mean; q += x[i] * x[i]; }
        q += __shfl_xor(q, 1); q += __shfl_xor(q, 2);
        const float rstd = 1.f / sqrtf(q * (1.f / 128.f) + LN_EPS);
        const float* gg = a->in[14] + g * 128 + 32 * qd; const float* gb = a->in[15] + g * 128 + 32 * qd;
#pragma unroll
        for (int i = 0; i < 32; i += 2) {
            const unsigned pr = pk2(x[i] * rstd * gg[i] + gb[i], x[i + 1] * rstd * gg[i + 1] + gb[i + 1]);
            vT[(32 * qd + i) * 136 + p] = (bf16_t)(pr & 0xffffu); vT[(32 * qd + i + 1) * 136 + p] = (bf16_t)(pr >> 16);
        }
    }
    __syncthreads();
    f32x4 acc[8];
#pragma unroll
    for (int ct = 0; ct < 8; ++ct) acc[ct] = (f32x4){0.f, 0.f, 0.f, 0.f};
#pragma unroll
    for (int ks = 0; ks < 4; ++ks) if (ks < nks) {
        const int j0 = ks * 32 + 8 * fq;
        const f32x4 w0 = wq[ks][0], w1 = wq[ks][1];
        const bf16x8 wf = pack8(j0 + 0 <= irow ? w0[0] : 0.f, j0 + 1 <= irow ? w0[1] : 0.f, j0 + 2 <= irow ? w0[2] : 0.f, j0 + 3 <= irow ? w0[3] : 0.f,
                                j0 + 4 <= irow ? w1[0] : 0.f, j0 + 5 <= irow ? w1[1] : 0.f, j0 + 6 <= irow ? w1[2] : 0.f, j0 + 7 <= irow ? w1[3] : 0.f);
#pragma unroll
        for (int ct = 0; ct < 8; ++ct) { const bf16x8 vf = *(const LAS bf16x8*)(vT + (16 * ct + fr) * 136 + ks * 32 + 8 * fq); acc[ct] = MFMA16(vf, wf, acc[ct]); }
    }
    float ssq = 0.f;
#pragma unroll
    for (int ct = 0; ct < 8; ++ct) {
        const float o0 = bflo(uw[ct].x) * (acc[ct][0] + bsp), o1 = bfhi(uw[ct].x) * (acc[ct][1] + bsp), o2 = bflo(uw[ct].y) * (acc[ct][2] + bsp), o3 = bfhi(uw[ct].y) * (acc[ct][3] + bsp);
        ssq += (o0 * o0 + o1 * o1) + (o2 * o2 + o3 * o3);
        const f32x4 og = *(const f32x4*)(a->in[18] + 1024 + g * 128 + 16 * ct + 4 * fq) * MIX_SCALE;
        *(unsigned*)(a->ws + WS_H8 + row * DM + 1024 + g * 128 + 16 * ct + 4 * fq) = pk4_fp8(o0 * og[0], o1 * og[1], o2 * og[2], o3 * og[3]);
    }
    ssq += __shfl_xor(ssq, 16); ssq += __shfl_xor(ssq, 32);
    if (fq == 0) SS[row * 24 + 16 + g] = ssq;
    __syncthreads();
}
__device__ __forceinline__ void sattn_wave(KArgsPtr a, LAS float* wl, int si, int lane) {
    const int bs = si >> 4, h = si & 15, kvh = h >> 2; const size_t row = MP + bs;
    const bf16_t* Q = (const bf16_t*)(a->ws + WS_Q); const bf16_t* Kb = (const bf16_t*)(a->ws + WS_K); const bf16_t* Vb = (const bf16_t*)(a->ws + WS_V);
    bf16_t* MIX = (bf16_t*)(a->ws + WS_MIX); float* SS = (float*)(a->ws + WS_SS);
    LAS float* ql = wl; LAS float* pl = wl + 64;
    const float qv = bf2f(Q[row * 1024 + h * 64 + lane]);
    ql[lane] = qv;
    const float dotnew = wave_sum(qv * bf2f(Kb[row * 256 + kvh * 64 + lane]));
    const float* ck = a->in[2] + (size_t)bs * 128 * 256 + kvh * 64; const float* cv = a->in[3] + (size_t)bs * 128 * 256 + kvh * 64;
    const int j0 = lane + 1, j1 = (lane + 65 < 128) ? (lane + 65) : 127;
    float s0 = 0.f, s1 = 0.f;
#pragma unroll
    for (int hf = 0; hf < 2; ++hf) {
        f32x4 k0[8], k1[8];
#pragma unroll
        for (int d4 = 0; d4 < 8; ++d4) { k0[d4] = *(const f32x4*)(ck + (size_t)j0 * 256 + 32 * hf + 4 * d4); k1[d4] = *(const f32x4*)(ck + (size_t)j1 * 256 + 32 * hf + 4 * d4); }
#pragma unroll
        for (int d4 = 0; d4 < 8; ++d4) {
            const f32x4 qq = *(const LAS f32x4*)(ql + 32 * hf + 4 * d4);
            s0 += (qq[0] * k0[d4][0] + qq[1] * k0[d4][1]) + (qq[2] * k0[d4][2] + qq[3] * k0[d4][3]);
            s1 += (qq[0] * k1[d4][0] + qq[1] * k1[d4][1]) + (qq[2] * k1[d4][2] + qq[3] * k1[d4][3]);
        }
    }
    if (lane == 63) s1 = dotnew;
    const float sink = a->in[13][h];
    const float mx = fmaxf(wave_max(fmaxf(s0, s1)), sink);
    const float p0 = __expf(s0 - mx), p1 = __expf(s1 - mx);
    const float denom = wave_sum(p0 + p1) + __expf(sink - mx);
    pl[lane] = p0; pl[lane + 64] = p1;
    float o = 0.f;
    const float vnew = bf2f(Vb[row * 256 + kvh * 64 + lane]);
    for (int jb = 0; jb < 128; jb += 32) {
        float vv[32];
#pragma unroll
        for (int u = 0; u < 32; ++u) { const int j = jb + u; vv[u] = cv[(size_t)(j < 127 ? j + 1 : 127) * 256 + lane]; }
#pragma unroll
        for (int u = 0; u < 32; ++u) { const int j = jb + u; o += pl[j] * (j < 127 ? vv[u] : vnew); }
    }
    o = o / denom;
    *(unsigned char*)(a->ws + WS_H8 + row * DM + h * 64 + lane) = (unsigned char)(pk4_fp8(o * a->in[18][h * 64 + lane] * MIX_SCALE, 0.f, 0.f, 0.f) & 0xffu);
    const float ss = wave_sum(o * o);
    if (lane == 0) SS[row * 24 + h] = ss;
}
__device__ __forceinline__ void sgmlp_wave(KArgsPtr a, int bs, int lane) {
    const size_t row = MP + bs;
    const bf16_t* GV = (const bf16_t*)(a->ws + WS_GV); const bf16_t* U = (const bf16_t*)(a->ws + WS_U);
    bf16_t* MIX = (bf16_t*)(a->ws + WS_MIX); float* SS = (float*)(a->ws + WS_SS);
    unsigned gwv[8], uwv[8]; float gn0[8], gn1[8], gb0[8], gb1[8], wsv[8], bsv[8], og0[8], og1[8];
#pragma unroll
    for (int g = 0; g < 8; ++g) {
        const int c = g * 128 + 2 * lane;
        gwv[g] = *(const unsigned*)(GV + row * 1024 + c); uwv[g] = *(const unsigned*)(U + row * 1024 + c);
        gn0[g] = a->in[14][c]; gn1[g] = a->in[14][c + 1]; gb0[g] = a->in[15][c]; gb1[g] = a->in[15][c + 1];
        wsv[g] = a->in[16][(size_t)g * 128 * 128]; bsv[g] = a->in[17][g * 128];
    }
#pragma unroll
    for (int g = 0; g < 8; ++g) {
        const int c = g * 128 + 2 * lane;
        float x0 = bflo(gwv[g]), x1 = bfhi(gwv[g]);
        const float mean = wave_sum(x0 + x1) * (1.f / 128.f); x0 -= mean; x1 -= mean;
        const float rstd = 1.f / sqrtf(wave_sum(x0 * x0 + x1 * x1) * (1.f / 128.f) + LN_EPS);
        const float v0 = x0 * rstd * gn0[g] + gb0[g], v1 = x1 * rstd * gn1[g] + gb1[g];
        a->out[OFF_GVS + (size_t)bs * 1024 + c] = v0; a->out[OFF_GVS + (size_t)bs * 1024 + c + 1] = v1;
        const float o0 = bflo(uwv[g]) * (wsv[g] * v0 + bsv[g]), o1 = bfhi(uwv[g]) * (wsv[g] * v1 + bsv[g]);
        *(unsigned short*)(a->ws + WS_H8 + row * DM + 1024 + c) = (unsigned short)(pk4_fp8(o0 * a->in[18][1024 + c] * MIX_SCALE, o1 * a->in[18][1024 + c + 1] * MIX_SCALE, 0.f, 0.f) & 0xffffu);
        const float ss = wave_sum(o0 * o0 + o1 * o1);
        if (lane == 0) SS[row * 24 + 16 + g] = ss;
    }
}
__device__ __forceinline__ void mix_phase(KArgsPtr a, LAS unsigned char* lds, int tid) {
    const int NA = 1024, NG = 512, NSA = 64, NSG = 4, NTOT = NA + NG + NSA + NSG;
    const int w = __builtin_amdgcn_readfirstlane(tid >> 6), lane = tid & 63;
    int it = blockIdx.x;
    {
        AttnRegs R, Rn;
        if (it < NA) attn_load(a, it, tid, R);
        while (it < NA) {
            attn_stage(lds, tid, R);
            __syncthreads();
            const int itn = it + gridDim.x;
            if (itn < NA) attn_load(a, itn, tid, Rn);
            attn_compute(a, lds, it, tid, R.qf);
            __syncthreads();
            R = Rn; it = itn;
        }
    }
    for (; it < NTOT; it += gridDim.x) {
        if (it < NA + NG) gmlp_item(a, lds, it - NA, tid);
        else if (it < NA + NG + NSA) sattn_wave(a, (LAS float*)(lds + w * 1024), (it - NA - NG) * 8 + w, lane);
        else sgmlp_wave(a, (it - NA - NG - NSA) * 8 + w, lane);
    }
}

#define XB_TMO      128
#define XB_XCNT(j)  (256  + 64 * (j))
#define XB_XSUB(j)  (1280 + 64 * (j))
#define XB_XGEN(j)  (2304 + 64 * (j))
#define XB_TOP      3328
#define XB_TOPGEN   3392
#define XCD_BAR_WORDS 3456
#define XB_SPIN_CAP (1u << 18)

__device__ __forceinline__ unsigned xb_ld(unsigned* p)              { return __hip_atomic_load(p, __ATOMIC_RELAXED, __HIP_MEMORY_SCOPE_AGENT); }
__device__ __forceinline__ unsigned xb_add(unsigned* p, unsigned v) { return __hip_atomic_fetch_add(p, v, __ATOMIC_RELAXED, __HIP_MEMORY_SCOPE_AGENT); }
__device__ __forceinline__ unsigned xb_xcc_id() { return (unsigned)__builtin_amdgcn_s_getreg((3 << 11) | 20) & 0xFu; }
#define XB_SPIN(cond, bar) do { unsigned _sp = 0; while (cond) { __builtin_amdgcn_s_sleep(1); \
    if ((++_sp & 255u) == 0u) { if (xb_ld(&(bar)[XB_TMO])) break; if (_sp > XB_SPIN_CAP) { atomicAdd(&(bar)[XB_TMO], 1u); break; } } } } while (0)

struct XcdBarrier {
    unsigned* bar; unsigned x;
    volatile LAS unsigned* st;
};

__device__ __forceinline__ XcdBarrier xcd_barrier_post(unsigned* bar, volatile LAS unsigned* st) {
    XcdBarrier b; b.bar = bar; b.x = xb_xcc_id(); b.st = st;
    if (threadIdx.x == 0) (void)xb_add(&bar[XB_XCNT(b.x)], 1u);
    return b;
}
__device__ __forceinline__ void xcd_barrier_complete(unsigned* bar, unsigned x, unsigned& nloc, unsigned& nx) {
    const unsigned G = gridDim.x * gridDim.y * gridDim.z;
    unsigned sum, cnt, mine, sp = 0u;
    for (;;) {
        sum = 0u; cnt = 0u; mine = 0u;
#pragma unroll
        for (unsigned j = 0; j < 16; ++j) { const unsigned c = xb_ld(&bar[XB_XCNT(j)]); sum += c; cnt += (c > 0u) ? 1u : 0u; mine = (j == x) ? c : mine; }
        if (sum == G) break;
        __builtin_amdgcn_s_sleep(1);
        if ((++sp & 255u) == 0u) { if (xb_ld(&bar[XB_TMO])) break; if (sp > XB_SPIN_CAP) { atomicAdd(&bar[XB_TMO], 1u); break; } }
    }
    nloc = mine > 0u ? mine : 1u; nx = cnt > 0u ? cnt : 1u;
}

__device__ __forceinline__ void xcd_barrier(const XcdBarrier& b) {
    asm volatile("s_waitcnt vmcnt(0)" ::: "memory");
    __syncthreads();
    if (threadIdx.x == 0) {
        unsigned* bar = b.bar;
        __builtin_amdgcn_s_waitcnt(0);
        unsigned nloc = b.st[0], nx = b.st[1];
        if (nloc == 0u) { xcd_barrier_complete(bar, b.x, nloc, nx); b.st[0] = nloc; b.st[1] = nx; }
        const unsigned old = xb_add(&bar[XB_XSUB(b.x)], 1u);
        const unsigned gen = old / nloc;
        if (old + 1u == (gen + 1u) * nloc) {
            __builtin_amdgcn_fence(__ATOMIC_RELEASE, "agent");
            asm volatile("s_waitcnt vmcnt(0)" ::: "memory");
            const unsigned og = xb_add(&bar[XB_TOP], 1u);
            const unsigned tg = og / nx;
            if (og + 1u == (tg + 1u) * nx) xb_add(&bar[XB_TOPGEN], 1u);
            else XB_SPIN(xb_ld(&bar[XB_TOPGEN]) == tg, bar);
            __builtin_amdgcn_fence(__ATOMIC_ACQUIRE, "agent");
            xb_add(&bar[XB_XGEN(b.x)], 1u);
            asm volatile("s_waitcnt vmcnt(0)" ::: "memory");
        } else {
            XB_SPIN(xb_ld(&bar[XB_XGEN(b.x)]) == gen, bar);
            __builtin_amdgcn_fence(__ATOMIC_ACQUIRE, "agent");
            asm volatile("s_waitcnt vmcnt(0)" ::: "memory");
        }
    }
    __syncthreads();
}

__device__ __forceinline__ int fresh_tid() { int t = threadIdx.x; asm volatile("" : "+v"(t)); return t; }
__device__ __forceinline__ KArgsPtr load_args() { KArgsPtr p = (KArgsPtr)__builtin_amdgcn_kernarg_segment_ptr(); asm volatile("" : "+s"(p)); return p; }
#define LA load_args()
__global__ void __launch_bounds__(512, 2) fwd(Args kernarg_only) {
    extern __shared__ __attribute__((aligned(16))) unsigned char lds_raw[];
    LAS unsigned char* lds = (LAS unsigned char*)lds_raw;
    cg::grid_group grid = cg::this_grid();
    volatile LAS unsigned* MISC = (volatile LAS unsigned*)(lds + 131072 + 320);
    if (threadIdx.x < 32) MISC[threadIdx.x] = 0u;
    __syncthreads();
    XcdBarrier xbar = xcd_barrier_post((unsigned*)(LA->ws + WS_CTL) + 4096, MISC + 8);
    if (gridDim.x == 0x7fffffffu) grid.sync();
#define GRID_SYNC() xcd_barrier(xbar)
    const int G = gridDim.x, c = blockIdx.x;
#define tid fresh_tid()
#define mod ((float*)(LA->ws + WS_MOD))
#define WUP ((bf16_t*)(LA->ws + WS_WUP))
#define WDN ((bf16_t*)(LA->ws + WS_WDN))
#define WIN ((bf16_t*)(LA->ws + WS_WIN))
#define WO ((bf16_t*)(LA->ws + WS_WO))
#define H ((bf16_t*)(LA->ws + WS_H))
#define ACT ((bf16_t*)(LA->ws + WS_ACT))
#define Y ((bf16_t*)(LA->ws + WS_Y))
#define PARTP ((float*)(LA->ws + WS_PART))
#define X1 ((bf16_t*)(LA->ws + WS_X1))

#ifndef NO_P0
    for (int rep = 0; rep <= DUP_P0; ++rep) { p0_phase(LA, lds, tid, rep); if (rep < DUP_P0) GRID_SYNC(); }
#endif
    GRID_SYNC();
#ifndef NO_ROW
    h0_phase(LA, tid);
#if DUP_ROW
    GRID_SYNC();
    h0_phase(LA, tid);
#endif
#endif
    GRID_SYNC();
#define UP_PHASE(l) { pg8::Gemm g{(const bf16_t*)(LA->ws + WS_H8), (const bf16_t*)(LA->ws + WS_WUP + (size_t)(l) * WUP_ELEMS), MPAD, NUP, DM / 2}; pg8::StaticOrder S; S.init(MPAD, NUP, G, c); EpiSwiGLU E{LA->ws + WS_ACT}; \
      pg8::gemm_phase<EpiSwiGLU, pg8::StaticOrder, true, true, true>(lds, g, S, E);       \
      { const int rem = ((MPAD / 256) * (NUP / 256)) % G; if (rem != 0 && c >= rem) tr_deferred(LA, lds, tid, 2 * I_UP + (l) * I_DN, I_DN, c - rem, G - rem); else if (rem == 0) tr_deferred(LA, lds, tid, 2 * I_UP + (l) * I_DN, I_DN, c, G); } }
#define DOWN_PHASE(l, sub, xres, XB, LNI) { pg8::Gemm g{(const bf16_t*)(LA->ws + WS_ACT), (const bf16_t*)(LA->ws + WS_WDN + (size_t)(l) * WDN8_BYTES), MP, DM, DFFP / 2}; pg8::StaticOrder S; S.init(MP, DM, G, c); \
      EpiResid<XB> E{xres, Y, mod + (sub) * 6144 + 4096, LA->in[8] + (LNI) * DM, LA->in[9] + (LNI) * DM, (const float*)(LA->ws + WS_STATS)}; \
      small_part<true>(lds, tid, LA->ws + WS_ACT + (size_t)MP * DFFP, LA->ws + WS_WDN + (size_t)(l) * WDN8_BYTES, DFFP, PARTP); \
      pg8::gemm_phase<EpiResid<XB>, pg8::StaticOrder, true, true, true>(lds, g, S, E); }
#ifndef NO_UP
    UP_PHASE(0)
#if DUP_UP
    GRID_SYNC();
    UP_PHASE(0)
#endif
#endif
    GRID_SYNC();
#ifndef NO_DN
    DOWN_PHASE(0, 0, LA->in[0], 0, 0)
#if DUP_DN
    GRID_SYNC();
    DOWN_PHASE(0, 0, LA->in[0], 0, 0)
#endif
#endif
    GRID_SYNC();
#ifndef NO_ROW
    ln_phase(LA, lds, tid, 0, false, 1);
#if DUP_ROW
    GRID_SYNC();
    ln_phase(LA, lds, tid, 0, false, 1);
#endif
#endif
    GRID_SYNC();
    { pg8::Gemm g{H, WIN, MPAD, INW, DM}; pg8::StaticOrder S; S.init(MPAD, INW, G, c);
      EpiInProj E{(bf16_t*)(LA->ws + WS_Q), (bf16_t*)(LA->ws + WS_K), (bf16_t*)(LA->ws + WS_V), (bf16_t*)(LA->ws + WS_U), (bf16_t*)(LA->ws + WS_GV), (const float*)(LA->ws + WS_ROPE), LA->out};

#ifndef NO_IN
      pg8::gemm_phase<EpiInProj, pg8::StaticOrder, true, true>(lds, g, S, E);
#endif
      { const int rem = ((MPAD / 256) * (INW / 256)) % G; const int bi_ = rem != 0 ? c - rem : c, nb_ = rem != 0 ? G - rem : G;
        if (rem == 0 || c >= rem) { tr_deferred(LA, lds, tid, 2 * I_UP + 2 * I_DN + I_IN, I_WO, bi_, nb_); tr_deferred(LA, lds, tid, 2 * I_UP - N_UP1_DEF, N_UP1_DEF, bi_, nb_); } }
    }
    GRID_SYNC();
#ifndef NO_MIX
    mix_phase(LA, lds, tid);
#if DUP_MIX
    GRID_SYNC();
    mix_phase(LA, lds, tid);
#endif
#endif
    GRID_SYNC();
#ifndef NO_WO
    { pg8::Gemm g{(const bf16_t*)(LA->ws + WS_H8), (const bf16_t*)(LA->ws + WS_WO), MP, DM, DM / 2}; pg8::StaticOrder S; S.init(MP, DM, G, c);
      LAS float* rs = (LAS float*)(lds + 131072 + 1024);
      rs_table(LA, rs, S, tid);
      EpiResidMix E{Y, mod + 1 * 6144 + 4096, rs, LA->in[8], LA->in[9], (const float*)(LA->ws + WS_STATS)};
      small_part<true>(lds, tid, LA->ws + WS_H8 + (size_t)MP * DM, LA->ws + WS_WO, DM, PARTP);
      pg8::gemm_phase<EpiResidMix, pg8::StaticOrder, true, true, true>(lds, g, S, E); }
#endif
    GRID_SYNC();
#ifndef NO_ROW
    ln_phase(LA, lds, tid, 1, false, 2);
#endif
    GRID_SYNC();
#ifndef NO_UP
    UP_PHASE(1)
#if DUP_UP
    GRID_SYNC();
    UP_PHASE(1)
#endif
#endif
    GRID_SYNC();
#ifndef NO_DN
    DOWN_PHASE(1, 2, nullptr, 2, 1)
#if DUP_DN
    GRID_SYNC();
    DOWN_PHASE(1, 2, nullptr, 2, 1)
#endif
#endif
    GRID_SYNC();
#ifndef DUP_SYNC
#define DUP_SYNC 0
#endif
    for (int i = 0; i < DUP_SYNC; ++i) GRID_SYNC();
    ln_phase(LA, lds, tid, 2, true, 0);
#if DUP_ROW
    GRID_SYNC();
    ln_phase(LA, lds, tid, 2, true, 0);
#endif
#undef tid
#undef mod
#undef WUP
#undef WDN
#undef WIN
#undef WO
#undef H
#undef ACT
#undef Y
#undef X1
}

extern "C" void kernel_launch(void* const* d_in, const int* in_sizes, int n_in, void* d_out, int out_size, void* d_ws, size_t ws_size, hipStream_t stream) {
    static int grid = 0;
    if (grid == 0) {
        if (n_in != 20 || ws_size < WS_END) { fprintf(stderr, "kernel_launch: unexpected n_in %d / ws %zu\n", n_in, ws_size); grid = -1; return; }
        int dev = 0, cus = 0, per_cu = 0;
        if (hipGetDevice(&dev) != hipSuccess || hipDeviceGetAttribute(&cus, hipDeviceAttributeMultiprocessorCount, dev) != hipSuccess) { grid = -1; return; }
        if (hipFuncSetAttribute((const void*)fwd, hipFuncAttributeMaxDynamicSharedMemorySize, LDS_BYTES) != hipSuccess) { fprintf(stderr, "kernel_launch: hipFuncSetAttribute failed\n"); grid = -1; return; }
        if (hipOccupancyMaxActiveBlocksPerMultiprocessor(&per_cu, (const void*)fwd, 512, LDS_BYTES) != hipSuccess || per_cu < 1) { fprintf(stderr, "kernel_launch: occupancy query says %d\n", per_cu); }
        (void)hipGetLastError();
        grid = cus;
    }
    if (grid < 0) return;
    (void)hipMemsetAsync((char*)d_ws + WS_CTL, 0, 65536, stream);
    Args a{};
    for (int i = 0; i < 20; ++i) a.in[i] = (const float*)d_in[i];
    a.out = (float*)d_out; a.ws = (unsigned char*)d_ws;
    void* args[] = {&a};
    hipError_t e = hipLaunchCooperativeKernel((const void*)fwd, dim3(grid), dim3(512), args, LDS_BYTES, stream);
    if (e != hipSuccess) fprintf(stderr, "kernel_launch: cooperative launch failed: %s (grid %d)\n", hipGetErrorString(e), grid);
}
```

```cpp
#include <hip/hip_runtime.h>
#include <hip/hip_cooperative_groups.h>
#include <cstdio>
#include <cstdint>
namespace cg = cooperative_groups;
#ifndef DUP_P0
#define DUP_P0 0
#endif
#ifndef DUP_UP
#define DUP_UP 0
#endif
#ifndef DUP_DN
#define DUP_DN 0
#endif
#ifndef DUP_MIX
#define DUP_MIX 0
#endif
#ifndef DUP_IN
#define DUP_IN 0
#endif
#ifndef DUP_WO
#define DUP_WO 0
#endif
#ifndef DUP_ROW
#define DUP_ROW 0
#endif
namespace pg8 {
#define PG8_LAS __attribute__((address_space(3)))
typedef unsigned short bf16_t;
typedef short bf16x8 __attribute__((ext_vector_type(8)));
typedef float f32x4 __attribute__((ext_vector_type(4)));
typedef unsigned u32x4 __attribute__((ext_vector_type(4)));
constexpr int BM = 256, BK = 64, HALF = 128, HTB = HALF * BK * 2  , STAGE_BYTES = 8 * HTB, NXCD = 8, WGM = 8;

__host__ __device__ __forceinline__ int lds_byte(int r, int c) { const int st = (r >> 4) * 2 + (c >> 5), rr = r & 15, cc = c & 31, ob = rr * 64 + cc * 2; return st * 1024 + (ob ^ (((ob >> 9) & 1) << 5)); }
__host__ __device__ __forceinline__ void stage_rc(int b, int& R, int& C) { const int st = b / 1024, sb = b % 1024, swz = sb ^ (((sb >> 9) & 1) << 5); R = (st >> 1) * 16 + swz / 64; C = (st & 1) * 32 + (swz % 64) / 2; }
__host__ __device__ __forceinline__ int perm32(int rho) { const int n = rho >> 4, i = rho & 15; return 8 * (i >> 2) + 4 * n + (i & 3); }

struct Unit { int pm, pn; };
struct Gemm { const bf16_t* A; const bf16_t* Bt; int M, N, K; };

struct StaticOrder {
    int nM, nN, nwg, G, c;
    __host__ __device__ void init(int M, int N, int G_, int c_) { nM = M / BM; nN = N / BM; nwg = nM * nN; G = G_; c = c_; }
    __host__ __device__ bool next(int i, Unit& u) const {
        const long L = (long)i * G + c; if (L >= nwg) return false;
        int wgid = (int)L; { const int q = nwg / NXCD, r = nwg % NXCD, xcd = wgid % NXCD, off = wgid / NXCD; wgid = (xcd < r ? xcd * (q + 1) : r * (q + 1) + (xcd - r) * q) + off; }
        const int nig = WGM * nN, gid = wgid / nig, fm = gid * WGM, gsz = (nM - fm) < WGM ? (nM - fm) : WGM;
        u.pm = fm + ((wgid % nig) % gsz); u.pn = (wgid % nig) / gsz; return true;
    }
    __device__ __forceinline__ void a_ready(const Unit&) const {}
    __device__ __forceinline__ void done(const Unit&) const {}
};

__device__ __forceinline__ unsigned cvt_pk_bf16(float lo, float hi) { unsigned r; asm volatile("v_cvt_pk_bf16_f32 %0, %1, %2" : "=v"(r) : "v"(lo), "v"(hi)); return r; }
typedef int i32x4v __attribute__((ext_vector_type(4)));
typedef int i32x8v __attribute__((ext_vector_type(8)));
__device__ __forceinline__ f32x4 mma_fp8(const bf16x8 (&a)[2], const bf16x8 (&b)[2], f32x4 c) {
    const i32x8v A = __builtin_shufflevector(__builtin_bit_cast(i32x4v, a[0]), __builtin_bit_cast(i32x4v, a[1]), 0, 1, 2, 3, 4, 5, 6, 7);
    const i32x8v B = __builtin_shufflevector(__builtin_bit_cast(i32x4v, b[0]), __builtin_bit_cast(i32x4v, b[1]), 0, 1, 2, 3, 4, 5, 6, 7);
    asm volatile("v_mfma_f32_16x16x128_f8f6f4 %0, %1, %2, %0" : "+v"(c) : "v"(A), "v"(B));
    return c;
}
template <class Epi, class Sched, bool ALIGN_EPI = false, bool SP2 = false, bool FP8 = false>
__device__ __forceinline__ void gemm_phase(PG8_LAS unsigned char* lds, const Gemm g, const Sched& S, const Epi& E) {
    int tid_ = threadIdx.x; asm volatile("" : "+v"(tid_));
    const int tid = tid_, wid = __builtin_amdgcn_readfirstlane(tid >> 6), lane = tid & 63, wr = wid >> 2, wc = wid & 3, fr = lane & 15, fq = lane >> 4;
    const int K = g.K, nt = K / BK;
    unsigned voffA[2], voffB[2];
#pragma unroll
    for (int i = 0; i < 2; ++i) { int R, C; stage_rc(tid * 16 + i * 8192, R, C); const int Rb = Epi::PERM ? ((R & ~31) + perm32(R & 31)) : R;
        voffA[i] = (unsigned)(R * K + C) * 2u; voffB[i] = (unsigned)(Rb * K + C) * 2u; }
    const size_t kstep = (size_t)(BK * 2);
    const size_t hstep = (size_t)HALF * K * 2;
    const size_t tstep = 2 * hstep;
    const unsigned ldsw = (unsigned)wid * 1024u;
    const int aoff = lds_byte(wr * 64 + fr, fq * 8), boff = lds_byte(wc * 32 + fr, fq * 8);
#define PG8_SA(b, h) (((b) * 2 + (h)) * HTB)
#define PG8_SB(b, h) ((4 + (b) * 2 + (h)) * HTB)
#define PG8_STAGE(bufoff, gbase, voff) do { _Pragma("unroll") for (int _i = 0; _i < 2; ++_i) \
        __builtin_amdgcn_global_load_lds((const unsigned*)((const char*)(gbase) + (voff)[_i]), (PG8_LAS unsigned*)(lds + (bufoff) + ldsw + _i * 8192), 16, 0, 0); } while (0)
#define PG8_LDA(dst, b, h) do { _Pragma("unroll") for (int m = 0; m < 4; ++m) _Pragma("unroll") for (int k = 0; k < 2; ++k) dst[m][k] = *(const PG8_LAS bf16x8*)(lds + PG8_SA(b, h) + aoff + m * 2048 + k * 1024); } while (0)
#define PG8_LDB(dst, b, h) do { _Pragma("unroll") for (int n = 0; n < 2; ++n) _Pragma("unroll") for (int k = 0; k < 2; ++k) dst[n][k] = *(const PG8_LAS bf16x8*)(lds + PG8_SB(b, h) + boff + n * 2048 + k * 1024); } while (0)
#define PG8_MMA(ai, bj, At, Bt) do { __builtin_amdgcn_s_setprio(1); \
        if constexpr (FP8) { _Pragma("unroll") for (int m = 0; m < 4; ++m) _Pragma("unroll") for (int n = 0; n < 2; ++n) acc[ai][bj][m][n] = mma_fp8(Bt[n], At[m], acc[ai][bj][m][n]); } \
        else { _Pragma("unroll") for (int m = 0; m < 4; ++m) _Pragma("unroll") for (int n = 0; n < 2; ++n) _Pragma("unroll") for (int k = 0; k < 2; ++k) \
        acc[ai][bj][m][n] = __builtin_amdgcn_mfma_f32_16x16x32_bf16(Bt[n][k], At[m][k], acc[ai][bj][m][n], 0, 0, 0); } __builtin_amdgcn_s_setprio(0); } while (0)
#define PG8_WAIT_V(n) asm volatile("s_waitcnt vmcnt(" #n ")" ::: "memory")
#define PG8_WAIT_L(n) asm volatile("s_waitcnt lgkmcnt(" #n ")" ::: "memory")
#define PG8_BAR __builtin_amdgcn_s_barrier()
#define PG8_SCHED __builtin_amdgcn_sched_barrier(0)
    Unit cur, nxt; int ui = 0;
    if (!S.next(0, cur)) return;
    f32x4 acc[2][2][4][2];
#pragma unroll
    for (int a = 0; a < 2; ++a)
#pragma unroll
        for (int b = 0; b < 2; ++b)
#pragma unroll
            for (int m = 0; m < 4; ++m)
#pragma unroll
                for (int n = 0; n < 2; ++n) acc[a][b][m][n] = (f32x4){0.f, 0.f, 0.f, 0.f};
    bf16x8 At[4][2], B0[2][2], B1[2][2];
    const char* cA = (const char*)g.A + (size_t)cur.pm * tstep; const char* cB = (const char*)g.Bt + (size_t)cur.pn * tstep;
    S.a_ready(cur);
    if constexpr (SP2) {
        PG8_STAGE(PG8_SB(0, 0), cB, voffB); PG8_STAGE(PG8_SB(0, 1), cB + hstep, voffB); PG8_STAGE(PG8_SA(0, 0), cA, voffA); PG8_STAGE(PG8_SA(0, 1), cA + hstep, voffA);
        if (wr == 1) PG8_BAR;
        PG8_WAIT_V(2); PG8_BAR;
        PG8_STAGE(PG8_SB(1, 0), cB + kstep, voffB); PG8_STAGE(PG8_SA(1, 0), cA + kstep, voffA); PG8_STAGE(PG8_SB(1, 1), cB + hstep + kstep, voffB);
        PG8_WAIT_V(6); PG8_BAR;
    } else {
        PG8_STAGE(PG8_SB(0, 0), cB, voffB); PG8_STAGE(PG8_SA(0, 0), cA, voffA); PG8_STAGE(PG8_SB(0, 1), cB + hstep, voffB); PG8_STAGE(PG8_SA(0, 1), cA + hstep, voffA);
        if (wr == 1) PG8_BAR;
        PG8_WAIT_V(4); PG8_BAR;
        PG8_STAGE(PG8_SB(1, 0), cB + kstep, voffB); PG8_STAGE(PG8_SA(1, 0), cA + kstep, voffA); PG8_STAGE(PG8_SB(1, 1), cB + hstep + kstep, voffB);
        PG8_WAIT_V(6); PG8_BAR;
    }
    for (;;) {
        const bool has_next = S.next(ui + 1, nxt);
        const char* nA = has_next ? (const char*)g.A + (size_t)nxt.pm * tstep : cA; const char* nB = has_next ? (const char*)g.Bt + (size_t)nxt.pn * tstep : cB;
        for (int t = 0; t < nt; t += 2) {
            if constexpr (Epi::MIDK) { if (t == nt / 2) E.mid(acc, ui, wr, fr); }
            const bool last = (t == nt - 2);
            const char* a1 = cA + (size_t)(t + 1) * kstep;
            const char* a2 = last ? nA : cA + (size_t)(t + 2) * kstep; const char* b2 = last ? nB : cB + (size_t)(t + 2) * kstep;
            const char* a3 = a2 + kstep; const char* b3 = b2 + kstep;
            if (last && has_next) S.a_ready(nxt);
            if constexpr (SP2) {
            PG8_LDB(B0, 0, 0); PG8_LDB(B1, 0, 1); PG8_SCHED; PG8_LDA(At, 0, 0); PG8_STAGE(PG8_SA(1, 1), a1 + hstep, voffA);
            PG8_WAIT_V(8); PG8_WAIT_L(0); PG8_BAR; PG8_MMA(0, 0, At, B0); PG8_MMA(0, 1, At, B1); PG8_BAR; PG8_SCHED;
            PG8_LDA(At, 0, 1); PG8_STAGE(PG8_SB(0, 0), b2, voffB); PG8_STAGE(PG8_SB(0, 1), b2 + hstep, voffB); PG8_STAGE(PG8_SA(0, 0), a2, voffA);
            PG8_WAIT_V(8); PG8_WAIT_L(0); PG8_BAR; PG8_MMA(1, 0, At, B0); PG8_MMA(1, 1, At, B1); PG8_BAR; PG8_SCHED;
            PG8_LDB(B0, 1, 0); PG8_LDB(B1, 1, 1); PG8_SCHED; PG8_LDA(At, 1, 0); PG8_STAGE(PG8_SA(0, 1), a2 + hstep, voffA);
            PG8_WAIT_V(8); PG8_WAIT_L(0); PG8_BAR; PG8_MMA(0, 0, At, B0); PG8_MMA(0, 1, At, B1); PG8_BAR; PG8_SCHED;
            PG8_LDA(At, 1, 1); PG8_STAGE(PG8_SB(1, 0), b3, voffB); PG8_STAGE(PG8_SB(1, 1), b3 + hstep, voffB); PG8_STAGE(PG8_SA(1, 0), a3, voffA);
            PG8_WAIT_V(8); PG8_WAIT_L(0); PG8_BAR; PG8_MMA(1, 0, At, B0); PG8_MMA(1, 1, At, B1); PG8_BAR; PG8_SCHED;
            } else {
            PG8_LDB(B0, 0, 0); PG8_SCHED; PG8_LDA(At, 0, 0); PG8_STAGE(PG8_SA(1, 1), a1 + hstep, voffA);
            PG8_WAIT_L(8); PG8_BAR; PG8_WAIT_L(0); PG8_MMA(0, 0, At, B0); PG8_BAR; PG8_SCHED;
            PG8_LDB(B1, 0, 1); PG8_STAGE(PG8_SB(0, 0), b2, voffB);
            PG8_BAR; PG8_WAIT_L(0); PG8_MMA(0, 1, At, B1); PG8_BAR;
            PG8_LDA(At, 0, 1); PG8_STAGE(PG8_SA(0, 0), a2, voffA);
            PG8_BAR; PG8_WAIT_L(0); PG8_MMA(1, 0, At, B0); PG8_BAR; PG8_SCHED;
            PG8_STAGE(PG8_SB(0, 1), b2 + hstep, voffB);
            PG8_WAIT_V(6); PG8_BAR; PG8_MMA(1, 1, At, B1); PG8_BAR;
            PG8_LDB(B0, 1, 0); PG8_SCHED; PG8_LDA(At, 1, 0); PG8_STAGE(PG8_SA(0, 1), a2 + hstep, voffA);
            PG8_WAIT_L(8); PG8_BAR; PG8_WAIT_L(0); PG8_MMA(0, 0, At, B0); PG8_BAR; PG8_SCHED;
            PG8_LDB(B1, 1, 1); PG8_STAGE(PG8_SB(1, 0), b3, voffB);
            PG8_BAR; PG8_WAIT_L(0); PG8_MMA(0, 1, At, B1); PG8_BAR;
            PG8_LDA(At, 1, 1); PG8_STAGE(PG8_SA(1, 0), a3, voffA);
            PG8_BAR; PG8_WAIT_L(0); PG8_MMA(1, 0, At, B0); PG8_BAR; PG8_SCHED;
            PG8_STAGE(PG8_SB(1, 1), b3 + hstep, voffB);
            PG8_WAIT_V(6); PG8_BAR; PG8_MMA(1, 1, At, B1); PG8_BAR;
            }
        }
        if constexpr (FP8) asm volatile("s_nop 15\n\ts_nop 15\n\ts_nop 15\n\ts_nop 15" ::: "memory");
        if constexpr (ALIGN_EPI) { if (wr == 0) PG8_BAR; }
        if constexpr (!Epi::AFTER_DRAIN) { if constexpr (Epi::MIDK) E(acc, cur, wr, wc, fr, fq, ui); else E(acc, cur, wr, wc, fr, fq); S.done(cur); }
        if (!has_next) break;
#pragma unroll
        for (int a = 0; a < 2; ++a)
#pragma unroll
            for (int b = 0; b < 2; ++b)
#pragma unroll
                for (int m = 0; m < 4; ++m)
#pragma unroll
                    for (int n = 0; n < 2; ++n) acc[a][b][m][n] = (f32x4){0.f, 0.f, 0.f, 0.f};
        cur = nxt; cA = nA; cB = nB; ++ui;
        if constexpr (ALIGN_EPI) { if (wr == 1) PG8_BAR; }
    }
    PG8_WAIT_V(0);
    if constexpr (!ALIGN_EPI) { if (wr == 0) PG8_BAR; }
    PG8_BAR;
    if constexpr (Epi::AFTER_DRAIN) { E.fused(acc, cur, wr, wc, fr, fq, lds, wid, lane); S.done(cur); }
#undef PG8_SA
#undef PG8_SB
#undef PG8_STAGE
#undef PG8_LDA
#undef PG8_LDB
#undef PG8_MMA
#undef PG8_WAIT_V
#undef PG8_WAIT_L
#undef PG8_BAR
#undef PG8_SCHED
}
}
#define LAS __attribute__((address_space(3)))
typedef unsigned short bf16_t;
typedef short bf16x8 __attribute__((ext_vector_type(8)));
typedef float f32x4 __attribute__((ext_vector_type(4)));
typedef float f32x16 __attribute__((ext_vector_type(16)));
typedef unsigned u32x4 __attribute__((ext_vector_type(4)));
typedef unsigned u32x2 __attribute__((ext_vector_type(2)));

constexpr int DM = 2048, SEQ = 2048, MP = 8192, NS = 32, MT = MP + NS, MPAD = 8448;
constexpr int DFF = 5504, NUP = 2 * DFF, INW = 3584, NMOD = 18432, NC = 36;
constexpr int DFFP = 5632;
constexpr float W_UP_SCALE = 32.f, W_DN_SCALE = 64.f, ACT_SCALE = 4.f, W_O_SCALE = 64.f, MIX_SCALE = 4.f;
constexpr float ALPHA = 1.189207115002721f;
constexpr float LN_EPS = 1e-5f;
constexpr int LDS_BYTES = 147456;
constexpr size_t OFF_YP = 0, OFF_YS = 16777216, OFF_KWP = OFF_YS + 65536, OFF_VWP = OFF_KWP + 131072, OFF_KWS = OFF_VWP + 131072, OFF_VWS = OFF_KWS + 1048576, OFF_GVS = OFF_VWS + 1048576;
constexpr size_t MiB = 1u << 20;
constexpr size_t WS_CTL = 0, WS_MOD = 1 * MiB, WS_ROPE = 4 * MiB, WS_SS = 5 * MiB, WS_WUP = 8 * MiB, WS_WDN = 96 * MiB, WS_WIN = 140 * MiB, WS_WO = 154 * MiB,
                 WS_H = 162 * MiB, WS_ACT = 196 * MiB, WS_Y = 286 * MiB, WS_X1 = 352 * MiB, WS_Q = 418 * MiB, WS_U = 436 * MiB, WS_GV = 453 * MiB, WS_K = 470 * MiB, WS_V = 475 * MiB,
                 WS_MIX = 480 * MiB, WS_H8 = 514 * MiB, WS_END = 532 * MiB;
constexpr size_t WS_STATS = WS_SS + 917504;
constexpr size_t WS_PART = WS_Y + 40 * MiB;
constexpr size_t WUP_ELEMS = (size_t)NUP * DM, WDN_ELEMS = (size_t)DM * DFF, WDN8_BYTES = (size_t)DM * DFFP;

struct Args { const float* in[20]; float* out; unsigned char* ws; };
typedef const Args __attribute__((address_space(4)))* KArgsPtr;

__device__ __forceinline__ unsigned pk2(float lo, float hi) { return pg8::cvt_pk_bf16(lo, hi); }
__device__ __forceinline__ float bf2f(unsigned short b) { return __builtin_bit_cast(float, (unsigned)b << 16); }
__device__ __forceinline__ float bflo(unsigned w) { return __builtin_bit_cast(float, w << 16); }
__device__ __forceinline__ float bfhi(unsigned w) { return __builtin_bit_cast(float, w & 0xffff0000u); }
__device__ __forceinline__ float wave_sum(float v) {
#pragma unroll
    for (int o = 1; o < 64; o <<= 1) v += __shfl_xor(v, o);
    return v;
}
__device__ __forceinline__ float wave_max(float v) {
#pragma unroll
    for (int o = 1; o < 64; o <<= 1) v = fmaxf(v, __shfl_xor(v, o));
    return v;
}
__device__ __forceinline__ float silu_f(float g) { return g * __builtin_amdgcn_rcpf(1.f + __expf(-g)); }
__device__ __forceinline__ float gelu_f(float x) { const float t = 1.5957691216057308f * (x + 0.044715f * x * x * x); return x * __builtin_amdgcn_rcpf(1.f + __expf(-t)); }
__device__ __forceinline__ bf16x8 pack8(float a0, float a1, float a2, float a3, float a4, float a5, float a6, float a7) {
    u32x4 w; w.x = pk2(a0, a1); w.y = pk2(a2, a3); w.z = pk2(a4, a5); w.w = pk2(a6, a7); return __builtin_bit_cast(bf16x8, w);
}
__device__ __forceinline__ unsigned pk4_fp8(float a, float b, float c, float d) { return (unsigned)__builtin_amdgcn_cvt_pk_fp8_f32(c, d, __builtin_amdgcn_cvt_pk_fp8_f32(a, b, 0, false), true); }
#define MFMA16(A, B, C) __builtin_amdgcn_mfma_f32_16x16x32_bf16((A), (B), (C), 0, 0, 0)

using pg8::Unit;
struct EpiSwiGLU {
    static constexpr bool PERM = true, AFTER_DRAIN = false, MIDK = false;
    unsigned char* O;
    __device__ __forceinline__ void operator()(const f32x4 (&acc)[2][2][4][2], const Unit& u, int wr, int wc, int fr, int fq) const {
        const int row0 = u.pm * 256 + wr * 64 + fr, col0 = u.pn * 128 + wc * 32 + 8 * fq;
        constexpr float IS = 1.f / W_UP_SCALE, OS = ACT_SCALE / W_UP_SCALE;
#pragma unroll
        for (int ai = 0; ai < 2; ++ai)
#pragma unroll
            for (int m = 0; m < 4; ++m) {
                unsigned char* rowp = O + (unsigned)(row0 + ai * 128 + m * 16) * (unsigned)DFFP + (unsigned)col0;
                const f32x4 v0 = acc[ai][0][m][0] * OS, v1 = acc[ai][0][m][1] * OS, g0 = acc[ai][1][m][0] * IS, g1 = acc[ai][1][m][1] * IS;
                u32x2 w;
                w.x = pk4_fp8(silu_f(g0[0]) * v0[0], silu_f(g0[1]) * v0[1], silu_f(g0[2]) * v0[2], silu_f(g0[3]) * v0[3]);
                w.y = pk4_fp8(silu_f(g1[0]) * v1[0], silu_f(g1[1]) * v1[1], silu_f(g1[2]) * v1[2], silu_f(g1[3]) * v1[3]);
                *(u32x2*)rowp = w;
            }
    }
};
template <int XB  > struct EpiResid {
    static constexpr bool PERM = false, AFTER_DRAIN = false, MIDK = false;
    const void* xres; bf16_t* Y; const float* gate; static constexpr float coef = 0.5f / (W_DN_SCALE * ACT_SCALE);
    const float* lng; const float* lnb; const float* stats;
    __device__ __forceinline__ void operator()(const f32x4 (&acc)[2][2][4][2], const Unit& u, int wr, int wc, int fr, int fq) const {
        const int b = u.pm >> 3, col0 = u.pn * 256 + wc * 32 + 4 * fq, row0 = u.pm * 256 + wr * 64 + fr;
        f32x4 g4[2][2];
#pragma unroll
        for (int bj = 0; bj < 2; ++bj)
#pragma unroll
            for (int n = 0; n < 2; ++n) g4[bj][n] = *(const f32x4*)(gate + (size_t)b * NMOD + col0 + bj * 128 + n * 16) * coef;
        f32x4 lg[2][2], lb[2][2];
        if (XB == 2) {
#pragma unroll
            for (int bj = 0; bj < 2; ++bj)
#pragma unroll
                for (int n = 0; n < 2; ++n) { lg[bj][n] = *(const f32x4*)(lng + col0 + bj * 128 + n * 16); lb[bj][n] = *(const f32x4*)(lnb + col0 + bj * 128 + n * 16); }
        }
#pragma unroll
        for (int ai = 0; ai < 2; ++ai)
#pragma unroll
            for (int m = 0; m < 4; ++m) {
                const unsigned off = (unsigned)(row0 + ai * 128 + m * 16) * (unsigned)DM + (unsigned)col0;
                float mu = 0.f, rs_ = 1.f;
                if (XB == 2) { const unsigned r = (unsigned)(row0 + ai * 128 + m * 16); mu = stats[2 * r]; rs_ = stats[2 * r + 1]; }
#pragma unroll
                for (int bj = 0; bj < 2; ++bj)
#pragma unroll
                    for (int n = 0; n < 2; ++n) {
                        f32x4 xr;
                        if (XB == 2) { const u32x2 yw = *(const u32x2*)(Y + off + bj * 128 + n * 16); xr = ((f32x4){bflo(yw.x), bfhi(yw.x), bflo(yw.y), bfhi(yw.y)} - mu) * rs_ * lg[bj][n] + lb[bj][n]; }
                        else if (XB == 1) { const u32x2 xw = *(const u32x2*)((const bf16_t*)xres + off + bj * 128 + n * 16); xr = (f32x4){bflo(xw.x), bfhi(xw.x), bflo(xw.y), bfhi(xw.y)}; }
                        else xr = *(const f32x4*)((const float*)xres + off + bj * 128 + n * 16);
                        const f32x4 y = xr * ALPHA + g4[bj][n] * acc[ai][bj][m][n]; u32x2 wv; wv.x = pk2(y[0], y[1]); wv.y = pk2(y[2], y[3]);
                        *(u32x2*)(Y + off + bj * 128 + n * 16) = wv;
                    }
            }
    }
};
struct EpiResidMix {
    static constexpr bool PERM = false, AFTER_DRAIN = false, MIDK = true;
    bf16_t* Y; const float* gate; const LAS float* rs; const float* lng; const float* lnb; const float* stats;
    __device__ __forceinline__ void mid(f32x4 (&acc)[2][2][4][2], int ui, int wr, int fr) const {
#pragma unroll
        for (int ai = 0; ai < 2; ++ai)
#pragma unroll
            for (int m = 0; m < 4; ++m) {
                const float f = rs[((ui & 3) * 256 + ai * 128 + wr * 64 + m * 16 + fr) * 2];
#pragma unroll
                for (int bj = 0; bj < 2; ++bj)
#pragma unroll
                    for (int n = 0; n < 2; ++n) acc[ai][bj][m][n] = acc[ai][bj][m][n] * f;
            }
    }
    __device__ __forceinline__ void operator()(const f32x4 (&acc)[2][2][4][2], const Unit& u, int wr, int wc, int fr, int fq, int ui) const {
        const int b = u.pm >> 3, col0 = u.pn * 256 + wc * 32 + 4 * fq, row0 = u.pm * 256 + wr * 64 + fr;
        f32x4 g4[2][2];
#pragma unroll
        for (int bj = 0; bj < 2; ++bj)
#pragma unroll
            for (int n = 0; n < 2; ++n) g4[bj][n] = *(const f32x4*)(gate + (size_t)b * NMOD + col0 + bj * 128 + n * 16) * (1.0f / (W_O_SCALE * MIX_SCALE));
        f32x4 lg[2][2], lb[2][2];
#pragma unroll
        for (int bj = 0; bj < 2; ++bj)
#pragma unroll
            for (int n = 0; n < 2; ++n) { lg[bj][n] = *(const f32x4*)(lng + col0 + bj * 128 + n * 16); lb[bj][n] = *(const f32x4*)(lnb + col0 + bj * 128 + n * 16); }
#pragma unroll
        for (int ai = 0; ai < 2; ++ai)
#pragma unroll
            for (int m = 0; m < 4; ++m) {
                const unsigned off = (unsigned)(row0 + ai * 128 + m * 16) * (unsigned)DM + (unsigned)col0;
                const float rg = rs[((ui & 3) * 256 + ai * 128 + wr * 64 + m * 16 + fr) * 2 + 1];
                const unsigned rr = (unsigned)(row0 + ai * 128 + m * 16); const float mu = stats[2 * rr], rs_ = stats[2 * rr + 1];
#pragma unroll
                for (int bj = 0; bj < 2; ++bj)
#pragma unroll
                    for (int n = 0; n < 2; ++n) {
                        const u32x2 yw = *(const u32x2*)(Y + off + bj * 128 + n * 16);
                        const f32x4 xr = ((f32x4){bflo(yw.x), bfhi(yw.x), bflo(yw.y), bfhi(yw.y)} - mu) * rs_ * lg[bj][n] + lb[bj][n];
                        const f32x4 y = xr * ALPHA + g4[bj][n] * (acc[ai][bj][m][n] * rg); u32x2 wv; wv.x = pk2(y[0], y[1]); wv.y = pk2(y[2], y[3]);
                        *(u32x2*)(Y + off + bj * 128 + n * 16) = wv;
                    }
            }
    }
};
__device__ __forceinline__ void rs_table(KArgsPtr a, LAS float* rs, const pg8::StaticOrder& S, int tid) {
    const float* SS = (const float*)(a->ws + WS_SS);
    const int rl = tid >> 1, hf = tid & 1;
    Unit u;
    for (int i = 0; i < 4 && S.next(i, u); ++i) {
        const f32x4* sp = (const f32x4*)(SS + (size_t)(u.pm * 256 + rl) * 24);
        float sum;
        if (hf == 0) { const f32x4 a0 = sp[0], a1 = sp[1], a2 = sp[2], a3 = sp[3]; sum = ((a0[0] + a0[1]) + (a0[2] + a0[3])) + ((a1[0] + a1[1]) + (a1[2] + a1[3])) + ((a2[0] + a2[1]) + (a2[2] + a2[3])) + ((a3[0] + a3[1]) + (a3[2] + a3[3])); }
        else { const f32x4 b0 = sp[4], b1 = sp[5]; sum = ((b0[0] + b0[1]) + (b0[2] + b0[3])) + ((b1[0] + b1[1]) + (b1[2] + b1[3])); }
        const float r = 1.f / sqrtf(sum * (1.f / 1024.f) + LN_EPS);
        const float other = __shfl_xor(r, 1);
        if (hf == 0) { rs[(i * 256 + rl) * 2] = r / other; rs[(i * 256 + rl) * 2 + 1] = other; }
    }
    __syncthreads();
}
struct EpiInProj {
    static constexpr bool PERM = false, AFTER_DRAIN = false, MIDK = false;
    bf16_t *Q, *Kb, *Vb, *U, *GV; const float* rope; float* out;
    __device__ __forceinline__ void operator()(const f32x4 (&acc)[2][2][4][2], const Unit& u, int wr, int wc, int fr, int fq) const {
        const int pn = u.pn, pm = u.pm; const bool samp = (pm == 32);
        const unsigned cl = wc * 32 + 4 * fq;
        if (pn < 6) {
            bf16_t* dst = pn < 4 ? Q + pn * 256 : (pn == 4 ? Kb : Vb);
            const unsigned ld = pn < 4 ? 1024u : 256u;
            const float qs = pn < 4 ? 0.125f : 1.f;
            const bool rot = (pn != 5) && ((wc & 1) == 0);
            float* wout = out + (samp ? (pn == 4 ? OFF_KWS : OFF_VWS) : (pn == 4 ? OFF_KWP : OFF_VWP));
#pragma unroll
            for (int ai = 0; ai < 2; ++ai)
#pragma unroll
                for (int m = 0; m < 4; ++m) {
                    const unsigned rowl = ai * 128 + wr * 64 + m * 16 + fr, row = pm * 256 + rowl;
                    f32x4 cs = {1.f, 1.f, 1.f, 1.f}, sn = {0.f, 0.f, 0.f, 0.f};
                    if (rot) { const unsigned pi = samp ? 2048u : (row & 2047u); cs = *(const f32x4*)(rope + pi * 16u + 4u * (fq & 1)); sn = *(const f32x4*)(rope + pi * 16u + 8u + 4u * (fq & 1)); }
                    const bool wwin = (pn >= 4) && (samp ? (rowl < (unsigned)NS) : ((pm & 7) == 7 && ai == 1));
                    const unsigned wrow = samp ? (rowl * 128u + 127u) : ((unsigned)(pm >> 3) * 128u + rowl - 128u);
#pragma unroll
                    for (int bj = 0; bj < 2; ++bj)
#pragma unroll
                        for (int n = 0; n < 2; ++n) {
                            f32x4 v = acc[ai][bj][m][n];
                            if (n == 0 && rot) {
                                f32x4 p; p[0] = __shfl_xor(v[0], 32); p[1] = __shfl_xor(v[1], 32); p[2] = __shfl_xor(v[2], 32); p[3] = __shfl_xor(v[3], 32);
                                v = (fq < 2) ? (v * cs - p * sn) : (v * cs + p * sn);
                            }
                            const unsigned c = bj * 128 + n * 16 + cl;
                            if (wwin) *(f32x4*)(wout + wrow * 256u + c) = v;
                            v = v * qs; u32x2 w; w.x = pk2(v[0], v[1]); w.y = pk2(v[2], v[3]);
                            *(u32x2*)(dst + row * ld + c) = w;
                        }
                    asm volatile("" ::: "memory");
                }
        } else {
            bf16_t* base = (pn < 10) ? (U + (pn - 6) * 256) : (GV + (pn - 10) * 256);
#pragma unroll
            for (int ai = 0; ai < 2; ++ai)
#pragma unroll
                for (int m = 0; m < 4; ++m) {
                    const unsigned row = pm * 256 + ai * 128 + wr * 64 + m * 16 + fr;
#pragma unroll
                    for (int bj = 0; bj < 2; ++bj)
#pragma unroll
                        for (int n = 0; n < 2; ++n) {
                            const f32x4 v = acc[ai][bj][m][n];
                            u32x2 w; w.x = pk2(gelu_f(v[0]), gelu_f(v[1])); w.y = pk2(gelu_f(v[2]), gelu_f(v[3]));
                            *(u32x2*)(base + row * 1024u + bj * 128 + n * 16 + cl) = w;
                        }
                    asm volatile("" ::: "memory");
                }
        }
    }
};

__device__ __forceinline__ void ada_item(KArgsPtr a, LAS unsigned char* lds, int it, int tid) {
    const int w = __builtin_amdgcn_readfirstlane(tid >> 6), lane = tid & 63, fr = lane & 15, fq = lane >> 4;
    const int g = w & 1, kq = w >> 1;
    const float* W = a->in[6]; const int c0 = it * 128;
    f32x4 acc[4][3];
#pragma unroll
    for (int nt = 0; nt < 4; ++nt)
#pragma unroll
        for (int mt = 0; mt < 3; ++mt) acc[nt][mt] = (f32x4){0.f, 0.f, 0.f, 0.f};
    for (int i4 = 0; i4 < 4; ++i4) {
        const int kb = 512 * kq + 128 * i4 + 8 * fq;
        f32x4 wv[4][8];
#pragma unroll
        for (int sx = 0; sx < 4; ++sx)
#pragma unroll
            for (int e = 0; e < 8; ++e) wv[sx][e] = __builtin_nontemporal_load((const f32x4*)(W + (size_t)(kb + 32 * sx + e) * NMOD + c0 + 64 * g + 4 * fr));
#pragma unroll
        for (int sx = 0; sx < 4; ++sx) {
            const int k0 = kb + 32 * sx;
            bf16x8 sc[3];
#pragma unroll
            for (int mt = 0; mt < 3; ++mt) {
                const int r = 16 * mt + fr;
                if (r < NC) {
                    const float* cp = (r < 4 ? a->in[4] + (size_t)r * DM : a->in[5] + (size_t)(r - 4) * DM) + k0;
                    const f32x4 x0 = *(const f32x4*)cp, x1 = *(const f32x4*)(cp + 4);
                    sc[mt] = pack8(silu_f(x0[0]), silu_f(x0[1]), silu_f(x0[2]), silu_f(x0[3]), silu_f(x1[0]), silu_f(x1[1]), silu_f(x1[2]), silu_f(x1[3]));
                } else sc[mt] = (bf16x8){0, 0, 0, 0, 0, 0, 0, 0};
            }
#pragma unroll
            for (int nt = 0; nt < 4; ++nt) {
                const bf16x8 wf = pack8(wv[sx][0][nt], wv[sx][1][nt], wv[sx][2][nt], wv[sx][3][nt], wv[sx][4][nt], wv[sx][5][nt], wv[sx][6][nt], wv[sx][7][nt]);
#pragma unroll
                for (int mt = 0; mt < 3; ++mt) acc[nt][mt] = MFMA16(wf, sc[mt], acc[nt][mt]);
            }
        }
    }
    LAS float* red = (LAS float*)(lds + 69632);
    for (int ww = 0; ww < 8; ++ww) {
        if (w == ww) {
#pragma unroll
            for (int nt = 0; nt < 4; ++nt)
#pragma unroll
                for (int mt = 0; mt < 3; ++mt)
#pragma unroll
                    for (int rg = 0; rg < 4; ++rg) {
                        const int idx = (16 * mt + fr) * 132 + 64 * g + 16 * fq + 4 * rg + nt;
                        if (kq == 0) red[idx] = acc[nt][mt][rg]; else red[idx] += acc[nt][mt][rg];
                    }
        }
        __syncthreads();
    }
    float* mod = (float*)(a->ws + WS_MOD);
    for (int e = tid; e < NC * 128; e += 512) { const int r = e >> 7, c = e & 127; mod[(size_t)r * NMOD + c0 + c] = red[r * 132 + c] + a->in[7][c0 + c]; }
    __syncthreads();
}
constexpr int I_UP = (DM / 64) * (NUP / 32), I_DN = (DFF / 64) * (DM / 32), I_IN = (DM / 64) * (INW / 32), I_WO = (DM / 64) * (DM / 32);
constexpr int N_TR = 2 * I_UP + 2 * I_DN + I_IN + I_WO;
constexpr int N_UP1_DEF = 4096;
constexpr int N_TR_P0 = 2 * I_UP - N_UP1_DEF + I_IN;
constexpr int N_TR_TAIL = 2048;
struct TrItem { const float* src; unsigned char* dst; int N, rowb; float scale; };
__device__ __forceinline__ void tr_decode(KArgsPtr a, int it, int lane, TrItem& d) {
    const float* W; unsigned char* WT; int N, kind = 0, r = it, rowb, esz; float scale = 0.f;
    if (r < 2 * I_UP) { const int l = r >= I_UP ? 1 : 0; r -= l * I_UP; W = a->in[10] + (size_t)l * WUP_ELEMS; WT = a->ws + WS_WUP + (size_t)l * WUP_ELEMS; rowb = DM; esz = 1; N = NUP; kind = 1; scale = W_UP_SCALE; }
    else if ((r -= 2 * I_UP) < 2 * I_DN) { const int l = r >= I_DN ? 1 : 0; r -= l * I_DN; W = a->in[11] + (size_t)l * WDN_ELEMS; WT = a->ws + WS_WDN + (size_t)l * WDN8_BYTES; rowb = DFFP; esz = 1; N = DM; scale = W_DN_SCALE; }
    else if ((r -= 2 * I_DN) < I_IN) { W = a->in[12]; WT = a->ws + WS_WIN; rowb = 2 * DM; esz = 2; N = INW; }
    else { r -= I_IN; W = a->in[19]; WT = a->ws + WS_WO; rowb = DM; esz = 1; N = DM; scale = W_O_SCALE; }
    const int nblk = N / 32, kb = r / nblk, nb = r - kb * nblk, k0 = 64 * kb, n0 = 32 * nb;
    int d0 = n0;
    if (kind) { const int bj = n0 >= DFF ? 1 : 0, q = n0 - bj * DFF; d0 = 256 * (q >> 7) + 128 * bj + (q & 127); }
    d.src = W + (size_t)(k0 + (lane >> 5)) * N + n0 + (lane & 31);
    d.dst = WT + (size_t)(d0 + (lane >> 3)) * rowb + (size_t)(k0 + 8 * (lane & 7)) * esz;
    d.N = N; d.rowb = rowb; d.scale = scale;
}
__device__ __forceinline__ void tr_load(const TrItem& d, float (&v)[32]) {
#pragma unroll
    for (int i = 0; i < 32; ++i) v[i] = __builtin_nontemporal_load(d.src + (size_t)(2 * i) * d.N);
}
__device__ __forceinline__ void tr_store(const TrItem& d, const float (&v)[32], LAS float* scr, int lane) {
#pragma unroll
    for (int i = 0; i < 32; ++i) scr[(2 * i + (lane >> 5)) * 33 + (lane & 31)] = v[i];
    asm volatile("s_waitcnt lgkmcnt(0)" ::: "memory");
    const int c = lane & 7;
    if (d.scale == 0.f) {
#pragma unroll
        for (int j = 0; j < 4; ++j) { const LAS float* sp = scr + (8 * c) * 33 + (lane >> 3) + 8 * j;
            u32x4 o; o.x = pk2(sp[0 * 33], sp[1 * 33]); o.y = pk2(sp[2 * 33], sp[3 * 33]); o.z = pk2(sp[4 * 33], sp[5 * 33]); o.w = pk2(sp[6 * 33], sp[7 * 33]);
            *(u32x4*)(d.dst + (size_t)(8 * j) * d.rowb) = o; }
    } else {
        const float sc = d.scale;
#pragma unroll
        for (int j = 0; j < 4; ++j) { const LAS float* sp = scr + (8 * c) * 33 + (lane >> 3) + 8 * j;
            u32x2 o; o.x = pk4_fp8(sp[0 * 33] * sc, sp[1 * 33] * sc, sp[2 * 33] * sc, sp[3 * 33] * sc); o.y = pk4_fp8(sp[4 * 33] * sc, sp[5 * 33] * sc, sp[6 * 33] * sc, sp[7 * 33] * sc);
            *(u32x2*)(d.dst + (size_t)(8 * j) * d.rowb) = o; }
    }
    asm volatile("s_waitcnt lgkmcnt(0)" ::: "memory");
}
__device__ __forceinline__ void p0_phase(KArgsPtr a, LAS unsigned char* lds, int tid, int rep) {
    const int w = __builtin_amdgcn_readfirstlane(tid >> 6), lane = tid & 63, G = gridDim.x;
    const int NADA = NMOD / 128;
#ifndef DUP_ADA
#define DUP_ADA 0
#endif
    if ((int)blockIdx.x < NADA) { for (int rr = 0; rr <= DUP_ADA; ++rr) for (int it = blockIdx.x; it < NADA; it += G) ada_item(a, lds, it, tid); }
    if ((int)blockIdx.x >= NADA || G <= NADA) {
        const int nb = (G > NADA) ? (G - NADA) : G, bi = (G > NADA) ? ((int)blockIdx.x - NADA) : (int)blockIdx.x;
        float* rope = (float*)(a->ws + WS_ROPE);
        for (int e = bi * 512 + tid; e < 2049 * 8; e += nb * 512) {
            const int pi = e >> 3, i = e & 7;
            const float pos = (pi == 2048) ? 16384.f : (float)pi;
            const float inv = (float)exp2(-(double)i * 0.125 * 18.931568569324174);
            const float angf = pos * inv;
            double ang = (double)angf;
            const double k = rint(ang * 0.15915494309189535);
            double r = fma(-k, 6.283185307179586, ang); r = fma(-k, 2.4492935982947064e-16, r);
            const double r2 = r * r;
            double s = -1.0 / 51090942171709440000.0;
            s = s * r2 + 1.0 / 121645100408832000.0; s = s * r2 - 1.0 / 355687428096000.0; s = s * r2 + 1.0 / 1307674368000.0; s = s * r2 - 1.0 / 6227020800.0;
            s = s * r2 + 1.0 / 39916800.0; s = s * r2 - 1.0 / 362880.0; s = s * r2 + 1.0 / 5040.0; s = s * r2 - 1.0 / 120.0; s = s * r2 + 1.0 / 6.0; s = -s * r2 + 1.0; s = s * r;
            double c = 1.0 / 2432902008176640000.0;
            c = c * r2 - 1.0 / 6402373705728000.0; c = c * r2 + 1.0 / 20922789888000.0; c = c * r2 - 1.0 / 87178291200.0; c = c * r2 + 1.0 / 479001600.0;
            c = c * r2 - 1.0 / 3628800.0; c = c * r2 + 1.0 / 40320.0; c = c * r2 - 1.0 / 720.0; c = c * r2 + 1.0 / 24.0; c = c * r2 - 0.5; c = c * r2 + 1.0;
            rope[pi * 16 + i] = (float)c; rope[pi * 16 + 8 + i] = (float)s;
        }
        for (int e = bi * 512 + tid; e < (2 * DM + MPAD) * 8; e += nb * 512) {
            const int rw = e >> 3, q = e & 7;
            unsigned char* base = rw < 2 * DM ? a->ws + WS_WDN + (size_t)rw * DFFP : a->ws + WS_ACT + (size_t)(rw - 2 * DM) * DFFP;
            *(u32x4*)(base + DFF + 16 * q) = (u32x4){0u, 0u, 0u, 0u};
        }
        for (int e = bi * 512 + tid; e < 2 * NS * 127 * 64; e += nb * 512) {
            const int t = e / (NS * 127 * 64), r = e % (NS * 127 * 64), b = r / (127 * 64), q = r % (127 * 64);
            const f32x4 v = *((const f32x4*)(a->in[2 + t] + (size_t)b * 128 * 256 + 256) + q);
            *((f32x4*)(a->out + (t ? OFF_VWS : OFF_KWS) + (size_t)b * 128 * 256) + q) = v;
        }
    }
    {
        const int gw = blockIdx.x * 8 + w, NGW = G * 8;
        LAS float* scr = (LAS float*)(lds + w * 8448);
        const bool has_tail = (G > NADA) && ((int)blockIdx.x >= NADA);
        const int n_main = (G > NADA) ? (N_TR_P0 - N_TR_TAIL) : N_TR_P0;
        const int nm_w = (gw < n_main) ? (n_main - gw + NGW - 1) / NGW : 0;
        const int tw = ((int)blockIdx.x - NADA) * 8 + w, TNW = (G - NADA) * 8;
        const int nt_w = (has_tail && tw < N_TR_TAIL) ? (N_TR_TAIL - tw + TNW - 1) / TNW : 0;
        const int n_w = nm_w + nt_w;
        for (int k = 0; k < n_w; k += 4) {
            TrItem d[4]; float v[4][32];
#pragma unroll
            for (int q = 0; q < 4; ++q) if (k + q < n_w) { const int kk = k + q; int it = kk < nm_w ? gw + kk * NGW : n_main + tw + (kk - nm_w) * TNW; if (it >= 2 * I_UP - N_UP1_DEF) it += 2 * I_DN + N_UP1_DEF;     tr_decode(a, it, lane, d[q]); tr_load(d[q], v[q]); }
#pragma unroll
            for (int q = 0; q < 4; ++q) if (k + q < n_w) tr_store(d[q], v[q], scr, lane);
        }
    }
}
__device__ __forceinline__ void tr_deferred(KArgsPtr a, LAS unsigned char* lds, int tid, int first, int count, int bi, int nblk) {
    const int w = __builtin_amdgcn_readfirstlane(tid >> 6), lane = tid & 63;
    LAS float* scr = (LAS float*)(lds + w * 8448);
    const int tw = bi * 8 + w, TNW = nblk * 8;
    const int n_w = (tw < count) ? (count - tw + TNW - 1) / TNW : 0;
    for (int k = 0; k < n_w; k += 4) {
        TrItem d[4]; float v[4][32];
#pragma unroll
        for (int q = 0; q < 4; ++q) if (k + q < n_w) { tr_decode(a, first + tw + (k + q) * TNW, lane, d[q]); tr_load(d[q], v[q]); }
#pragma unroll
        for (int q = 0; q < 4; ++q) if (k + q < n_w) tr_store(d[q], v[q], scr, lane);
    }
}
__device__ __forceinline__ const float* mod_row(KArgsPtr a, int row, int sub) {
    const int b = row < MP ? (row >> 11) : (4 + row - MP);
    return (const float*)(a->ws + WS_MOD) + (size_t)b * NMOD + sub * 6144;
}
__device__ __forceinline__ void h0_phase(KArgsPtr a, int tid) {
    const unsigned lane = tid & 63; const int gw = blockIdx.x * 8 + __builtin_amdgcn_readfirstlane(tid >> 6), NGW = gridDim.x * 8;
    unsigned char* H8 = a->ws + WS_H8;
    for (int r0 = 4 * gw; r0 < MP; r0 += 4 * NGW) {
        const f32x4* sh = (const f32x4*)mod_row(a, r0, 0); const f32x4* scl = sh + 512;
        f32x4 ps[8], ph[8];
#pragma unroll
        for (int j = 0; j < 8; ++j) { const unsigned c = 64u * j + lane; ps[j] = scl[c] + 1.f; ph[j] = sh[c]; }
#pragma unroll
        for (int q0 = 0; q0 < 4; q0 += 2) {
            f32x4 xv[2][8];
#pragma unroll
            for (int q = 0; q < 2; ++q) { const f32x4* xr = (const f32x4*)(a->in[0] + (size_t)(r0 + q0 + q) * DM);
#pragma unroll
                for (int j = 0; j < 8; ++j) xv[q][j] = __builtin_nontemporal_load(xr + (64u * j + lane)); }
#pragma unroll
            for (int q = 0; q < 2; ++q) { unsigned* o = (unsigned*)(H8 + (size_t)(r0 + q0 + q) * DM);
#pragma unroll
                for (int j = 0; j < 8; ++j) { const f32x4 h = xv[q][j] * ps[j] + ph[j]; o[64u * j + lane] = pk4_fp8(h[0], h[1], h[2], h[3]); } }
        }
    }
    const int w = __builtin_amdgcn_readfirstlane(tid >> 6);
    for (int t = blockIdx.x; t < NS; t += gridDim.x) {
        const int row = MP + t; const unsigned c = 64u * w + lane;
        const f32x4 x = ((const f32x4*)(a->in[1] + (size_t)t * DM))[c];
        const f32x4* sh = (const f32x4*)mod_row(a, row, 0); const f32x4* scl = sh + 512;
        const f32x4 h = x * (scl[c] + 1.f) + sh[c];
        ((unsigned*)(H8 + (size_t)row * DM))[c] = pk4_fp8(h[0], h[1], h[2], h[3]);
    }
}
__device__ __forceinline__ void ln_finish(KArgsPtr a, f32x4 (&v)[8], int row, unsigned lane, int li, bool final_out, int next_sub) {
    const f32x4* g4 = (const f32x4*)(a->in[8] + li * DM); const f32x4* b4 = (const f32x4*)(a->in[9] + li * DM);
    bf16_t* X1 = (bf16_t*)(a->ws + WS_X1); bf16_t* H = (bf16_t*)(a->ws + WS_H);
    float s = 0.f;
#pragma unroll
    for (int j = 0; j < 8; ++j) s += (v[j][0] + v[j][1]) + (v[j][2] + v[j][3]);
    const float mean = wave_sum(s) * (1.f / DM); float q = 0.f;
#pragma unroll
    for (int j = 0; j < 8; ++j) { v[j] = v[j] - mean; q += (v[j][0] * v[j][0] + v[j][1] * v[j][1]) + (v[j][2] * v[j][2] + v[j][3] * v[j][3]); }
    const float rstd = 1.f / sqrtf(wave_sum(q) * (1.f / DM) + LN_EPS);
    f32x4* xo = (f32x4*)(row < MP ? a->out + OFF_YP + (size_t)row * DM : a->out + OFF_YS + (size_t)(row - MP) * DM);
    if (!final_out && lane == 0) { float* st = (float*)(a->ws + WS_STATS) + 2 * (size_t)row; st[0] = mean; st[1] = rstd; }
    const f32x4* sh = (const f32x4*)mod_row(a, row, final_out ? 0 : next_sub); const f32x4* scl = sh + 512;
    u32x2* ho = (u32x2*)(H + (size_t)row * DM); unsigned* ho8 = (unsigned*)(a->ws + WS_H8 + (size_t)row * DM);
#pragma unroll
    for (int j = 0; j < 8; ++j) {
        const unsigned c = 64u * j + lane; const f32x4 x = v[j] * rstd * g4[c] + b4[c]; if (final_out) xo[c] = x;
        if (!final_out) { const f32x4 h = x * (scl[c] + 1.f) + sh[c];
            if (next_sub == 2) ho8[c] = pk4_fp8(h[0], h[1], h[2], h[3]);
            else { u32x2 wv; wv.x = pk2(h[0], h[1]); wv.y = pk2(h[2], h[3]); ho[c] = wv; } }
        if (j & 1) asm volatile("" ::: "memory");
    }
}
__device__ __forceinline__ void ln_phase(KArgsPtr a, LAS unsigned char* lds, int tid, int li, bool final_out, int next_sub) {
    const unsigned lane = tid & 63; const int gw = blockIdx.x * 8 + __builtin_amdgcn_readfirstlane(tid >> 6), NGW = gridDim.x * 8;
    const bf16_t* Y = (const bf16_t*)(a->ws + WS_Y); const bf16_t* X1 = (const bf16_t*)(a->ws + WS_X1);
    for (int r0 = 4 * gw; r0 < MP; r0 += 4 * NGW) {
        const f32x4* g4 = (const f32x4*)(a->in[8] + li * DM); const f32x4* b4 = (const f32x4*)(a->in[9] + li * DM);
        const f32x4* sh = (const f32x4*)mod_row(a, r0, final_out ? 0 : next_sub); const f32x4* scl = sh + 512;
        f32x4 pg[8], pb[8], ps[8], ph[8];
#pragma unroll
        for (int j = 0; j < 8; ++j) { const unsigned c = 64u * j + lane; pg[j] = g4[c]; pb[j] = b4[c];
            if (!final_out) { ps[j] = scl[c] + 1.f; ph[j] = sh[c]; pg[j] = pg[j] * ps[j]; pb[j] = pb[j] * ps[j] + ph[j]; } }
        u32x2 yw[2][8];
#pragma unroll
        for (int j = 0; j < 8; ++j) yw[0][j] = ((const u32x2*)(Y + (size_t)r0 * DM))[64u * j + lane];
#pragma unroll
        for (int q = 0; q < 4; ++q) {
            const int row = r0 + q;
            if (q < 3) {
#pragma unroll
                for (int j = 0; j < 8; ++j) yw[(q + 1) & 1][j] = ((const u32x2*)(Y + (size_t)(row + 1) * DM))[64u * j + lane];
            }
            f32x4 v[8]; float sm = 0.f;
#pragma unroll
            for (int j = 0; j < 8; ++j) { const u32x2 y2 = yw[q & 1][j]; v[j] = (f32x4){bflo(y2.x), bfhi(y2.x), bflo(y2.y), bfhi(y2.y)}; sm += (v[j][0] + v[j][1]) + (v[j][2] + v[j][3]); }
            const float mean = wave_sum(sm) * (1.f / DM); float qq = 0.f;
#pragma unroll
            for (int j = 0; j < 8; ++j) { v[j] = v[j] - mean; qq += (v[j][0] * v[j][0] + v[j][1] * v[j][1]) + (v[j][2] * v[j][2] + v[j][3] * v[j][3]); }
            const float rstd = 1.f / sqrtf(wave_sum(qq) * (1.f / DM) + LN_EPS);
            if (!final_out && lane == 0) { float* st = (float*)(a->ws + WS_STATS) + 2 * (size_t)row; st[0] = mean; st[1] = rstd; }
            f32x4* xo = (f32x4*)(a->out + OFF_YP + (size_t)row * DM);
            u32x2* ho = (u32x2*)(a->ws + WS_H + (size_t)row * DM * 2); unsigned* ho8 = (unsigned*)(a->ws + WS_H8 + (size_t)row * DM);
#pragma unroll
            for (int j = 0; j < 8; ++j) {
                const unsigned c = 64u * j + lane; const f32x4 x = v[j] * rstd * pg[j] + pb[j];
                if (final_out) xo[c] = x;
                else { const f32x4 h = x;
                    if (next_sub == 2) ho8[c] = pk4_fp8(h[0], h[1], h[2], h[3]);
                    else { u32x2 wv; wv.x = pk2(h[0], h[1]); wv.y = pk2(h[2], h[3]); ho[c] = wv; } }
            }
        }
    }
    const int w = __builtin_amdgcn_readfirstlane(tid >> 6);
    LAS float* red = (LAS float*)lds;
    for (int t = blockIdx.x; t < NS; t += gridDim.x) {
        const int row = MP + t; const float coef = (li == 1) ? 1.0f / (W_O_SCALE * MIX_SCALE) : 0.5f / (W_DN_SCALE * ACT_SCALE);
        const unsigned c = 64u * w + lane;
        float ra = 1.f, rg = 1.f;
        if (li == 1) {
            const float sv = (lane < 24) ? ((const float*)(a->ws + WS_SS))[(size_t)row * 24 + lane] : 0.f;
            const float sa = wave_sum(lane < 16 ? sv : 0.f), sg = wave_sum(lane >= 16 ? sv : 0.f);
            ra = 1.f / sqrtf(sa * (1.f / 1024.f) + LN_EPS); rg = 1.f / sqrtf(sg * (1.f / 1024.f) + LN_EPS);
        }
        const f32x4* xs = (const f32x4*)(a->in[1] + (size_t)t * DM); const u32x2* xsb = (const u32x2*)(X1 + (size_t)row * DM);
        const f32x4* gt = (const f32x4*)(mod_row(a, row, li) + 4096);
        const f32x4* pp = (const f32x4*)((const float*)(a->ws + WS_PART) + (size_t)t * DM);
        const f32x4 sm = (pp[c] + pp[c + 32 * 512]) * ra + (pp[c + 64 * 512] + pp[c + 96 * 512]) * rg;
        f32x4 xv; if (li == 0) xv = xs[c]; else { const u32x2 xw = xsb[c]; xv = (f32x4){bflo(xw.x), bfhi(xw.x), bflo(xw.y), bfhi(xw.y)}; }
        f32x4 v = xv * ALPHA + gt[c] * coef * sm;
        const float s = wave_sum((v[0] + v[1]) + (v[2] + v[3]));
        if (lane == 0) red[w] = s;
        __syncthreads();
        const float mean = (((red[0] + red[1]) + (red[2] + red[3])) + ((red[4] + red[5]) + (red[6] + red[7]))) * (1.f / DM);
        v = v - mean;
        const float q = wave_sum((v[0] * v[0] + v[1] * v[1]) + (v[2] * v[2] + v[3] * v[3]));
        if (lane == 0) red[8 + w] = q;
        __syncthreads();
        const float rstd = 1.f / sqrtf((((red[8] + red[9]) + (red[10] + red[11])) + ((red[12] + red[13]) + (red[14] + red[15]))) * (1.f / DM) + LN_EPS);
        const f32x4* g4 = (const f32x4*)(a->in[8] + li * DM); const f32x4* b4 = (const f32x4*)(a->in[9] + li * DM);
        const f32x4 x = v * rstd * g4[c] + b4[c];
        if (final_out) ((f32x4*)(a->out + OFF_YS + (size_t)t * DM))[c] = x;
        else {
            u32x2 xw; xw.x = pk2(x[0], x[1]); xw.y = pk2(x[2], x[3]); ((u32x2*)(a->ws + WS_X1 + (size_t)row * DM * 2))[c] = xw;
            const f32x4* sh = (const f32x4*)mod_row(a, row, next_sub); const f32x4* scl = sh + 512;
            const f32x4 h = x * (scl[c] + 1.f) + sh[c];
            if (next_sub == 2) ((unsigned*)(a->ws + WS_H8 + (size_t)row * DM))[c] = pk4_fp8(h[0], h[1], h[2], h[3]);
            else { u32x2 hw; hw.x = pk2(h[0], h[1]); hw.y = pk2(h[2], h[3]); ((u32x2*)(a->ws + WS_H + (size_t)row * DM * 2))[c] = hw; }
        }
        __syncthreads();
    }
}
__device__ __forceinline__ void merge_phase(KArgsPtr a, int tid) {
    const unsigned lane = tid & 63; const int gw = blockIdx.x * 8 + __builtin_amdgcn_readfirstlane(tid >> 6), NGW = gridDim.x * 8;
    const bf16_t* MIX = (const bf16_t*)(a->ws + WS_MIX); const float* SS = (const float*)(a->ws + WS_SS); unsigned char* H8 = a->ws + WS_H8;
    const float* og = a->in[18];
    for (int r0 = gw; r0 < MP; r0 += 4 * NGW) {
        u32x4 mv[4][4]; float sv[4];
#pragma unroll
        for (int q = 0; q < 4; ++q) { const int row = r0 + q * NGW; if (row < MP) {
            sv[q] = (lane < 24) ? SS[(size_t)row * 24 + lane] : 0.f;
            const u32x4* mr = (const u32x4*)(MIX + (size_t)row * DM);
#pragma unroll
            for (int j = 0; j < 4; ++j) mv[q][j] = mr[64u * j + lane]; } }
#pragma unroll
        for (int q = 0; q < 4; ++q) { const int row = r0 + q * NGW; if (row < MP) {
            float sa = (lane < 16) ? sv[q] : 0.f, sg = (lane >= 16) ? sv[q] : 0.f;
            sa = wave_sum(sa); sg = wave_sum(sg);
            const float ra = 1.f / sqrtf(sa * (1.f / 1024.f) + LN_EPS), rg = 1.f / sqrtf(sg * (1.f / 1024.f) + LN_EPS);
            u32x2* ho = (u32x2*)(H8 + (size_t)row * DM);
#pragma unroll
            for (int j = 0; j < 4; ++j) {
                const unsigned c = 64u * j + lane; const u32x4 m = mv[q][j]; const float r = (j < 2) ? ra : rg;
                const f32x4 g0 = *(const f32x4*)(og + 8 * c), g1 = *(const f32x4*)(og + 8 * c + 4);
                u32x2 o;
                o.x = pk4_fp8(bflo(m.x) * r * g0[0], bfhi(m.x) * r * g0[1], bflo(m.y) * r * g0[2], bfhi(m.y) * r * g0[3]);
                o.y = pk4_fp8(bflo(m.z) * r * g1[0], bfhi(m.z) * r * g1[1], bflo(m.w) * r * g1[2], bfhi(m.w) * r * g1[3]);
                ho[c] = o;
            } } }
    }
    const int w = __builtin_amdgcn_readfirstlane(tid >> 6);
    for (int t = blockIdx.x; t < NS; t += gridDim.x) {
        const int row = MP + t;
        const float sv = (lane < 24) ? SS[(size_t)row * 24 + lane] : 0.f;
        const float sa = wave_sum(lane < 16 ? sv : 0.f), sg = wave_sum(lane >= 16 ? sv : 0.f);
        const float ra = 1.f / sqrtf(sa * (1.f / 1024.f) + LN_EPS), rg = 1.f / sqrtf(sg * (1.f / 1024.f) + LN_EPS);
        if (lane < 32) {
            const unsigned c = 32u * w + lane;
            const u32x4 m = ((const u32x4*)(MIX + (size_t)row * DM))[c]; const float r = (c < 128u) ? ra : rg;
            const f32x4 g0 = *(const f32x4*)(og + 8 * c), g1 = *(const f32x4*)(og + 8 * c + 4);
            u32x2 o;
            o.x = pk4_fp8(bflo(m.x) * r * g0[0], bfhi(m.x) * r * g0[1], bflo(m.y) * r * g0[2], bfhi(m.y) * r * g0[3]);
            o.y = pk4_fp8(bflo(m.z) * r * g1[0], bfhi(m.z) * r * g1[1], bflo(m.w) * r * g1[2], bfhi(m.w) * r * g1[3]);
            ((u32x2*)(H8 + (size_t)row * DM))[c] = o;
        }
    }
}
template <bool FP8  >
__device__ __forceinline__ void small_part(LAS unsigned char* lds, int tid, const void* Av, const void* Btv, int K, float* PART) {
    const int w = __builtin_amdgcn_readfirstlane(tid >> 6), lane = tid & 63, S = K / 16;
    LAS float* part = (LAS float*)lds;
    for (int it = blockIdx.x; it < 256; it += gridDim.x) {
        const int n0 = 32 * (it & 63), kq = it >> 6, sl = kq * 8 + w;
        const int s0 = (sl * S) >> 5, s1 = ((sl + 1) * S) >> 5;
        f32x16 acc;
#pragma unroll
        for (int i = 0; i < 16; ++i) acc[i] = 0.f;
        if constexpr (FP8) {
            const unsigned char* ap = (const unsigned char*)Av + (size_t)(lane & 31) * K + 8 * (lane >> 5);
            const unsigned char* bp = (const unsigned char*)Btv + (size_t)(n0 + (lane & 31)) * K + 8 * (lane >> 5);
            long af[11], bfr[11];
#pragma unroll
            for (int i = 0; i < 11; ++i) { const int st = (s0 + i < s1) ? s0 + i : s0; af[i] = *(const long*)(ap + 16 * st); bfr[i] = *(const long*)(bp + 16 * st); }
#pragma unroll
            for (int i = 0; i < 11; ++i) if (s0 + i < s1) acc = __builtin_amdgcn_mfma_f32_32x32x16_fp8_fp8(af[i], bfr[i], acc, 0, 0, 0);
        } else {
            const bf16_t* ap = (const bf16_t*)Av + (size_t)(lane & 31) * K + 8 * (lane >> 5);
            const bf16_t* bp = (const bf16_t*)Btv + (size_t)(n0 + (lane & 31)) * K + 8 * (lane >> 5);
            bf16x8 af[11], bfr[11];
#pragma unroll
            for (int i = 0; i < 11; ++i) { const int st = (s0 + i < s1) ? s0 + i : s0; af[i] = *(const bf16x8*)(ap + 16 * st); bfr[i] = *(const bf16x8*)(bp + 16 * st); }
#pragma unroll
            for (int i = 0; i < 11; ++i) if (s0 + i < s1) acc = __builtin_amdgcn_mfma_f32_32x32x16_bf16(af[i], bfr[i], acc, 0, 0, 0);
        }
#pragma unroll
        for (int rg = 0; rg < 16; ++rg) { const int i = 8 * (rg >> 2) + 4 * (lane >> 5) + (rg & 3); part[w * 1024 + i * 32 + (lane & 31)] = acc[rg]; }
        __syncthreads();
        for (int e = tid; e < 1024; e += 512) {
            const int t = e >> 5, n = e & 31; float sm = 0.f;
#pragma unroll
            for (int ww = 0; ww < 8; ++ww) sm += part[ww * 1024 + e];
            PART[(size_t)(kq * 32 + t) * DM + n0 + n] = sm;
        }
        __syncthreads();
    }
}
struct AttnRegs { u32x4 kv[4], vv[4]; bf16x8 qf[2]; };
__device__ __forceinline__ void attn_load(KArgsPtr a, int item, int tid, AttnRegs& R) {
    const int h = item & 15, nb = (item >> 4) & 15, b = item >> 8, kvh = h >> 2;
    const bf16_t* Q = (const bf16_t*)(a->ws + WS_Q); const bf16_t* Kb = (const bf16_t*)(a->ws + WS_K); const bf16_t* Vb = (const bf16_t*)(a->ws + WS_V);
    const int w = __builtin_amdgcn_readfirstlane(tid >> 6), lane = tid & 63, fr = lane & 15, fq = lane >> 4;
    const unsigned qrow = b * SEQ + nb * 128 + 16 * w + fr;
#pragma unroll
    for (int ks = 0; ks < 2; ++ks) R.qf[ks] = *(const bf16x8*)(Q + qrow * 1024u + h * 64 + ks * 32 + 8 * fq);
    const int rowk0 = b * SEQ + (nb - 1) * 128;
#pragma unroll
    for (int i = 0; i < 4; ++i) {
        const int ch = tid + 512 * i, c = ch >> 3, part = ch & 7;
        R.kv[i] = (u32x4){0u, 0u, 0u, 0u}; R.vv[i] = (u32x4){0u, 0u, 0u, 0u};
        if (nb > 0 || c >= 128) { const unsigned off = (unsigned)(rowk0 + c) * 256u + kvh * 64 + part * 8; R.kv[i] = *(const u32x4*)(Kb + off); R.vv[i] = *(const u32x4*)(Vb + off); }
    }
}
__device__ __forceinline__ void attn_stage(LAS unsigned char* lds, int tid, const AttnRegs& R) {
    LAS bf16_t* Kl = (LAS bf16_t*)lds; LAS bf16_t* Vl = Kl + 256 * 72;
#pragma unroll
    for (int i = 0; i < 4; ++i) { const int ch = tid + 512 * i, c = ch >> 3, part = ch & 7; *(LAS u32x4*)(Kl + c * 72 + part * 8) = R.kv[i]; *(LAS u32x4*)(Vl + c * 72 + part * 8) = R.vv[i]; }
}
__device__ __forceinline__ void attn_compute(KArgsPtr a, LAS unsigned char* lds, int item, int tid, const bf16x8 (&qf)[2]) {
    const int h = item & 15, nb = (item >> 4) & 15, b = item >> 8;
    bf16_t* MIX = (bf16_t*)(a->ws + WS_MIX); float* SS = (float*)(a->ws + WS_SS);
    LAS bf16_t* Kl = (LAS bf16_t*)lds; LAS bf16_t* Vl = Kl + 256 * 72;
    const int w = __builtin_amdgcn_readfirstlane(tid >> 6), lane = tid & 63, fr = lane & 15, fq = lane >> 4;
    const size_t qrow = (size_t)b * SEQ + nb * 128 + 16 * w + fr;
    f32x4 s[9];
#pragma unroll
    for (int t = 0; t < 9; ++t) {
        s[t] = (f32x4){0.f, 0.f, 0.f, 0.f};
#pragma unroll
        for (int ks = 0; ks < 2; ++ks) { const bf16x8 kf = *(const LAS bf16x8*)(Kl + (16 * (w + t) + fr) * 72 + ks * 32 + 8 * fq); s[t] = MFMA16(kf, qf[ks], s[t]); }
    }
    const float sink = a->in[13][h];
    float mx = sink;
#pragma unroll
    for (int t = 0; t < 9; ++t)
#pragma unroll
        for (int rg = 0; rg < 4; ++rg) {
            bool valid = (nb > 0) || (w + t >= 8);
            if (t == 0) valid = valid && (4 * fq + rg > fr);
            if (t == 8) valid = valid && (4 * fq + rg <= fr);
            const float v = valid ? s[t][rg] : -INFINITY; s[t][rg] = v; mx = fmaxf(mx, v);
        }
    mx = fmaxf(mx, __shfl_xor(mx, 16)); mx = fmaxf(mx, __shfl_xor(mx, 32));
    float sum = 0.f;
#pragma unroll
    for (int t = 0; t < 9; ++t)
#pragma unroll
        for (int rg = 0; rg < 4; ++rg) { const float p = __expf(s[t][rg] - mx); s[t][rg] = p; sum += p; }
    sum += __shfl_xor(sum, 16); sum += __shfl_xor(sum, 32);
    const float inv = 1.f / (sum + __expf(sink - mx));
    f32x4 o[4];
#pragma unroll
    for (int dt = 0; dt < 4; ++dt) o[dt] = (f32x4){0.f, 0.f, 0.f, 0.f};
#pragma unroll
    for (int st = 0; st < 5; ++st) {
        u32x4 pw; pw.x = pk2(s[2 * st][0], s[2 * st][1]); pw.y = pk2(s[2 * st][2], s[2 * st][3]);
        if (st < 4) { pw.z = pk2(s[2 * st + 1][0], s[2 * st + 1][1]); pw.w = pk2(s[2 * st + 1][2], s[2 * st + 1][3]); } else { pw.z = 0u; pw.w = 0u; }
        const bf16x8 pf = __builtin_bit_cast(bf16x8, pw);
        const int ca = 16 * (w + 2 * st) + 4 * fq, cb = ca + 16;
#pragma unroll
        for (int dt = 0; dt < 4; ++dt) {
            const LAS bf16_t* vp = Vl + 16 * dt + fr;
            u32x4 vw;
            vw.x = (unsigned)vp[(ca + 0) * 72] | ((unsigned)vp[(ca + 1) * 72] << 16); vw.y = (unsigned)vp[(ca + 2) * 72] | ((unsigned)vp[(ca + 3) * 72] << 16);
            if (st < 4) { vw.z = (unsigned)vp[(cb + 0) * 72] | ((unsigned)vp[(cb + 1) * 72] << 16); vw.w = (unsigned)vp[(cb + 2) * 72] | ((unsigned)vp[(cb + 3) * 72] << 16); } else { vw.z = 0u; vw.w = 0u; }
            o[dt] = MFMA16(__builtin_bit_cast(bf16x8, vw), pf, o[dt]);
        }
    }
    float ssq = 0.f;
#pragma unroll
    for (int dt = 0; dt < 4; ++dt) {
        const f32x4 v = o[dt] * inv; ssq += (v[0] * v[0] + v[1] * v[1]) + (v[2] * v[2] + v[3] * v[3]);
        const f32x4 vg = v * *(const f32x4*)(a->in[18] + h * 64 + 16 * dt + 4 * fq) * MIX_SCALE;
        *(unsigned*)(a->ws + WS_H8 + qrow * DM + h * 64 + 16 * dt + 4 * fq) = pk4_fp8(vg[0], vg[1], vg[2], vg[3]);
    }
    ssq += __shfl_xor(ssq, 16); ssq += __shfl_xor(ssq, 32);
    if (fq == 0) SS[qrow * 24 + h] = ssq;
}
__device__ __forceinline__ void gmlp_item(KArgsPtr a, LAS unsigned char* lds, int item, int tid) {
    const int g = item & 7, ch = (item >> 3) & 15, b = item >> 7; const size_t r0 = (size_t)b * SEQ + ch * 128;
    const bf16_t* GV = (const bf16_t*)(a->ws + WS_GV); const bf16_t* U = (const bf16_t*)(a->ws + WS_U);
    bf16_t* MIX = (bf16_t*)(a->ws + WS_MIX); float* SS = (float*)(a->ws + WS_SS);
    LAS bf16_t* vT = (LAS bf16_t*)lds;
    const int w = __builtin_amdgcn_readfirstlane(tid >> 6), lane = tid & 63, fr = lane & 15, fq = lane >> 4;
    const int irow = 16 * w + fr;
    const int nks = (16 * w + 15) / 32 + 1;
    const float* Wrow = a->in[16] + ((size_t)g * 128 + irow) * 128;
    f32x4 wq[4][2];
#pragma unroll
    for (int ks = 0; ks < 4; ++ks) if (ks < nks) { wq[ks][0] = *(const f32x4*)(Wrow + ks * 32 + 8 * fq); wq[ks][1] = *(const f32x4*)(Wrow + ks * 32 + 8 * fq + 4); }
    const size_t row = r0 + irow;
    u32x2 uw[8];
#pragma unroll
    for (int ct = 0; ct < 8; ++ct) uw[ct] = *(const u32x2*)(U + row * 1024 + g * 128 + 16 * ct + 4 * fq);
    const float bsp = a->in[17][g * 128 + irow];
    {
        const int p = tid >> 2, qd = tid & 3;
        const u32x4* src = (const u32x4*)(GV + (r0 + p) * 1024 + g * 128 + 32 * qd);
        float x[32];
#pragma unroll
        for (int i = 0; i < 4; ++i) { const u32x4 rw = src[i];
            x[8 * i + 0] = bflo(rw.x); x[8 * i + 1] = bfhi(rw.x); x[8 * i + 2] = bflo(rw.y); x[8 * i + 3] = bfhi(rw.y);
            x[8 * i + 4] = bflo(rw.z); x[8 * i + 5] = bfhi(rw.z); x[8 * i + 6] = bflo(rw.w); x[8 * i + 7] = bfhi(rw.w); }
        float s = 0.f;
#pragma unroll
        for (int i = 0; i < 32; ++i) s += x[i];
        s += __shfl_xor(s, 1); s += __shfl_xor(s, 2);
        const float mean = s * (1.f / 128.f); float q = 0.f;
#pragma unroll
        for (int i = 0; i < 32; ++i) { x[i] -= mean; q += x[i] * x[i]; }
        q += __shfl_xor(q, 1); q += __shfl_xor(q, 2);
        const float rstd = 1.f / sqrtf(q * (1.f / 128.f) + LN_EPS);
        const float* gg = a->in[14] + g * 128 + 32 * qd; const float* gb = a->in[15] + g * 128 + 32 * qd;
#pragma unroll
        for (int i = 0; i < 32; i += 2) {
            const unsigned pr = pk2(x[i] * rstd * gg[i] + gb[i], x[i + 1] * rstd * gg[i + 1] + gb[i + 1]);
            vT[(32 * qd + i) * 136 + p] = (bf16_t)(pr & 0xffffu); vT[(32 * qd + i + 1) * 136 + p] = (bf16_t)(pr >> 16);
        }
    }
    __syncthreads();
    f32x4 acc[8];
#pragma unroll
    for (int ct = 0; ct < 8; ++ct) acc[ct] = (f32x4){0.f, 0.f, 0.f, 0.f};
#pragma unroll
    for (int ks = 0; ks < 4; ++ks) if (ks < nks) {
        const int j0 = ks * 32 + 8 * fq;
        const f32x4 w0 = wq[ks][0], w1 = wq[ks][1];
        const bf16x8 wf = pack8(j0 + 0 <= irow ? w0[0] : 0.f, j0 + 1 <= irow ? w0[1] : 0.f, j0 + 2 <= irow ? w0[2] : 0.f, j0 + 3 <= irow ? w0[3] : 0.f,
                                j0 + 4 <= irow ? w1[0] : 0.f, j0 + 5 <= irow ? w1[1] : 0.f, j0 + 6 <= irow ? w1[2] : 0.f, j0 + 7 <= irow ? w1[3] : 0.f);
#pragma unroll
        for (int ct = 0; ct < 8; ++ct) { const bf16x8 vf = *(const LAS bf16x8*)(vT + (16 * ct + fr) * 136 + ks * 32 + 8 * fq); acc[ct] = MFMA16(vf, wf, acc[ct]); }
    }
    float ssq = 0.f;
#pragma unroll
    for (int ct = 0; ct < 8; ++ct) {
        const float o0 = bflo(uw[ct].x) * (acc[ct][0] + bsp), o1 = bfhi(uw[ct].x) * (acc[ct][1] + bsp), o2 = bflo(uw[ct].y) * (acc[ct][2] + bsp), o3 = bfhi(uw[ct].y) * (acc[ct][3] + bsp);
        ssq += (o0 * o0 + o1 * o1) + (o2 * o2 + o3 * o3);
        const f32x4 og = *(const f32x4*)(a->in[18] + 1024 + g * 128 + 16 * ct + 4 * fq) * MIX_SCALE;
        *(unsigned*)(a->ws + WS_H8 + row * DM + 1024 + g * 128 + 16 * ct + 4 * fq) = pk4_fp8(o0 * og[0], o1 * og[1], o2 * og[2], o3 * og[3]);
    }
    ssq += __shfl_xor(ssq, 16); ssq += __shfl_xor(ssq, 32);
    if (fq == 0) SS[row * 24 + 16 + g] = ssq;
    __syncthreads();
}
__device__ __forceinline__ void sattn_wave(KArgsPtr a, LAS float* wl, int si, int lane) {
    const int bs = si >> 4, h = si & 15, kvh = h >> 2; const size_t row = MP + bs;
    const bf16_t* Q = (const bf16_t*)(a->ws + WS_Q); const bf16_t* Kb = (const bf16_t*)(a->ws + WS_K); const bf16_t* Vb = (const bf16_t*)(a->ws + WS_V);
    bf16_t* MIX = (bf16_t*)(a->ws + WS_MIX); float* SS = (float*)(a->ws + WS_SS);
    LAS float* ql = wl; LAS float* pl = wl + 64;
    const float qv = bf2f(Q[row * 1024 + h * 64 + lane]);
    ql[lane] = qv;
    const float dotnew = wave_sum(qv * bf2f(Kb[row * 256 + kvh * 64 + lane]));
    const float* ck = a->in[2] + (size_t)bs * 128 * 256 + kvh * 64; const float* cv = a->in[3] + (size_t)bs * 128 * 256 + kvh * 64;
    const int j0 = lane + 1, j1 = (lane + 65 < 128) ? (lane + 65) : 127;
    float s0 = 0.f, s1 = 0.f;
#pragma unroll
    for (int hf = 0; hf < 2; ++hf) {
        f32x4 k0[8], k1[8];
#pragma unroll
        for (int d4 = 0; d4 < 8; ++d4) { k0[d4] = *(const f32x4*)(ck + (size_t)j0 * 256 + 32 * hf + 4 * d4); k1[d4] = *(const f32x4*)(ck + (size_t)j1 * 256 + 32 * hf + 4 * d4); }
#pragma unroll
        for (int d4 = 0; d4 < 8; ++d4) {
            const f32x4 qq = *(const LAS f32x4*)(ql + 32 * hf + 4 * d4);
            s0 += (qq[0] * k0[d4][0] + qq[1] * k0[d4][1]) + (qq[2] * k0[d4][2] + qq[3] * k0[d4][3]);
            s1 += (qq[0] * k1[d4][0] + qq[1] * k1[d4][1]) + (qq[2] * k1[d4][2] + qq[3] * k1[d4][3]);
        }
    }
    if (lane == 63) s1 = dotnew;
    const float sink = a->in[13][h];
    const float mx = fmaxf(wave_max(fmaxf(s0, s1)), sink);
    const float p0 = __expf(s0 - mx), p1 = __expf(s1 - mx);
    const float denom = wave_sum(p0 + p1) + __expf(sink - mx);
    pl[lane] = p0; pl[lane + 64] = p1;
    float o = 0.f;
    const float vnew = bf2f(Vb[row * 256 + kvh * 64 + lane]);
    for (int jb = 0; jb < 128; jb += 32) {
        float vv[32];
#pragma unroll
        for (int u = 0; u < 32; ++u) { const int j = jb + u; vv[u] = cv[(size_t)(j < 127 ? j + 1 : 127) * 256 + lane]; }
#pragma unroll
        for (int u = 0; u < 32; ++u) { const int j = jb + u; o += pl[j] * (j < 127 ? vv[u] : vnew); }
    }
    o = o / denom;
    *(unsigned char*)(a->ws + WS_H8 + row * DM + h * 64 + lane) = (unsigned char)(pk4_fp8(o * a->in[18][h * 64 + lane] * MIX_SCALE, 0.f, 0.f, 0.f) & 0xffu);
    const float ss = wave_sum(o * o);
    if (lane == 0) SS[row * 24 + h] = ss;
}
__device__ __forceinline__ void sgmlp_wave(KArgsPtr a, int bs, int lane) {
    const size_t row = MP + bs;
    const bf16_t* GV = (const bf16_t*)(a->ws + WS_GV); const bf16_t* U = (const bf16_t*)(a->ws + WS_U);
    bf16_t* MIX = (bf16_t*)(a->ws + WS_MIX); float* SS = (float*)(a->ws + WS_SS);
    unsigned gwv[8], uwv[8]; float gn0[8], gn1[8], gb0[8], gb1[8], wsv[8], bsv[8], og0[8], og1[8];
#pragma unroll
    for (int g = 0; g < 8; ++g) {
        const int c = g * 128 + 2 * lane;
        gwv[g] = *(const unsigned*)(GV + row * 1024 + c); uwv[g] = *(const unsigned*)(U + row * 1024 + c);
        gn0[g] = a->in[14][c]; gn1[g] = a->in[14][c + 1]; gb0[g] = a->in[15][c]; gb1[g] = a->in[15][c + 1];
        wsv[g] = a->in[16][(size_t)g * 128 * 128]; bsv[g] = a->in[17][g * 128];
    }
#pragma unroll
    for (int g = 0; g < 8; ++g) {
        const int c = g * 128 + 2 * lane;
        float x0 = bflo(gwv[g]), x1 = bfhi(gwv[g]);
        const float mean = wave_sum(x0 + x1) * (1.f / 128.f); x0 -= mean; x1 -= mean;
        const float rstd = 1.f / sqrtf(wave_sum(x0 * x0 + x1 * x1) * (1.f / 128.f) + LN_EPS);
        const float v0 = x0 * rstd * gn0[g] + gb0[g], v1 = x1 * rstd * gn1[g] + gb1[g];
        a->out[OFF_GVS + (size_t)bs * 1024 + c] = v0; a->out[OFF_GVS + (size_t)bs * 1024 + c + 1] = v1;
        const float o0 = bflo(uwv[g]) * (wsv[g] * v0 + bsv[g]), o1 = bfhi(uwv[g]) * (wsv[g] * v1 + bsv[g]);
        *(unsigned short*)(a->ws + WS_H8 + row * DM + 1024 + c) = (unsigned short)(pk4_fp8(o0 * a->in[18][1024 + c] * MIX_SCALE, o1 * a->in[18][1024 + c + 1] * MIX_SCALE, 0.f, 0.f) & 0xffffu);
        const float ss = wave_sum(o0 * o0 + o1 * o1);
        if (lane == 0) SS[row * 24 + 16 + g] = ss;
    }
}
__device__ __forceinline__ void mix_phase(KArgsPtr a, LAS unsigned char* lds, int tid) {
    const int NA4 = 256, NG = 512, NSA = 64, NSG = 4, NREST = NG + NSA + NSG;
    const int w = __builtin_amdgcn_readfirstlane(tid >> 6), lane = tid & 63, fr = lane & 15, fq = lane >> 4;
    for (int j = blockIdx.x; j < NA4; j += gridDim.x) {
        const int kvh = j & 3, nb = (j >> 2) & 15, bb = j >> 6;
        const int item0 = (bb << 8) | (nb << 4) | (4 * kvh);
        AttnRegs R; attn_load(a, item0, tid, R);
        bf16x8 qx[3][2];
        {
            const bf16_t* Q = (const bf16_t*)(a->ws + WS_Q);
            const unsigned qrow = bb * SEQ + nb * 128 + 16 * w + fr;
#pragma unroll
            for (int hh = 0; hh < 3; ++hh)
#pragma unroll
                for (int ks = 0; ks < 2; ++ks) qx[hh][ks] = *(const bf16x8*)(Q + qrow * 1024u + (4 * kvh + 1 + hh) * 64 + ks * 32 + 8 * fq);
        }
        attn_stage(lds, tid, R);
        __syncthreads();
        attn_compute(a, lds, item0, tid, R.qf);
#pragma unroll
        for (int hh = 0; hh < 3; ++hh) attn_compute(a, lds, item0 + 1 + hh, tid, qx[hh]);
        __syncthreads();
    }
    for (int it = blockIdx.x; it < NREST; it += gridDim.x) {
        if (it < NG) gmlp_item(a, lds, it, tid);
        else if (it < NG + NSA) sattn_wave(a, (LAS float*)(lds + w * 1024), (it - NG) * 8 + w, lane);
        else sgmlp_wave(a, (it - NG - NSA) * 8 + w, lane);
    }
}

#define XB_TMO      128
#define XB_XCNT(j)  (256  + 64 * (j))
#define XB_XSUB(j)  (1280 + 64 * (j))
#define XB_XGEN(j)  (2304 + 64 * (j))
#define XB_TOP      3328
#define XB_TOPGEN   3392
#define XCD_BAR_WORDS 3456
#define XB_SPIN_CAP (1u << 18)

__device__ __forceinline__ unsigned xb_ld(unsigned* p)              { return __hip_atomic_load(p, __ATOMIC_RELAXED, __HIP_MEMORY_SCOPE_AGENT); }
__device__ __forceinline__ unsigned xb_add(unsigned* p, unsigned v) { return __hip_atomic_fetch_add(p, v, __ATOMIC_RELAXED, __HIP_MEMORY_SCOPE_AGENT); }
__device__ __forceinline__ unsigned xb_xcc_id() { return (unsigned)__builtin_amdgcn_s_getreg((3 << 11) | 20) & 0xFu; }
#define XB_SPIN(cond, bar) do { unsigned _sp = 0; while (cond) { __builtin_amdgcn_s_sleep(1); \
    if ((++_sp & 255u) == 0u) { if (xb_ld(&(bar)[XB_TMO])) break; if (_sp > XB_SPIN_CAP) { atomicAdd(&(bar)[XB_TMO], 1u); break; } } } } while (0)

struct XcdBarrier {
    unsigned* bar; unsigned x;
    volatile LAS unsigned* st;
};

__device__ __forceinline__ XcdBarrier xcd_barrier_post(unsigned* bar, volatile LAS unsigned* st) {
    XcdBarrier b; b.bar = bar; b.x = xb_xcc_id(); b.st = st;
    if (threadIdx.x == 0) (void)xb_add(&bar[XB_XCNT(b.x)], 1u);
    return b;
}
__device__ __forceinline__ void xcd_barrier_complete(unsigned* bar, unsigned x, unsigned& nloc, unsigned& nx) {
    const unsigned G = gridDim.x * gridDim.y * gridDim.z;
    unsigned sum, cnt, mine, sp = 0u;
    for (;;) {
        sum = 0u; cnt = 0u; mine = 0u;
#pragma unroll
        for (unsigned j = 0; j < 16; ++j) { const unsigned c = xb_ld(&bar[XB_XCNT(j)]); sum += c; cnt += (c > 0u) ? 1u : 0u; mine = (j == x) ? c : mine; }
        if (sum == G) break;
        __builtin_amdgcn_s_sleep(1);
        if ((++sp & 255u) == 0u) { if (xb_ld(&bar[XB_TMO])) break; if (sp > XB_SPIN_CAP) { atomicAdd(&bar[XB_TMO], 1u); break; } }
    }
    nloc = mine > 0u ? mine : 1u; nx = cnt > 0u ? cnt : 1u;
}

__device__ __forceinline__ void xcd_barrier(const XcdBarrier& b) {
    asm volatile("s_waitcnt vmcnt(0)" ::: "memory");
    __syncthreads();
    if (threadIdx.x == 0) {
        unsigned* bar = b.bar;
        __builtin_amdgcn_s_waitcnt(0);
        unsigned nloc = b.st[0], nx = b.st[1];
        if (nloc == 0u) { xcd_barrier_complete(bar, b.x, nloc, nx); b.st[0] = nloc; b.st[1] = nx; }
        const unsigned old = xb_add(&bar[XB_XSUB(b.x)], 1u);
        const unsigned gen = old / nloc;
        if (old + 1u == (gen + 1u) * nloc) {
            __builtin_amdgcn_fence(__ATOMIC_RELEASE, "agent");
            asm volatile("s_waitcnt vmcnt(0)" ::: "memory");
            const unsigned og = xb_add(&bar[XB_TOP], 1u);
            const unsigned tg = og / nx;
            if (og + 1u == (tg + 1u) * nx) xb_add(&bar[XB_TOPGEN], 1u);
            else XB_SPIN(xb_ld(&bar[XB_TOPGEN]) == tg, bar);
            __builtin_amdgcn_fence(__ATOMIC_ACQUIRE, "agent");
            xb_add(&bar[XB_XGEN(b.x)], 1u);
            asm volatile("s_waitcnt vmcnt(0)" ::: "memory");
        } else {
            XB_SPIN(xb_ld(&bar[XB_XGEN(b.x)]) == gen, bar);
            __builtin_amdgcn_fence(__ATOMIC_ACQUIRE, "agent");
            asm volatile("s_waitcnt vmcnt(0)" ::: "memory");
        }
    }
    __syncthreads();
}

__device__ __forceinline__ int fresh_tid() { int t = threadIdx.x; asm volatile("" : "+v"(t)); return t; }
__device__ __forceinline__ KArgsPtr load_args() { KArgsPtr p = (KArgsPtr)__builtin_amdgcn_kernarg_segment_ptr(); asm volatile("" : "+s"(p)); return p; }
#define LA load_args()
__global__ void __launch_bounds__(512, 2) fwd(Args kernarg_only) {
    extern __shared__ __attribute__((aligned(16))) unsigned char lds_raw[];
    LAS unsigned char* lds = (LAS unsigned char*)lds_raw;
    cg::grid_group grid = cg::this_grid();
    volatile LAS unsigned* MISC = (volatile LAS unsigned*)(lds + 131072 + 320);
    if (threadIdx.x < 32) MISC[threadIdx.x] = 0u;
    __syncthreads();
    XcdBarrier xbar = xcd_barrier_post((unsigned*)(LA->ws + WS_CTL) + 4096, MISC + 8);
    if (gridDim.x == 0x7fffffffu) grid.sync();
#define GRID_SYNC() xcd_barrier(xbar)
    const int G = gridDim.x, c = blockIdx.x;
#define tid fresh_tid()
#define mod ((float*)(LA->ws + WS_MOD))
#define WUP ((bf16_t*)(LA->ws + WS_WUP))
#define WDN ((bf16_t*)(LA->ws + WS_WDN))
#define WIN ((bf16_t*)(LA->ws + WS_WIN))
#define WO ((bf16_t*)(LA->ws + WS_WO))
#define H ((bf16_t*)(LA->ws + WS_H))
#define ACT ((bf16_t*)(LA->ws + WS_ACT))
#define Y ((bf16_t*)(LA->ws + WS_Y))
#define PARTP ((float*)(LA->ws + WS_PART))
#define X1 ((bf16_t*)(LA->ws + WS_X1))

#ifndef NO_P0
    for (int rep = 0; rep <= DUP_P0; ++rep) { p0_phase(LA, lds, tid, rep); if (rep < DUP_P0) GRID_SYNC(); }
#endif
    GRID_SYNC();
#ifndef NO_ROW
    h0_phase(LA, tid);
#if DUP_ROW
    GRID_SYNC();
    h0_phase(LA, tid);
#endif
#endif
    GRID_SYNC();
#define UP_PHASE(l) { pg8::Gemm g{(const bf16_t*)(LA->ws + WS_H8), (const bf16_t*)(LA->ws + WS_WUP + (size_t)(l) * WUP_ELEMS), MPAD, NUP, DM / 2}; pg8::StaticOrder S; S.init(MPAD, NUP, G, c); EpiSwiGLU E{LA->ws + WS_ACT}; \
      pg8::gemm_phase<EpiSwiGLU, pg8::StaticOrder, true, true, true>(lds, g, S, E);       \
      { const int rem = ((MPAD / 256) * (NUP / 256)) % G; if (rem != 0 && c >= rem) tr_deferred(LA, lds, tid, 2 * I_UP + (l) * I_DN, I_DN, c - rem, G - rem); else if (rem == 0) tr_deferred(LA, lds, tid, 2 * I_UP + (l) * I_DN, I_DN, c, G); } }
#define DOWN_PHASE(l, sub, xres, XB, LNI) { pg8::Gemm g{(const bf16_t*)(LA->ws + WS_ACT), (const bf16_t*)(LA->ws + WS_WDN + (size_t)(l) * WDN8_BYTES), MP, DM, DFFP / 2}; pg8::StaticOrder S; S.init(MP, DM, G, c); \
      EpiResid<XB> E{xres, Y, mod + (sub) * 6144 + 4096, LA->in[8] + (LNI) * DM, LA->in[9] + (LNI) * DM, (const float*)(LA->ws + WS_STATS)}; \
      small_part<true>(lds, tid, LA->ws + WS_ACT + (size_t)MP * DFFP, LA->ws + WS_WDN + (size_t)(l) * WDN8_BYTES, DFFP, PARTP); \
      pg8::gemm_phase<EpiResid<XB>, pg8::StaticOrder, true, true, true>(lds, g, S, E); }
#ifndef NO_UP
    UP_PHASE(0)
#if DUP_UP
    GRID_SYNC();
    UP_PHASE(0)
#endif
#endif
    GRID_SYNC();
#ifndef NO_DN
    DOWN_PHASE(0, 0, LA->in[0], 0, 0)
#if DUP_DN
    GRID_SYNC();
    DOWN_PHASE(0, 0, LA->in[0], 0, 0)
#endif
#endif
    GRID_SYNC();
#ifndef NO_ROW
    ln_phase(LA, lds, tid, 0, false, 1);
#if DUP_ROW
    GRID_SYNC();
    ln_phase(LA, lds, tid, 0, false, 1);
#endif
#endif
    GRID_SYNC();
    { pg8::Gemm g{H, WIN, MPAD, INW, DM}; pg8::StaticOrder S; S.init(MPAD, INW, G, c);
      EpiInProj E{(bf16_t*)(LA->ws + WS_Q), (bf16_t*)(LA->ws + WS_K), (bf16_t*)(LA->ws + WS_V), (bf16_t*)(LA->ws + WS_U), (bf16_t*)(LA->ws + WS_GV), (const float*)(LA->ws + WS_ROPE), LA->out};

#ifndef NO_IN
      pg8::gemm_phase<EpiInProj, pg8::StaticOrder, true, true>(lds, g, S, E);
#endif
      { const int rem = ((MPAD / 256) * (INW / 256)) % G; const int bi_ = rem != 0 ? c - rem : c, nb_ = rem != 0 ? G - rem : G;
        if (rem == 0 || c >= rem) { tr_deferred(LA, lds, tid, 2 * I_UP + 2 * I_DN + I_IN, I_WO, bi_, nb_); tr_deferred(LA, lds, tid, 2 * I_UP - N_UP1_DEF, N_UP1_DEF, bi_, nb_); } }
    }
    GRID_SYNC();
#ifndef NO_MIX
    mix_phase(LA, lds, tid);
#if DUP_MIX
    GRID_SYNC();
    mix_phase(LA, lds, tid);
#endif
#endif
    GRID_SYNC();
#ifndef NO_WO
    { pg8::Gemm g{(const bf16_t*)(LA->ws + WS_H8), (const bf16_t*)(LA->ws + WS_WO), MP, DM, DM / 2}; pg8::StaticOrder S; S.init(MP, DM, G, c);
      LAS float* rs = (LAS float*)(lds + 131072 + 1024);
      rs_table(LA, rs, S, tid);
      EpiResidMix E{Y, mod + 1 * 6144 + 4096, rs, LA->in[8], LA->in[9], (const float*)(LA->ws + WS_STATS)};
      small_part<true>(lds, tid, LA->ws + WS_H8 + (size_t)MP * DM, LA->ws + WS_WO, DM, PARTP);
      pg8::gemm_phase<EpiResidMix, pg8::StaticOrder, true, true, true>(lds, g, S, E); }
#endif
    GRID_SYNC();
#ifndef NO_ROW
    ln_phase(LA, lds, tid, 1, false, 2);
#endif
    GRID_SYNC();
#ifndef NO_UP
    UP_PHASE(1)
#if DUP_UP
    GRID_SYNC();
    UP_PHASE(1)
#endif
#endif
    GRID_SYNC();
#ifndef NO_DN
    DOWN_PHASE(1, 2, nullptr, 2, 1)
#if DUP_DN
    GRID_SYNC();
    DOWN_PHASE(1, 2, nullptr, 2, 1)
#endif
#endif
    GRID_SYNC();
#ifndef DUP_SYNC
#define DUP_SYNC 0
#endif
    for (int i = 0; i < DUP_SYNC; ++i) GRID_SYNC();
    ln_phase(LA, lds, tid, 2, true, 0);
#if DUP_ROW
    GRID_SYNC();
    ln_phase(LA, lds, tid, 2, true, 0);
#endif
#undef tid
#undef mod
#undef WUP
#undef WDN
#undef WIN
#undef WO
#undef H
#undef ACT
#undef Y
#undef X1
}

extern "C" void kernel_launch(void* const* d_in, const int* in_sizes, int n_in, void* d_out, int out_size, void* d_ws, size_t ws_size, hipStream_t stream) {
    static int grid = 0;
    if (grid == 0) {
        if (n_in != 20 || ws_size < WS_END) { fprintf(stderr, "kernel_launch: unexpected n_in %d / ws %zu\n", n_in, ws_size); grid = -1; return; }
        int dev = 0, cus = 0, per_cu = 0;
        if (hipGetDevice(&dev) != hipSuccess || hipDeviceGetAttribute(&cus, hipDeviceAttributeMultiprocessorCount, dev) != hipSuccess) { grid = -1; return; }
        if (hipFuncSetAttribute((const void*)fwd, hipFuncAttributeMaxDynamicSharedMemorySize, LDS_BYTES) != hipSuccess) { fprintf(stderr, "kernel_launch: hipFuncSetAttribute failed\n"); grid = -1; return; }
        if (hipOccupancyMaxActiveBlocksPerMultiprocessor(&per_cu, (const void*)fwd, 512, LDS_BYTES) != hipSuccess || per_cu < 1) { fprintf(stderr, "kernel_launch: occupancy query says %d\n", per_cu); }
        (void)hipGetLastError();
        grid = cus;
    }
    if (grid < 0) return;
    (void)hipMemsetAsync((char*)d_ws + WS_CTL, 0, 65536, stream);
    Args a{};
    for (int i = 0; i < 20; ++i) a.in[i] = (const float*)d_in[i];
    a.out = (float*)d_out; a.ws = (unsigned char*)d_ws;
    void* args[] = {&a};
    hipError_t e = hipLaunchCooperativeKernel((const void*)fwd, dim3(grid), dim3(512), args, LDS_BYTES, stream);
    if (e != hipSuccess) fprintf(stderr, "kernel_launch: cooperative launch failed: %s (grid %d)\n", hipGetErrorString(e), grid);
}
```
